# Optimizing an MI355X kernel written in HIP

```python
import jax, jax.numpy as jnp
from jax import lax
import numpy as np

D_MODEL = 1024
BATCH = 16
SEQ = 2048
DEPTH = 1

N_MEM = 256
EPS = 1e-6

HEAD_DIM = 64
DIL_PATTERNS = ((128, 1), (512, 4), (2048, 16))
N_GROUPS = len(DIL_PATTERNS)
ATTN_SLOTS = 4
ATTN_HEADS = N_GROUPS * ATTN_SLOTS
ATTN_WIDTH = ATTN_HEADS * HEAD_DIM
ATTN_OUT = ATTN_SLOTS * HEAD_DIM
ROT_DIM = HEAD_DIM // 4
ROPE_THETA = 500000.0

CONV_WIDTH = 768
CONV_K = 3

MEM_HEADS = 4
MEM_HEAD_DIM = 128
MEM_WIDTH = MEM_HEADS * MEM_HEAD_DIM

N_BRANCH = 3
IN_SIZES = (ATTN_WIDTH, ATTN_WIDTH, ATTN_WIDTH, CONV_WIDTH, CONV_WIDTH, CONV_WIDTH,
            MEM_WIDTH, N_BRANCH * D_MODEL)
IN_COLS = sum(IN_SIZES)
IN_SPLITS = tuple(int(c) for c in np.cumsum(IN_SIZES)[:-1])

N_EXPERT_GROUPS = 4
EXPERTS_PER_GROUP = 8
N_EXPERTS = N_EXPERT_GROUPS * EXPERTS_PER_GROUP
TOP_K = 2
EXPERT_FF = 512
MOE_BLOCK = 256

kernel_name = 'hybrid_dilated_conv_mem_hmoe_block'


def _rmsnorm(x, g):
    xf = x.astype(jnp.float32)
    y = xf * lax.rsqrt(jnp.mean(xf * xf, axis=-1, keepdims=True) + EPS)
    return (y * g.astype(jnp.float32)).astype(x.dtype)


def _rope_tables(positions):
    inv = ROPE_THETA ** (-jnp.arange(0, ROT_DIM, 2, dtype=jnp.float32) / ROT_DIM)
    ang = positions.astype(jnp.float32)[..., None] * inv
    return jnp.cos(ang)[:, :, None, :], jnp.sin(ang)[:, :, None, :]


def _partial_rope(t, cos, sin):
    tr = t[..., :ROT_DIM].astype(jnp.float32)
    t1, t2 = tr[..., :ROT_DIM // 2], tr[..., ROT_DIM // 2:]
    rot = jnp.concatenate([t1 * cos - t2 * sin, t2 * cos + t1 * sin], axis=-1)
    return jnp.concatenate([rot.astype(t.dtype), t[..., ROT_DIM:]], axis=-1)


def _banded_attention(q, k, v, half):
    b, g, L, h, dh = q.shape
    blk = half
    nb = -(-L // blk)
    lp = nb * blk
    qb = jnp.pad(q, ((0, 0), (0, 0), (0, lp - L), (0, 0), (0, 0))).reshape(b, g, nb, blk, h, dh)
    pad_k = ((0, 0), (0, 0), (blk, lp - L + blk), (0, 0), (0, 0))

    def windows(t):
        tb = jnp.pad(t, pad_k).reshape(b, g, nb + 2, blk, h, dh)
        return jnp.concatenate([tb[:, :, :-2], tb[:, :, 1:-1], tb[:, :, 2:]], axis=3)

    kw, vw = windows(k), windows(v)
    qpos = np.arange(nb)[:, None] * blk + np.arange(blk)[None, :]
    kpos = np.arange(nb)[:, None] * blk - blk + np.arange(3 * blk)[None, :]
    valid = ((np.abs(qpos[:, :, None] - kpos[:, None, :]) <= half)
             & (kpos[:, None, :] >= 0) & (kpos[:, None, :] < L))
    s = jnp.einsum('bgnqhd,bgnkhd->bgnhqk', qb, kw).astype(jnp.float32) * (dh ** -0.5)
    s = jnp.where(jnp.asarray(valid)[:, None], s, jnp.finfo(jnp.float32).min)
    m = jnp.max(s, axis=-1, keepdims=True)
    p = jnp.exp(s - m)
    den = jnp.sum(p, axis=-1)
    o = jnp.einsum('bgnhqk,bgnkhd->bgnqhd', p.astype(v.dtype), vw)
    o = o / jnp.transpose(den, (0, 1, 2, 4, 3))[..., None].astype(o.dtype)
    lse = jnp.transpose(m[..., 0] + jnp.log(den), (0, 1, 2, 4, 3))
    o = o.reshape(b, g, lp, h, dh)[:, :, :L]
    lse = lse.reshape(b, g, lp, h)[:, :, :L]
    return o, lse


def _dilated_attention(q, k, v, window, dilation):
    b, s, h, dh = q.shape
    L = s // dilation
    half = window // (2 * dilation)

    def to_sub(t):
        return jnp.transpose(t.reshape(b, L, dilation, h, dh), (0, 2, 1, 3, 4))

    o, lse = _banded_attention(to_sub(q), to_sub(k), to_sub(v), half)
    o = jnp.transpose(o, (0, 2, 1, 3, 4)).reshape(b, s, h, dh)
    lse = jnp.transpose(lse, (0, 2, 1, 3)).reshape(b, s, h)
    return o, lse


def _hierarchical_moe(h, w_rg, b_rg, w_re, b_re, w_gate, w_up, w_down):
    b, s, d = h.shape
    n = b * s
    hf = h.reshape(n, d)
    hr = hf.astype(jnp.float32)
    pg = jax.nn.softmax(hr @ w_rg.astype(jnp.float32) + b_rg.astype(jnp.float32), axis=-1)
    pg_top, g_idx = lax.top_k(pg, 1)
    el = (hr @ w_re.astype(jnp.float32) + b_re.astype(jnp.float32)).reshape(n, N_EXPERT_GROUPS, EXPERTS_PER_GROUP)
    sel = jnp.einsum('ng,nge->ne', jax.nn.one_hot(g_idx[:, 0], N_EXPERT_GROUPS, dtype=jnp.float32), el)
    pe_top, e_idx = lax.top_k(jax.nn.softmax(sel, axis=-1), TOP_K)
    weights = pg_top * pe_top / jnp.sum(pe_top, axis=-1, keepdims=True)
    ids = g_idx * EXPERTS_PER_GROUP + e_idx

    nk = n * TOP_K
    e = ids.reshape(nk).astype(jnp.int32)
    w = weights.reshape(nk)
    t = jnp.repeat(jnp.arange(n, dtype=jnp.int32), TOP_K)
    order = jnp.argsort(e, stable=True)
    e_s, t_s, w_s = e[order], t[order], w[order]
    counts = jnp.bincount(e, length=N_EXPERTS)
    padded = ((counts + MOE_BLOCK - 1) // MOE_BLOCK) * MOE_BLOCK
    start = jnp.cumsum(counts) - counts
    pend = jnp.cumsum(padded)
    pstart = pend - padded
    dest = pstart[e_s] + (jnp.arange(nk, dtype=jnp.int32) - start[e_s])
    n_rows = (-(-nk // MOE_BLOCK) + N_EXPERTS) * MOE_BLOCK
    n_blk = n_rows // MOE_BLOCK
    row_tok = jnp.zeros((n_rows,), jnp.int32).at[dest].set(t_s)
    row_w = jnp.zeros((n_rows,), jnp.float32).at[dest].set(w_s)
    blk_exp = jnp.minimum(jnp.searchsorted(pend, jnp.arange(n_blk) * MOE_BLOCK, side='right'),
                          N_EXPERTS - 1).astype(jnp.int32)

    def expert_block(args):
        tok, wt, ex = args
        xb = hf[tok]
        a = xb @ w_gate[ex]
        u = xb @ w_up[ex]
        y = (jax.nn.silu(a) * u) @ w_down[ex]
        return y * wt[:, None].astype(y.dtype)

    ys = lax.map(expert_block, (row_tok.reshape(n_blk, MOE_BLOCK),
                                row_w.reshape(n_blk, MOE_BLOCK), blk_exp))
    out = jnp.zeros((n, d), h.dtype).at[row_tok].add(ys.reshape(n_rows, d).astype(h.dtype))
    return out.reshape(b, s, d)


def setup_inputs(seed: int = 0) -> dict:
    key = jax.random.key(seed)
    ks = jax.random.split(key, 24)
    f32 = jnp.float32

    def nrm(k, shape, scale):
        return jax.random.normal(k, shape, f32) * scale

    def gain(k, dim):
        return 1.0 + 0.05 * jax.random.normal(k, (DEPTH, dim), f32)

    x = jax.random.normal(ks[0], (BATCH, SEQ, D_MODEL), f32)
    mem = jax.random.normal(ks[1], (BATCH, N_MEM, D_MODEL), f32)
    positions = (jnp.arange(SEQ, dtype=jnp.int32)[None, :]
                 + jax.random.randint(ks[2], (BATCH, 1), 0, 4096, dtype=jnp.int32))
    return {
        'x': x,
        'mem': mem,
        'positions': positions,
        'g_mix': gain(ks[3], D_MODEL),
        'g_mem': gain(ks[4], D_MODEL),
        'w_in': nrm(ks[5], (DEPTH, D_MODEL, IN_COLS), D_MODEL ** -0.5),
        'g_qn_attn': gain(ks[6], HEAD_DIM),
        'g_kn_attn': gain(ks[7], HEAD_DIM),
        'w_conv': nrm(ks[8], (DEPTH, CONV_K, CONV_WIDTH), CONV_K ** -0.5),
        'w_mem_kv': nrm(ks[9], (DEPTH, D_MODEL, 2 * MEM_WIDTH), D_MODEL ** -0.5),
        'g_qn_mem': gain(ks[10], MEM_HEAD_DIM),
        'g_kn_mem': gain(ks[11], MEM_HEAD_DIM),
        'w_proj_attn': nrm(ks[12], (DEPTH, ATTN_OUT, D_MODEL), ATTN_OUT ** -0.5),
        'w_proj_conv': nrm(ks[13], (DEPTH, CONV_WIDTH, D_MODEL), CONV_WIDTH ** -0.5),
        'w_proj_mem': nrm(ks[14], (DEPTH, MEM_WIDTH, D_MODEL), MEM_WIDTH ** -0.5),
        'w_out': nrm(ks[15], (DEPTH, D_MODEL, D_MODEL), D_MODEL ** -0.5),
        'g_ffn': gain(ks[16], D_MODEL),
        'w_router_group': nrm(ks[17], (DEPTH, D_MODEL, N_EXPERT_GROUPS), D_MODEL ** -0.5),
        'b_router_group': nrm(ks[18], (DEPTH, N_EXPERT_GROUPS), 0.01),
        'w_router_expert': nrm(ks[19], (DEPTH, D_MODEL, N_EXPERTS), D_MODEL ** -0.5),
        'b_router_expert': nrm(ks[20], (DEPTH, N_EXPERTS), 0.01),
        'w_gate': nrm(ks[21], (DEPTH, N_EXPERTS, D_MODEL, EXPERT_FF), D_MODEL ** -0.5),
        'w_up': nrm(ks[22], (DEPTH, N_EXPERTS, D_MODEL, EXPERT_FF), D_MODEL ** -0.5),
        'w_down': nrm(ks[23], (DEPTH, N_EXPERTS, EXPERT_FF, D_MODEL), EXPERT_FF ** -0.5),
    }


def reference(x, mem, positions, g_mix, g_mem, w_in, g_qn_attn, g_kn_attn, w_conv,
              w_mem_kv, g_qn_mem, g_kn_mem, w_proj_attn, w_proj_conv, w_proj_mem, w_out,
              g_ffn, w_router_group, b_router_group, w_router_expert, b_router_expert,
              w_gate, w_up, w_down):
    b, s, d = x.shape
    cos, sin = _rope_tables(positions)
    cos, sin = cos.astype(x.dtype), sin.astype(x.dtype)
    for l in range(DEPTH):
        h = _rmsnorm(x, g_mix[l])
        proj = h @ w_in[l]
        q_a, k_a, v_a, cx, cb, cc, q_m, gate_logits = jnp.split(proj, IN_SPLITS, axis=-1)

        q_a = _partial_rope(_rmsnorm(q_a.reshape(b, s, ATTN_HEADS, HEAD_DIM), g_qn_attn[l]), cos, sin)
        k_a = _partial_rope(_rmsnorm(k_a.reshape(b, s, ATTN_HEADS, HEAD_DIM), g_kn_attn[l]), cos, sin)
        v_a = v_a.reshape(b, s, ATTN_HEADS, HEAD_DIM)
        q_a = q_a.reshape(b, s, N_GROUPS, ATTN_SLOTS, HEAD_DIM)
        k_a = k_a.reshape(b, s, N_GROUPS, ATTN_SLOTS, HEAD_DIM)
        v_a = v_a.reshape(b, s, N_GROUPS, ATTN_SLOTS, HEAD_DIM)
        outs, lses = [], []
        for gi, (window, dilation) in enumerate(DIL_PATTERNS):
            o_g, lse_g = _dilated_attention(q_a[:, :, gi], k_a[:, :, gi], v_a[:, :, gi], window, dilation)
            outs.append(o_g)
            lses.append(lse_g)
        alpha = jax.nn.softmax(jnp.stack(lses, axis=2), axis=2)
        o_attn = jnp.einsum('bsgh,bsghd->bshd', alpha.astype(x.dtype),
                            jnp.stack(outs, axis=2)).reshape(b, s, ATTN_OUT)

        u = cc * cx
        up = jnp.pad(u, ((0, 0), (1, 1), (0, 0)))
        wc = w_conv[l]
        y_conv = wc[0] * up[:, :-2] + wc[1] * up[:, 1:-1] + wc[2] * up[:, 2:]
        z_conv = cb * y_conv

        mkv = _rmsnorm(mem, g_mem[l]) @ w_mem_kv[l]
        k_m, v_m = jnp.split(mkv, 2, axis=-1)
        k_m = _rmsnorm(k_m.reshape(b, N_MEM, MEM_HEADS, MEM_HEAD_DIM), g_kn_mem[l])
        v_m = v_m.reshape(b, N_MEM, MEM_HEADS, MEM_HEAD_DIM)
        q_m = _rmsnorm(q_m.reshape(b, s, MEM_HEADS, MEM_HEAD_DIM), g_qn_mem[l])
        sm = jnp.einsum('bshd,bmhd->bhsm', q_m, k_m).astype(jnp.float32) * (MEM_HEAD_DIM ** -0.5)
        pm = jax.nn.softmax(sm, axis=-1).astype(v_m.dtype)
        o_mem = jnp.einsum('bhsm,bmhd->bshd', pm, v_m).reshape(b, s, MEM_WIDTH)

        gates = jax.nn.sigmoid(gate_logits).reshape(b, s, N_BRANCH, d)
        merged = (gates[:, :, 0] * (o_attn @ w_proj_attn[l])
                  + gates[:, :, 1] * (z_conv @ w_proj_conv[l])
                  + gates[:, :, 2] * (o_mem @ w_proj_mem[l]))
        x = x + merged @ w_out[l]

        h2 = _rmsnorm(x, g_ffn[l])
        x = x + _hierarchical_moe(h2, w_router_group[l], b_router_group[l], w_router_expert[l],
                                  b_router_expert[l], w_gate[l], w_up[l], w_down[l])
    return x
```

```cpp
#include <hip/hip_runtime.h>
#include <hip/hip_cooperative_groups.h>
#include <cstdio>
#include <cstdint>
namespace cg = cooperative_groups;
namespace pg8 {
#define PG8_LAS __attribute__((address_space(3)))
typedef unsigned short bf16_t;
typedef short bf16x8 __attribute__((ext_vector_type(8)));
typedef float f32x4 __attribute__((ext_vector_type(4)));
typedef unsigned u32x4 __attribute__((ext_vector_type(4)));
constexpr int BM = 256, BK = 64, HALF = 128, HTB = HALF * BK * 2  , STAGE_BYTES = 8 * HTB, NXCD = 8, WGM = 8;

__host__ __device__ __forceinline__ int lds_byte(int r, int c) { const int st = (r >> 4) * 2 + (c >> 5), rr = r & 15, cc = c & 31, ob = rr * 64 + cc * 2; return st * 1024 + (ob ^ (((ob >> 9) & 1) << 5)); }
__host__ __device__ __forceinline__ void stage_rc(int b, int& R, int& C) { const int st = b / 1024, sb = b % 1024, swz = sb ^ (((sb >> 9) & 1) << 5); R = (st >> 1) * 16 + swz / 64; C = (st & 1) * 32 + (swz % 64) / 2; }
__host__ __device__ __forceinline__ int perm32(int rho) { const int n = rho >> 4, i = rho & 15; return 8 * (i >> 2) + 4 * n + (i & 3); }

struct Unit { int pm, pn, aux; };
struct Gemm { const bf16_t* A; const bf16_t* Bt; int M, N, K; };

struct StaticOrder {
    static constexpr bool GATHER = false; __device__ __forceinline__ int row(int, int) const { return 0; }
    int nM, nN, nwg, G, c;
    __host__ __device__ void init(int M, int N, int G_, int c_) { nM = M / BM; nN = N / BM; nwg = nM * nN; G = G_; c = c_; }
    __host__ __device__ bool next(int i, Unit& u) const {
        const long L = (long)i * G + c; if (L >= nwg) return false;
        int wgid = (int)L; { const int q = nwg / NXCD, r = nwg % NXCD, xcd = wgid % NXCD, off = wgid / NXCD; wgid = (xcd < r ? xcd * (q + 1) : r * (q + 1) + (xcd - r) * q) + off; }
        const int nig = WGM * nN, gid = wgid / nig, fm = gid * WGM, gsz = (nM - fm) < WGM ? (nM - fm) : WGM;
        u.pm = fm + ((wgid % nig) % gsz); u.pn = (wgid % nig) / gsz; u.aux = u.pn; return true;
    }
    __device__ __forceinline__ void a_ready(const Unit&) const {}
    __device__ __forceinline__ void done(const Unit&) const {}
};

__device__ __forceinline__ unsigned cvt_pk_bf16(float lo, float hi) { unsigned r; asm volatile("v_cvt_pk_bf16_f32 %0, %1, %2" : "=v"(r) : "v"(lo), "v"(hi)); return r; }
template <class Epi, class Sched, bool ALIGN_EPI = false, bool SP2 = false>
__device__ __forceinline__ void gemm_phase(PG8_LAS unsigned char* lds, const Gemm g, const Sched& S, const Epi& E) {
    const int tid = threadIdx.x, wid = __builtin_amdgcn_readfirstlane(tid >> 6), lane = tid & 63, wr = wid >> 2, wc = wid & 3, fr = lane & 15, fq = lane >> 4;
    const int K = g.K, nt = K / BK;
    unsigned voffA[2], voffB[2];
    constexpr bool GATHER = Sched::GATHER;
    static_assert(!GATHER || SP2, "gather is implemented for the SP2 loop");
    unsigned gA[2][2], gN[2][2];
#pragma unroll
    for (int i = 0; i < 2; ++i) { int R, C; stage_rc(tid * 16 + i * 8192, R, C); const int Rb = Epi::PERM ? ((R & ~31) + perm32(R & 31)) : R;
        voffA[i] = (unsigned)(R * K + C) * 2u; voffB[i] = (unsigned)(Rb * K + C) * 2u; }
#define PG8_ROWS(dst, ui_) do { _Pragma("unroll") for (int h_ = 0; h_ < 2; ++h_) _Pragma("unroll") for (int i_ = 0; i_ < 2; ++i_) { int R_, C_; stage_rc(tid * 16 + i_ * 8192, R_, C_); \
        dst[h_][i_] = (unsigned)S.row(ui_, h_ * HALF + R_) * (unsigned)(K * 2) + (unsigned)(C_ * 2); } } while (0)
    const size_t kstep = (size_t)(BK * 2);
    const size_t hstep = (size_t)HALF * K * 2;
    const size_t hstepA = GATHER ? (size_t)0 : hstep;
    const size_t tstep = 2 * hstep;
    const unsigned ldsw = (unsigned)wid * 1024u;
    const int aoff = lds_byte(wr * 64 + fr, fq * 8), boff = lds_byte(wc * 32 + fr, fq * 8);
#define PG8_SA(b, h) (((b) * 2 + (h)) * HTB)
#define PG8_SB(b, h) ((4 + (b) * 2 + (h)) * HTB)
#define PG8_STAGE(bufoff, gbase, voff) do { _Pragma("unroll") for (int _i = 0; _i < 2; ++_i) \
        __builtin_amdgcn_global_load_lds((const unsigned*)((const char*)(gbase) + (voff)[_i]), (PG8_LAS unsigned*)(lds + (bufoff) + ldsw + _i * 8192), 16, 0, 0); } while (0)
#define PG8_LDA(dst, b, h) do { _Pragma("unroll") for (int m = 0; m < 4; ++m) _Pragma("unroll") for (int k = 0; k < 2; ++k) dst[m][k] = *(const PG8_LAS bf16x8*)(lds + PG8_SA(b, h) + aoff + m * 2048 + k * 1024); } while (0)
#define PG8_LDB(dst, b, h) do { _Pragma("unroll") for (int n = 0; n < 2; ++n) _Pragma("unroll") for (int k = 0; k < 2; ++k) dst[n][k] = *(const PG8_LAS bf16x8*)(lds + PG8_SB(b, h) + boff + n * 2048 + k * 1024); } while (0)
#define PG8_MMA(ai, bj, At, Bt) do { __builtin_amdgcn_s_setprio(1); _Pragma("unroll") for (int m = 0; m < 4; ++m) _Pragma("unroll") for (int n = 0; n < 2; ++n) _Pragma("unroll") for (int k = 0; k < 2; ++k) \
        acc[ai][bj][m][n] = __builtin_amdgcn_mfma_f32_16x16x32_bf16(Bt[n][k], At[m][k], acc[ai][bj][m][n], 0, 0, 0); __builtin_amdgcn_s_setprio(0); } while (0)
#define PG8_WAIT_V(n) asm volatile("s_waitcnt vmcnt(" #n ")" ::: "memory")
#define PG8_WAIT_L(n) asm volatile("s_waitcnt lgkmcnt(" #n ")" ::: "memory")
#define PG8_BAR __builtin_amdgcn_s_barrier()
#define PG8_SCHED __builtin_amdgcn_sched_barrier(0)
    Unit cur, nxt; int ui = 0;
    if (!S.next(0, cur)) return;
    f32x4 acc[2][2][4][2];
#pragma unroll
    for (int a = 0; a < 2; ++a)
#pragma unroll
        for (int b = 0; b < 2; ++b)
#pragma unroll
            for (int m = 0; m < 4; ++m)
#pragma unroll
                for (int n = 0; n < 2; ++n) acc[a][b][m][n] = (f32x4){0.f, 0.f, 0.f, 0.f};
    bf16x8 At[4][2], B0[2][2], B1[2][2];
    const char* cA = (const char*)g.A + (GATHER ? (size_t)0 : (size_t)cur.pm * tstep); const char* cB = (const char*)g.Bt + (size_t)cur.pn * tstep;
    if constexpr (GATHER) { PG8_ROWS(gA, 0); PG8_ROWS(gN, 0); }
#define PG8_OA(h) (GATHER ? gA[h] : voffA)
    S.a_ready(cur);
    if constexpr (SP2) {
        PG8_STAGE(PG8_SB(0, 0), cB, voffB); PG8_STAGE(PG8_SB(0, 1), cB + hstep, voffB); PG8_STAGE(PG8_SA(0, 0), cA, PG8_OA(0)); PG8_STAGE(PG8_SA(0, 1), cA + hstepA, PG8_OA(1));
        if (wr == 1) PG8_BAR;
        PG8_WAIT_V(2); PG8_BAR;
        PG8_STAGE(PG8_SB(1, 0), cB + kstep, voffB); PG8_STAGE(PG8_SA(1, 0), cA + kstep, PG8_OA(0)); PG8_STAGE(PG8_SB(1, 1), cB + hstep + kstep, voffB);
        PG8_WAIT_V(6); PG8_BAR;
    } else {
        PG8_STAGE(PG8_SB(0, 0), cB, voffB); PG8_STAGE(PG8_SA(0, 0), cA, voffA); PG8_STAGE(PG8_SB(0, 1), cB + hstep, voffB); PG8_STAGE(PG8_SA(0, 1), cA + hstep, voffA);
        if (wr == 1) PG8_BAR;
        PG8_WAIT_V(4); PG8_BAR;
        PG8_STAGE(PG8_SB(1, 0), cB + kstep, voffB); PG8_STAGE(PG8_SA(1, 0), cA + kstep, voffA); PG8_STAGE(PG8_SB(1, 1), cB + hstep + kstep, voffB);
        PG8_WAIT_V(6); PG8_BAR;
    }
    for (;;) {
        const bool has_next = S.next(ui + 1, nxt);
        const char* nA = (has_next && !GATHER) ? (const char*)g.A + (size_t)nxt.pm * tstep : cA; const char* nB = has_next ? (const char*)g.Bt + (size_t)nxt.pn * tstep : cB;
        if constexpr (GATHER) { if (has_next) PG8_ROWS(gN, ui + 1); }
        for (int t = 0; t < nt; t += 2) {
            const bool last = (t == nt - 2);
            const char* a1 = cA + (size_t)(t + 1) * kstep;
            const char* a2 = last ? nA : cA + (size_t)(t + 2) * kstep; const char* b2 = last ? nB : cB + (size_t)(t + 2) * kstep;
            const char* a3 = a2 + kstep; const char* b3 = b2 + kstep;
            if (last && has_next) S.a_ready(nxt);
            if constexpr (Epi::HAS_MID) { if (t == E.mid0 || t == E.mid1) E.mid(acc, cur, t, wr, wc, fr, fq); }
            if constexpr (SP2) {
            unsigned on0[2], on1[2];
            on0[0] = GATHER ? (last ? gN[0][0] : gA[0][0]) : voffA[0]; on0[1] = GATHER ? (last ? gN[0][1] : gA[0][1]) : voffA[1];
            on1[0] = GATHER ? (last ? gN[1][0] : gA[1][0]) : voffA[0]; on1[1] = GATHER ? (last ? gN[1][1] : gA[1][1]) : voffA[1];
            PG8_LDB(B0, 0, 0); PG8_LDB(B1, 0, 1); PG8_SCHED; PG8_LDA(At, 0, 0); PG8_STAGE(PG8_SA(1, 1), a1 + hstepA, PG8_OA(1));
            PG8_WAIT_V(8); PG8_WAIT_L(0); PG8_BAR; PG8_MMA(0, 0, At, B0); PG8_MMA(0, 1, At, B1); PG8_BAR; PG8_SCHED;
            PG8_LDA(At, 0, 1); PG8_STAGE(PG8_SB(0, 0), b2, voffB); PG8_STAGE(PG8_SB(0, 1), b2 + hstep, voffB); PG8_STAGE(PG8_SA(0, 0), a2, on0);
            PG8_WAIT_V(8); PG8_WAIT_L(0); PG8_BAR; PG8_MMA(1, 0, At, B0); PG8_MMA(1, 1, At, B1); PG8_BAR; PG8_SCHED;
            PG8_LDB(B0, 1, 0); PG8_LDB(B1, 1, 1); PG8_SCHED; PG8_LDA(At, 1, 0); PG8_STAGE(PG8_SA(0, 1), a2 + hstepA, on1);
            PG8_WAIT_V(8); PG8_WAIT_L(0); PG8_BAR; PG8_MMA(0, 0, At, B0); PG8_MMA(0, 1, At, B1); PG8_BAR; PG8_SCHED;
            PG8_LDA(At, 1, 1); PG8_STAGE(PG8_SB(1, 0), b3, voffB); PG8_STAGE(PG8_SB(1, 1), b3 + hstep, voffB); PG8_STAGE(PG8_SA(1, 0), a3, on0);
            PG8_WAIT_V(8); PG8_WAIT_L(0); PG8_BAR; PG8_MMA(1, 0, At, B0); PG8_MMA(1, 1, At, B1); PG8_BAR; PG8_SCHED;
            } else {
            PG8_LDB(B0, 0, 0); PG8_SCHED; PG8_LDA(At, 0, 0); PG8_STAGE(PG8_SA(1, 1), a1 + hstep, voffA);
            PG8_WAIT_L(8); PG8_BAR; PG8_WAIT_L(0); PG8_MMA(0, 0, At, B0); PG8_BAR; PG8_SCHED;
            PG8_LDB(B1, 0, 1); PG8_STAGE(PG8_SB(0, 0), b2, voffB);
            PG8_BAR; PG8_WAIT_L(0); PG8_MMA(0, 1, At, B1); PG8_BAR;
            PG8_LDA(At, 0, 1); PG8_STAGE(PG8_SA(0, 0), a2, voffA);
            PG8_BAR; PG8_WAIT_L(0); PG8_MMA(1, 0, At, B0); PG8_BAR; PG8_SCHED;
            PG8_STAGE(PG8_SB(0, 1), b2 + hstep, voffB);
            PG8_WAIT_V(6); PG8_BAR; PG8_MMA(1, 1, At, B1); PG8_BAR;
            PG8_LDB(B0, 1, 0); PG8_SCHED; PG8_LDA(At, 1, 0); PG8_STAGE(PG8_SA(0, 1), a2 + hstep, voffA);
            PG8_WAIT_L(8); PG8_BAR; PG8_WAIT_L(0); PG8_MMA(0, 0, At, B0); PG8_BAR; PG8_SCHED;
            PG8_LDB(B1, 1, 1); PG8_STAGE(PG8_SB(1, 0), b3, voffB);
            PG8_BAR; PG8_WAIT_L(0); PG8_MMA(0, 1, At, B1); PG8_BAR;
            PG8_LDA(At, 1, 1); PG8_STAGE(PG8_SA(1, 0), a3, voffA);
            PG8_BAR; PG8_WAIT_L(0); PG8_MMA(1, 0, At, B0); PG8_BAR; PG8_SCHED;
            PG8_STAGE(PG8_SB(1, 1), b3 + hstep, voffB);
            PG8_WAIT_V(6); PG8_BAR; PG8_MMA(1, 1, At, B1); PG8_BAR;
            }
        }
        if constexpr (ALIGN_EPI) { if (wr == 0) PG8_BAR; }
        if constexpr (!Epi::AFTER_DRAIN) { E(acc, cur, wr, wc, fr, fq); S.done(cur); }
        if (!has_next) break;
#pragma unroll
        for (int a = 0; a < 2; ++a)
#pragma unroll
            for (int b = 0; b < 2; ++b)
#pragma unroll
                for (int m = 0; m < 4; ++m)
#pragma unroll
                    for (int n = 0; n < 2; ++n) acc[a][b][m][n] = (f32x4){0.f, 0.f, 0.f, 0.f};
        cur = nxt; cA = nA; cB = nB; ++ui;
        if constexpr (GATHER) { _Pragma("unroll") for (int h_ = 0; h_ < 2; ++h_) _Pragma("unroll") for (int i_ = 0; i_ < 2; ++i_) gA[h_][i_] = gN[h_][i_]; }
        if constexpr (ALIGN_EPI) { if (wr == 1) PG8_BAR; }
    }
    PG8_WAIT_V(0);
    if constexpr (!ALIGN_EPI) { if (wr == 0) PG8_BAR; }
    PG8_BAR;
    if constexpr (Epi::AFTER_DRAIN) { E.fused(acc, cur, wr, wc, fr, fq, lds, wid, lane); S.done(cur); }
#undef PG8_SA
#undef PG8_OA
#undef PG8_ROWS
#undef PG8_SB
#undef PG8_STAGE
#undef PG8_LDA
#undef PG8_LDB
#undef PG8_MMA
#undef PG8_WAIT_V
#undef PG8_WAIT_L
#undef PG8_BAR
#undef PG8_SCHED
}
}

#define DI __device__ __forceinline__
#define LAS __attribute__((address_space(3)))
typedef unsigned short bf16_t;
typedef float f32x4 __attribute__((ext_vector_type(4)));
typedef float f32x2 __attribute__((ext_vector_type(2)));
typedef float f32x16 __attribute__((ext_vector_type(16)));
typedef unsigned u32x4 __attribute__((ext_vector_type(4)));
typedef unsigned u32x2 __attribute__((ext_vector_type(2)));
typedef short bf16x8 __attribute__((ext_vector_type(8)));
typedef short s16x4 __attribute__((ext_vector_type(4)));
typedef __bf16 bf16x2_t __attribute__((ext_vector_type(2)));
using pg8::Unit;

constexpr int NB = 16, SEQ = 2048, DM = 1024, NTOK = NB * SEQ, NMEM = 256, NMROW = NB * NMEM;
constexpr float EPS = 1e-6f, LOG2E = 1.4426950408889634f;
constexpr float QSCALE_A = 0.125f * LOG2E, QSCALE_M = 0.08838834764831845f * LOG2E;
constexpr int MAXROWS = 73728, MAXTILES = MAXROWS / 256;

constexpr size_t MiB = 1u << 20;
constexpr size_t WS_CTL = 0, CTL_BYTES = 64 * 1024;
constexpr size_t WS_WIN = 1 * MiB, WS_WMKV = 17 * MiB, WS_WMRG = 19 * MiB, WS_WOUT = 22 * MiB;
constexpr size_t WS_ROPE = 24 * MiB, WS_WRH = 26 * MiB, WS_WRL = WS_WRH + 128 * 1024;
constexpr size_t WS_RT = 27 * MiB;
constexpr size_t RT_TOKE = 0, RT_RANK = 256 * 1024, RT_W = 512 * 1024, RT_RSTD = 768 * 1024, RT_CCNT = 896 * 1024, RT_META = 960 * 1024;
constexpr size_t WS_WGU = 28 * MiB, WS_WD = 92 * MiB;
constexpr size_t WS_Q = 124 * MiB, WS_K = 172 * MiB, WS_V = 220 * MiB, WS_U = 268 * MiB, WS_CB = 316 * MiB;
constexpr size_t WS_AM = 364 * MiB, WS_PO = 460 * MiB, WS_LSE = 508 * MiB, WS_SROW = 510 * MiB;
constexpr size_t WS_G = 124 * MiB;
constexpr size_t WS_MRG = 220 * MiB, WS_XB = 284 * MiB;
constexpr size_t SR_RSTD = 0, SR_DEST = 320 * 1024, SR_W = 640 * 1024;
constexpr size_t WS_HS = 124 * MiB, WS_ACT = 348 * MiB, WS_Y = 124 * MiB;
constexpr size_t WS_NEED = 512 * MiB;
constexpr size_t DO_H = 0, DO_HM = 64 * MiB, DO_QM = 72 * MiB, DO_KM = 104 * MiB, DO_VM = 108 * MiB;
constexpr int RING_BYTES = 131072, MISC_OFF = 131072, LDS_BYTES = 147456;

DI unsigned pk2(float lo, float hi) { f32x2 v = {lo, hi}; bf16x2_t b = __builtin_convertvector(v, bf16x2_t); return __builtin_bit_cast(unsigned, b); }
DI float bf_lo(unsigned u) { return __uint_as_float(u << 16); }
DI float bf_hi(unsigned u) { return __uint_as_float(u & 0xffff0000u); }
DI float bf2f(short s) { return __uint_as_float(((unsigned)(unsigned short)s) << 16); }
DI float fexp2(float x) { return __builtin_amdgcn_exp2f(x); }
DI float fexp(float x) { return __builtin_amdgcn_exp2f(x * LOG2E); }
DI float frcp(float x) { return __builtin_amdgcn_rcpf(x); }
DI u32x4 pack8(const f32x4& a, const f32x4& b) { u32x4 w; w.x = pk2(a.x, a.y); w.y = pk2(a.z, a.w); w.z = pk2(b.x, b.y); w.w = pk2(b.z, b.w); return w; }
DI void st16(void* p, const u32x4& v) { __builtin_nontemporal_store(v, (u32x4*)p); }
DI void st16f(void* p, const f32x4& v) { __builtin_nontemporal_store(v, (f32x4*)p); }
DI void st8(void* p, const u32x2& v) { __builtin_nontemporal_store(v, (u32x2*)p); }
DI void st16d(void* p, const u32x4& v) { *(u32x4*)p = v; }
DI void st8d(void* p, const u32x2& v) { *(u32x2*)p = v; }
DI int crow(int reg, int h) { return (reg & 3) + 8 * (reg >> 2) + 4 * h; }
DI float wave_sum(float v) {
#pragma unroll
    for (int o = 1; o < 64; o <<= 1) v += __shfl_xor(v, o);
    return v;
}
#define MFMA32(a, b, c) __builtin_amdgcn_mfma_f32_32x32x16_bf16((a), (b), (c), 0, 0, 0)
#define MFMA16(a, b, c) __builtin_amdgcn_mfma_f32_16x16x32_bf16((a), (b), (c), 0, 0, 0)

struct EpiIn {
    static constexpr bool PERM = true, AFTER_DRAIN = false, HAS_MID = false;
    unsigned char* wsb; bf16_t* QM; bf16_t* KMVM; const float *gq, *gk, *cs;
    DI void operator()(const pg8::f32x4 (&acc)[2][2][4][2], const Unit& u, int wr, int wc, int fr, int fq) const {
        const int t = u.pn, row0 = u.pm * 256 + wr * 64 + fr;
        if (t >= 32) {
            bf16_t* dst = KMVM + (t >= 34 ? (size_t)NMROW * 512 : 0);
            const int col = (t & 1) * 256 + wc * 32 + 8 * fq;
#pragma unroll
            for (int ai = 0; ai < 2; ++ai)
#pragma unroll
                for (int m = 0; m < 4; ++m) {
                    bf16_t* rp = dst + (size_t)(row0 - NTOK + ai * 128 + m * 16) * 512 + col;
#pragma unroll
                    for (int bj = 0; bj < 2; ++bj) st16(rp + 128 * bj, pack8(acc[ai][bj][m][0], acc[ai][bj][m][1]));
                }
        } else if (t < 6) {
            const bool isq = t < 3; bf16_t* dst = (bf16_t*)(wsb + (isq ? WS_Q : WS_K)); const float* g = isq ? gq : gk; const float osc = isq ? QSCALE_A : 1.f;
            const int head = 4 * (isq ? t : t - 3) + wc;
            f32x4 gv[2][2];
#pragma unroll
            for (int bj = 0; bj < 2; ++bj)
#pragma unroll
                for (int n = 0; n < 2; ++n) gv[bj][n] = *(const f32x4*)(g + 32 * bj + 8 * fq + 4 * n) * osc;
#pragma unroll
            for (int ai = 0; ai < 2; ++ai) {
#pragma unroll
              for (int mp = 0; mp < 2; ++mp) {
                f32x4 csv[4][4];
#pragma unroll
                for (int m2 = 0; m2 < 2; ++m2) { const float* cr = cs + (size_t)(row0 + ai * 128 + (2 * mp + m2) * 16) * 16;
#pragma unroll
                    for (int q = 0; q < 4; ++q) csv[2 * mp + m2][q] = *(const f32x4*)(cr + 4 * q); }
#pragma unroll
                for (int m = 2 * mp; m < 2 * mp + 2; ++m) {
                    const int row = row0 + ai * 128 + m * 16;
                    float ss = 0.f;
#pragma unroll
                    for (int bj = 0; bj < 2; ++bj)
#pragma unroll
                        for (int n = 0; n < 2; ++n) { const f32x4 x = acc[ai][bj][m][n]; ss += (x.x * x.x + x.y * x.y) + (x.z * x.z + x.w * x.w); }
                    ss += __shfl_xor(ss, 16); ss += __shfl_xor(ss, 32);
                    const float rstd = __builtin_amdgcn_rsqf(ss * (1.f / 64.f) + EPS);
                    f32x4 v[2][2];
#pragma unroll
                    for (int bj = 0; bj < 2; ++bj)
#pragma unroll
                        for (int n = 0; n < 2; ++n) v[bj][n] = acc[ai][bj][m][n] * rstd * gv[bj][n];
                    f32x4 p0, p1;
#pragma unroll
                    for (int c = 0; c < 4; ++c) { p0[c] = __shfl_xor(v[0][0][c], 16); p1[c] = __shfl_xor(v[0][1][c], 16); }
                    if (fq < 2) {
                        const f32x4 c0 = csv[m][0], c1 = csv[m][1], s0 = csv[m][2], s1 = csv[m][3];
                        if (fq == 0) { v[0][0] = v[0][0] * c0 - p0 * s0; v[0][1] = v[0][1] * c1 - p1 * s1; }
                        else         { v[0][0] = v[0][0] * c0 + p0 * s0; v[0][1] = v[0][1] * c1 + p1 * s1; }
                    }
                    bf16_t* rp = dst + (size_t)row * 768 + head * 64 + 8 * fq;
#pragma unroll
                    for (int bj = 0; bj < 2; ++bj) st16(rp + 32 * bj, pack8(v[bj][0], v[bj][1]));
                }
                asm volatile("" ::: "memory");
              }
            }
        } else if (t >= 9 && t < 15) {
            bf16_t* U = (bf16_t*)(wsb + WS_U);
            const int c0 = (t - 9) * 128 + wc * 32 + 8 * fq;
#pragma unroll
            for (int ai = 0; ai < 2; ++ai)
#pragma unroll
                for (int m = 0; m < 4; ++m) {
                    const int row = row0 + ai * 128 + m * 16;
                    st16(U + (size_t)row * 768 + c0, pack8(acc[ai][0][m][0] * acc[ai][1][m][0], acc[ai][0][m][1] * acc[ai][1][m][1]));
                }
        } else {
            if (t >= 18) {
                const int col = (t - 18) * 256 + wc * 32 + 8 * fq;
#pragma unroll
                for (int ai = 0; ai < 2; ++ai)
#pragma unroll
                    for (int m = 0; m < 4; ++m) {
                        bf16_t* rp = QM + (size_t)(row0 + ai * 128 + m * 16) * 512 + col;
#pragma unroll
                        for (int bj = 0; bj < 2; ++bj) st16(rp + 128 * bj, pack8(acc[ai][bj][m][0], acc[ai][bj][m][1]));
                    }
            } else {
                bf16_t* dst = (bf16_t*)(wsb + (t < 9 ? WS_V : WS_CB));
                const int col = (t < 9 ? t - 6 : t - 15) * 256 + wc * 32 + 8 * fq;
#pragma unroll
                for (int ai = 0; ai < 2; ++ai)
#pragma unroll
                    for (int m = 0; m < 4; ++m) {
                        bf16_t* rp = dst + (size_t)(row0 + ai * 128 + m * 16) * 768 + col;
#pragma unroll
                        for (int bj = 0; bj < 2; ++bj) st16(rp + 128 * bj, pack8(acc[ai][bj][m][0], acc[ai][bj][m][1]));
                    }
            }
        }
    }
};

DI float sigm(float x) { return frcp(1.f + fexp(-fminf(fmaxf(x, -60.f), 60.f))); }
DI f32x4 sigm4(const f32x4& v) { f32x4 r; r.x = sigm(v.x); r.y = sigm(v.y); r.z = sigm(v.z); r.w = sigm(v.w); return r; }
DI unsigned gq1(float x) { return (unsigned)fminf(fmaxf(__builtin_rintf(sigm(x) * 255.f), 1.f), 255.f); }
DI unsigned gq4(const f32x4& v) { return gq1(v.x) | (gq1(v.y) << 8) | (gq1(v.z) << 16) | (gq1(v.w) << 24); }
DI float ub(unsigned w, int k) { return (float)((w >> (8 * k)) & 0xffu); }
struct EpiGate {
    static constexpr bool PERM = true, AFTER_DRAIN = false, HAS_MID = false;
    unsigned char* O; int ld;
    DI void operator()(const pg8::f32x4 (&acc)[2][2][4][2], const Unit& u, int wr, int wc, int fr, int fq) const {
        const int row0 = u.pm * 256 + wr * 64 + fr, col = u.pn * 256 + wc * 64 + 16 * fq;
#pragma unroll
        for (int ai = 0; ai < 2; ++ai)
#pragma unroll
            for (int m = 0; m < 4; ++m) {
                u32x4 w; w.x = gq4(acc[ai][0][m][0]); w.y = gq4(acc[ai][0][m][1]); w.z = gq4(acc[ai][1][m][0]); w.w = gq4(acc[ai][1][m][1]);
                st16d(O + (size_t)(row0 + ai * 128 + m * 16) * ld + col, w);
            }
    }
};

struct EpiMerge {
    static constexpr bool PERM = true, AFTER_DRAIN = false, HAS_MID = true;
    const unsigned char* G; bf16_t* O; int mid0, mid1;
    DI void mid(pg8::f32x4 (&acc)[2][2][4][2], const Unit& u, int t, int wr, int wc, int fr, int fq) const {
        const int ga = (t == mid0) ? 0 : 1;
        int row0 = u.pm * 256 + wr * 64 + fr; const int col = u.pn * 256 + wc * 64 + 16 * fq;
        asm volatile("" : "+v"(row0));
        u32x4 la[2][4], lb[2][4];
#pragma unroll
        for (int ai = 0; ai < 2; ++ai)
#pragma unroll
            for (int m = 0; m < 4; ++m) { const unsigned char* gp = G + (size_t)(row0 + ai * 128 + m * 16) * 3072 + ga * 1024 + col; la[ai][m] = *(const u32x4*)gp; lb[ai][m] = *(const u32x4*)(gp + 1024); }
#pragma unroll
        for (int ai = 0; ai < 2; ++ai)
#pragma unroll
            for (int m = 0; m < 4; ++m)
#pragma unroll
                for (int bj = 0; bj < 2; ++bj)
#pragma unroll
                    for (int n = 0; n < 2; ++n)
#pragma unroll
                        for (int c = 0; c < 4; ++c) acc[ai][bj][m][n][c] *= ub(la[ai][m][2 * bj + n], c) * frcp(ub(lb[ai][m][2 * bj + n], c));
        asm volatile("" ::: "memory");
    }
    DI void operator()(const pg8::f32x4 (&acc)[2][2][4][2], const Unit& u, int wr, int wc, int fr, int fq) const {
        const int row0 = u.pm * 256 + wr * 64 + fr, col = u.pn * 256 + wc * 64 + 16 * fq;
        u32x4 lq[2][4];
#pragma unroll
        for (int ai = 0; ai < 2; ++ai)
#pragma unroll
            for (int m = 0; m < 4; ++m) lq[ai][m] = *(const u32x4*)(G + (size_t)(row0 + ai * 128 + m * 16) * 3072 + 2048 + col);
#pragma unroll
        for (int ai = 0; ai < 2; ++ai)
#pragma unroll
            for (int m = 0; m < 4; ++m) {
                const size_t row = (size_t)(row0 + ai * 128 + m * 16);
#pragma unroll
                for (int bj = 0; bj < 2; ++bj) {
                    const float k = 1.f / 255.f; const unsigned q0 = lq[ai][m][2 * bj], q1 = lq[ai][m][2 * bj + 1];
                    const f32x4 g0 = {ub(q0, 0) * k, ub(q0, 1) * k, ub(q0, 2) * k, ub(q0, 3) * k}, g1 = {ub(q1, 0) * k, ub(q1, 1) * k, ub(q1, 2) * k, ub(q1, 3) * k};
                    st16d(O + row * 1024 + col + 8 * bj, pack8(acc[ai][bj][m][0] * g0, acc[ai][bj][m][1] * g1));
                }
            }
    }
};

struct EpiOut {
    static constexpr bool PERM = true, AFTER_DRAIN = false, HAS_MID = false;
    const float* X; float* O; bf16_t* XB;
    DI void operator()(const pg8::f32x4 (&acc)[2][2][4][2], const Unit& u, int wr, int wc, int fr, int fq) const {
        const int row0 = u.pm * 256 + wr * 64 + fr, col = u.pn * 256 + wc * 32 + 8 * fq;
#pragma unroll
        for (int ai = 0; ai < 2; ++ai)
#pragma unroll
            for (int m = 0; m < 4; ++m) {
                const size_t off = (size_t)(row0 + ai * 128 + m * 16) * 1024 + col;
#pragma unroll
                for (int bj = 0; bj < 2; ++bj) {
                    const f32x4 o0 = *(const f32x4*)(X + off + 128 * bj) + acc[ai][bj][m][0], o1 = *(const f32x4*)(X + off + 128 * bj + 4) + acc[ai][bj][m][1];
                    st16d(XB + off + 128 * bj, pack8(o0, o1));
                }
            }
    }
};

struct EpiUp {
    static constexpr bool PERM = true, AFTER_DRAIN = false, HAS_MID = false;
    const float* rstd; bf16_t* ACT;
    DI void operator()(const pg8::f32x4 (&acc)[2][2][4][2], const Unit& u, int wr, int wc, int fr, int fq) const {
        const int row0 = u.pm * 256 + wr * 64 + fr, col = u.aux * 128 + wc * 32 + 8 * fq;
#pragma unroll
        for (int ai = 0; ai < 2; ++ai)
#pragma unroll
            for (int m = 0; m < 4; ++m) {
                const int row = row0 + ai * 128 + m * 16; const float rs = rstd[row];
                f32x4 o[2];
#pragma unroll
                for (int n = 0; n < 2; ++n)
#pragma unroll
                    for (int c = 0; c < 4; ++c) { const float a = acc[ai][0][m][n][c] * rs, b = acc[ai][1][m][n][c] * rs; o[n][c] = a * b * frcp(1.f + fexp(-a)); }
                st16d(ACT + (size_t)row * 512 + col, pack8(o[0], o[1]));
            }
    }
};

struct EpiDown {
    static constexpr bool PERM = true, AFTER_DRAIN = false, HAS_MID = false;
    const u32x2* dw; bf16_t* Y;
    DI void operator()(const pg8::f32x4 (&acc)[2][2][4][2], const Unit& u, int wr, int wc, int fr, int fq) const {
        const int row0 = u.pm * 256 + wr * 64 + fr, col = u.aux * 256 + wc * 32 + 8 * fq;
#pragma unroll
        for (int ai = 0; ai < 2; ++ai)
#pragma unroll
            for (int m = 0; m < 4; ++m) {
                const int row = row0 + ai * 128 + m * 16; const u32x2 rec = dw[row]; const int d = (int)rec.x;
                if (d >= 0) { const float ww = __uint_as_float(rec.y); bf16_t* rp = Y + (size_t)d * 1024 + col;
#pragma unroll
                    for (int bj = 0; bj < 2; ++bj) st16d(rp + 128 * bj, pack8(acc[ai][bj][m][0] * ww, acc[ai][bj][m][1] * ww)); }
            }
    }
};

struct InOrder {
    static constexpr bool GATHER = false; DI int row(int, int) const { return 0; }
    pg8::StaticOrder so; int nmain;
    DI bool next(int i, Unit& u) const {
        const long L = (long)i * so.G + so.c;
        if (L < nmain) return so.next(i, u);
        const int idx = (int)(L - nmain); if (idx >= 64) return false;
        u.pm = NTOK / 256 + (idx >> 2); u.pn = 32 + (idx & 3); u.aux = u.pn; return true;
    }
    DI void a_ready(const Unit&) const {}
    DI void done(const Unit&) const {}
};
template <bool GATHER_> struct MoeOrder {
    static constexpr bool GATHER = GATHER_;
    const LAS int* tile_exp; int ntiles, G, c; const LAS int* rowtab;
    DI int row(int ui, int r) const { return rowtab[ui * 256 + r]; }
    DI bool next(int i, Unit& u) const {
        const int nwg = ntiles * 4; const long L = (long)i * G + c; if (L >= nwg) return false;
        int wgid = (int)L; { const int q = nwg / 8, r = nwg % 8, xcd = wgid % 8, off = wgid / 8; wgid = (xcd < r ? xcd * (q + 1) : r * (q + 1) + (xcd - r) * q) + off; }
        u.pm = wgid >> 2; u.aux = wgid & 3; u.pn = tile_exp[u.pm] * 4 + u.aux; return true;
    }
    DI void a_ready(const Unit&) const {}
    DI void done(const Unit&) const {}
};

struct Args { const void* in[24]; float* out; unsigned char* ws; int ph_lo, ph_hi; };
enum { I_X = 0, I_MEM, I_POS, I_GMIX, I_GMEM, I_WIN, I_GQA, I_GKA, I_WCONV, I_WMKV, I_GQM, I_GKM, I_WPA, I_WPC, I_WPM, I_WOUT, I_GFFN, I_WRG, I_BRG, I_WRE, I_BRE, I_WGATE, I_WUP, I_WDOWN };

DI void transpose_item(const float* src, int ldsrc, int k0, int col0, bf16_t* dst, int lddst, int drow0, int dk0, const float* kgain, LAS float* scr, int lane, bool gmode = false) {
    (void)scr;
    const int kg = lane >> 3, nq = lane & 7;
    const float* sp = src + (size_t)(k0 + 8 * kg) * ldsrc + col0 + (gmode ? 16 * (nq >> 1) + 4 * (nq & 1) : 4 * nq);
    f32x4 v[8];
#pragma unroll
    for (int j = 0; j < 8; ++j) v[j] = *(const f32x4*)(sp + (size_t)j * ldsrc);
    if (kgain) { const f32x4 g0 = *(const f32x4*)(kgain + k0 + 8 * kg), g1 = *(const f32x4*)(kgain + k0 + 8 * kg + 4);
        v[0] *= g0.x; v[1] *= g0.y; v[2] *= g0.z; v[3] *= g0.w; v[4] *= g1.x; v[5] *= g1.y; v[6] *= g1.z; v[7] *= g1.w; }
    bf16_t* dp = dst + (size_t)(drow0 + 4 * nq) * lddst + dk0 + 8 * kg;
#pragma unroll
    for (int q = 0; q < 4; ++q) { u32x4 o; o.x = pk2(v[0][q], v[1][q]); o.y = pk2(v[2][q], v[3][q]); o.z = pk2(v[4][q], v[5][q]); o.w = pk2(v[6][q], v[7][q]);
        *(u32x4*)(dp + (size_t)q * lddst) = o; }
}
DI int gperm_col0(int c) { return 64 * ((c >> 5) & 3) + 8 * (c >> 7); }
DI int in_orig_col(int n0) {
    const int t = n0 >> 8, c = n0 & 255;
    if (t < 3)  return (4 * t + ((c >> 5) & 3)) * 64 + 32 * (c >> 7) + (c & 31);
    if (t < 6)  return 768 + (4 * (t - 3) + ((c >> 5) & 3)) * 64 + 32 * (c >> 7) + (c & 31);
    if (t < 9)  return 1536 + (t - 6) * 256 + c;
    if (t < 15) return (c < 128) ? 2304 + 128 * (t - 9) + c : 3840 + 128 * (t - 9) + c - 128;
    if (t < 18) return 3072 + (t - 15) * 256 + c;
    if (t < 20) return 4608 + (t - 18) * 256 + c;
    return 5120 + (t - 20) * 256 + gperm_col0(c);
}
DI void rms_row_to_bf16(const float* xrow, const float* g, bf16_t* orow, int lane) {
    const f32x4* xr = (const f32x4*)xrow + lane; const f32x4* gr = (const f32x4*)g + lane;
    f32x4 v[4]; float s = 0.f;
#pragma unroll
    for (int j = 0; j < 4; ++j) { v[j] = xr[64 * j]; s += (v[j].x * v[j].x + v[j].y * v[j].y) + (v[j].z * v[j].z + v[j].w * v[j].w); }
    const float rstd = __builtin_amdgcn_rsqf(wave_sum(s) * (1.f / 1024.f) + EPS);
    u32x2* o8 = (u32x2*)orow + lane;
#pragma unroll
    for (int j = 0; j < 4; ++j) { const f32x4 gg = gr[64 * j]; u32x2 w; w.x = pk2(v[j].x * rstd * gg.x, v[j].y * rstd * gg.y); w.y = pk2(v[j].z * rstd * gg.z, v[j].w * rstd * gg.w); o8[64 * j] = w; }
}

DI void phase0(const Args& a, LAS unsigned char* lds, int tid, int lane, int wave) {
    const int gw = blockIdx.x * 8 + wave, NGW = gridDim.x * 8;
    LAS float* scr = (LAS float*)(lds + wave * 16384);
    unsigned char* ws = a.ws; unsigned char* dob = (unsigned char*)a.out;
    bf16_t* Wt_in = (bf16_t*)(ws + WS_WIN); bf16_t* Wt_mkv = (bf16_t*)(ws + WS_WMKV); bf16_t* Wt_mrg = (bf16_t*)(ws + WS_WMRG); bf16_t* Wt_out = (bf16_t*)(ws + WS_WOUT);
    constexpr int I_IN = 16 * 256, I_MKV = 16 * 32, I_PA = 4 * 32, I_PC = 12 * 32, I_PM = 8 * 32, I_OUT = 16 * 32;
    constexpr int NITEMS = I_IN + I_MKV + I_PA + I_PC + I_PM + I_OUT;
    for (int it = gw; it < NITEMS; it += NGW) {
        int r = it;
        if (r < I_IN) { const int kb = r >> 8, nb = r & 255; transpose_item((const float*)a.in[I_WIN], 8192, kb * 64, in_orig_col(nb * 32), Wt_in, 1024, nb * 32, kb * 64, nullptr, scr, lane, nb >= 160); continue; } r -= I_IN;
        if (r < I_MKV) { const int kb = r >> 5, nb = r & 31; transpose_item((const float*)a.in[I_WMKV], 1024, kb * 64, nb * 32, Wt_mkv, 1024, nb * 32, kb * 64, nullptr, scr, lane); continue; } r -= I_MKV;
        if (r < I_PA) { const int kb = r >> 5, nb = r & 31; transpose_item((const float*)a.in[I_WPA], 1024, kb * 64, (nb >> 3) * 256 + gperm_col0((nb & 7) * 32), Wt_mrg, 1536, nb * 32, kb * 64, nullptr, scr, lane, true); continue; } r -= I_PA;
        if (r < I_PC) { const int kb = r >> 5, nb = r & 31; transpose_item((const float*)a.in[I_WPC], 1024, kb * 64, (nb >> 3) * 256 + gperm_col0((nb & 7) * 32), Wt_mrg, 1536, nb * 32, 256 + kb * 64, nullptr, scr, lane, true); continue; } r -= I_PC;
        if (r < I_PM) { const int kb = r >> 5, nb = r & 31; transpose_item((const float*)a.in[I_WPM], 1024, kb * 64, (nb >> 3) * 256 + gperm_col0((nb & 7) * 32), Wt_mrg, 1536, nb * 32, 1024 + kb * 64, nullptr, scr, lane, true); continue; } r -= I_PM;
        { const int kb = r >> 5, nb = r & 31; transpose_item((const float*)a.in[I_WOUT], 1024, kb * 64, nb * 32, Wt_out, 1024, nb * 32, kb * 64, nullptr, scr, lane); }
    }
    { const float* x = (const float*)a.in[I_X]; const float* g = (const float*)a.in[I_GMIX]; bf16_t* H = (bf16_t*)(dob + DO_H);
      const f32x4* gr = (const f32x4*)g + lane; f32x4 gg[4];
#pragma unroll
      for (int j = 0; j < 4; ++j) gg[j] = gr[64 * j];
      for (int m0 = 4 * gw; m0 < NTOK; m0 += 4 * NGW) {
          f32x4 v[4][4];
#pragma unroll
          for (int r = 0; r < 4; ++r)
#pragma unroll
              for (int j = 0; j < 4; ++j) v[r][j] = ((const f32x4*)(x + (size_t)(m0 + r) * 1024) + lane)[64 * j];
#pragma unroll
          for (int r = 0; r < 4; ++r) {
              float s = 0.f;
#pragma unroll
              for (int j = 0; j < 4; ++j) s += (v[r][j].x * v[r][j].x + v[r][j].y * v[r][j].y) + (v[r][j].z * v[r][j].z + v[r][j].w * v[r][j].w);
              const float rstd = __builtin_amdgcn_rsqf(wave_sum(s) * (1.f / 1024.f) + EPS);
              u32x2* o8 = (u32x2*)(H + (size_t)(m0 + r) * 1024) + lane;
#pragma unroll
              for (int j = 0; j < 4; ++j) { u32x2 w; w.x = pk2(v[r][j].x * rstd * gg[j].x, v[r][j].y * rstd * gg[j].y); w.y = pk2(v[r][j].z * rstd * gg[j].z, v[r][j].w * rstd * gg[j].w); o8[64 * j] = w; }
          }
      } }
    { const float* x = (const float*)a.in[I_MEM]; const float* g = (const float*)a.in[I_GMEM]; bf16_t* H = (bf16_t*)(dob + DO_HM);
      for (int m = gw; m < NMROW; m += NGW) rms_row_to_bf16(x + (size_t)m * 1024, g, H + (size_t)m * 1024, lane); }
    const int gt = blockIdx.x * 512 + tid, NT = gridDim.x * 512;
    { const float* wrg = (const float*)a.in[I_WRG]; const float* wre = (const float*)a.in[I_WRE]; const float* gf = (const float*)a.in[I_GFFN];
      bf16_t* WH = (bf16_t*)(ws + WS_WRH); bf16_t* WL = (bf16_t*)(ws + WS_WRL);
      for (int idx = gt; idx < 48 * 1024; idx += NT) { const int n = idx >> 10, k = idx & 1023;
          float v = 0.f; if (n < 4) v = wrg[k * 4 + n] * gf[k]; else if (n < 36) v = wre[k * 32 + (n - 4)] * gf[k];
          const unsigned hi = pk2(v, 0.f) & 0xffffu; const float lo = v - __uint_as_float(hi << 16);
          WH[idx] = (bf16_t)hi; WL[idx] = (bf16_t)(pk2(lo, 0.f) & 0xffffu); } }
    { const int* pos = (const int*)a.in[I_POS]; float* cs = (float*)(ws + WS_ROPE);
      for (int idx = gt; idx < NTOK * 8; idx += NT) { const int row = idx >> 3, j = idx & 7;
          const double inv = exp2(-(double)j * (18.931568569324174 / 8.0));
          const float invf = (float)inv; const float ang = (float)pos[row] * invf;
          const double ad = (double)ang; cs[row * 16 + j] = (float)cos(ad); cs[row * 16 + 8 + j] = (float)sin(ad); } }
}

typedef short v4i16_t __attribute__((ext_vector_type(4)));
DI s16x4 vtr(const LAS unsigned char* p) { return __builtin_bit_cast(s16x4, __builtin_amdgcn_ds_read_tr16_b64_v4i16((LAS v4i16_t*)p)); }

DI int kimg64(int slot, int c16) { return slot * 128 + ((c16 ^ ((slot >> 1) & 7)) << 4); }
DI int img256(int row, int ch) { return row * 256 + ((ch ^ (((row & 3) << 2) | ((row >> 2) & 3))) << 4); }
constexpr int A_VOFF = 49152, A_VS = 192;
constexpr int M_VOFF = 65536;

struct AUnit { int b, head, gi, hs, dl, L, j, Q0; size_t rowb; };
DI AUnit a_decode(int wu) {
    AUnit u; const int blk8 = wu & 7; const int bh = wu >> 3; u.head = bh % 12; u.b = bh / 12; u.gi = u.head >> 2; u.hs = u.head & 3;
    u.dl = (u.gi == 0) ? 1 : (u.gi == 1) ? 4 : 16; u.L = SEQ / u.dl;
    if (u.gi < 2) { const int npj = u.L >> 8; u.j = blk8 / npj; u.Q0 = (blk8 % npj) << 8; } else { u.j = 2 * blk8; u.Q0 = 0; }
    u.rowb = (size_t)u.b * SEQ; return u;
}
DI void a_wave_geom(const AUnit& u, int wave, int& qsub, int& kj_first, int& slot_first, int& jq) {
    jq = u.j;
    if (u.gi < 2) { qsub = u.Q0 + 32 * wave; kj_first = qsub - 64; slot_first = 32 * wave; }
    else { const int sub = wave >> 2; jq = u.j + sub; qsub = 32 * (wave & 3); kj_first = qsub - 64; slot_first = sub * 128 + kj_first; }
}
DI void a_issue(const AUnit& u, const bf16_t* Q, const bf16_t* K, const bf16_t* V, int tid, int lane, int wave, u32x4 (&kv)[6], u32x4 (&vv)[6], unsigned& okm, bf16x8 (&qf)[4]) {
    const int nsl = (u.gi < 2) ? 384 : 256; okm = 0u;
#pragma unroll
    for (int i = 0; i < 6; ++i) {
        const int p = tid + i * 512, slot = p >> 3, c16 = p & 7; size_t row; bool ok = slot < nsl;
        if (u.gi < 2) { const int kj = u.Q0 - 64 + slot; ok = ok && (kj >= 0 && kj < u.L); row = u.rowb + (size_t)kj * u.dl + u.j; }
        else { row = u.rowb + (size_t)(slot & 127) * 16 + u.j + (slot >> 7); }
        if (ok) { kv[i] = *(const u32x4*)(K + row * 768 + u.head * 64 + c16 * 8); vv[i] = *(const u32x4*)(V + row * 768 + u.head * 64 + c16 * 8); okm |= 1u << i; }
    }
    int qsub, kj_first, slot_first, jq; a_wave_geom(u, wave, qsub, kj_first, slot_first, jq);
    const size_t rowq = u.rowb + (size_t)(qsub + (lane & 31)) * u.dl + jq;
    const bf16_t* qrow = Q + rowq * 768 + u.head * 64;
#pragma unroll
    for (int s = 0; s < 4; ++s) qf[s] = *(const bf16x8*)(qrow + 16 * s + 8 * (lane >> 5));
}
DI void a_fill(LAS unsigned char* lds, int tid, const u32x4 (&kv)[6], const u32x4 (&vv)[6], unsigned okm) {
#pragma unroll
    for (int i = 0; i < 6; ++i) { const int p = tid + i * 512, slot = p >> 3, c16 = p & 7;
        if (okm & (1u << i)) { *(LAS u32x4*)(lds + kimg64(slot, c16)) = kv[i]; *(LAS u32x4*)(lds + A_VOFF + slot * A_VS + c16 * 16) = vv[i]; } }
}
DI void a_compute(const AUnit& u, const bf16x8 (&qf)[4], bf16_t* PO, float* LSE, LAS unsigned char* lds, int lane, int wave) {
    const int gi = u.gi, hs = u.hs, dl = u.dl, L = u.L; const size_t rowb = u.rowb;
    const int r32 = lane & 31, h = lane >> 5;
    int qsub, kj_first, slot_first, jq; a_wave_geom(u, wave, qsub, kj_first, slot_first, jq);
    const size_t rowq = rowb + (size_t)(qsub + r32) * dl + jq;
    f32x16 o[2];
#pragma unroll
    for (int dt = 0; dt < 2; ++dt)
#pragma unroll
        for (int r = 0; r < 16; ++r) o[dt][r] = 0.f;
    float m = -INFINITY, lp = 0.f;
    const int q4 = (lane & 15) >> 2, p4 = lane & 3, blk = (lane >> 4) & 1;
    const int troff = (4 * h + q4) * A_VS + blk * 32 + p4 * 8;
#pragma unroll
    for (int ci = 0; ci < 5; ++ci) {
        const int c = (ci == 0 ? 2 : ci == 1 ? 1 : ci == 2 ? 3 : ci == 3 ? 0 : 4);
        const int kj = kj_first + 32 * c;
        if (kj < 0 || kj >= L) continue;
        const int slot0 = slot_first + 32 * c, ks = slot0 + r32;
        const LAS unsigned char* kp = lds + ks * 128; const int kx = (ks >> 1) & 7;
        f32x16 S;
        const float ninit = (ci == 0) ? 0.f : -m;
#pragma unroll
        for (int r = 0; r < 16; ++r) S[r] = ninit;
#pragma unroll
        for (int s = 0; s < 4; ++s) { const bf16x8 kf = *(const LAS bf16x8*)(kp + (((2 * s + h) ^ kx) << 4)); S = MFMA32(kf, qf[s], S); }
        if (c == 0) {
#pragma unroll
            for (int r = 0; r < 16; ++r) if (crow(r, h) < r32) S[r] = -INFINITY;
        }
        if (c == 4) {
#pragma unroll
            for (int r = 0; r < 16; ++r) if (crow(r, h) > r32) S[r] = -INFINITY;
        }
        float mx = S[0];
#pragma unroll
        for (int r = 1; r < 16; ++r) mx = fmaxf(mx, S[r]);
        mx = fmaxf(mx, __shfl_xor(mx, 32));
        if (ci == 0 || __builtin_amdgcn_ballot_w64(mx > 8.f) != 0ull) {
            const float d = (ci == 0) ? mx : fmaxf(mx, 0.f), al = fexp2(-d);
            m = ((ci == 0) ? 0.f : m) + d; lp *= al;
#pragma unroll
            for (int r = 0; r < 16; ++r) S[r] -= d;
#pragma unroll
            for (int dt = 0; dt < 2; ++dt)
#pragma unroll
                for (int r = 0; r < 16; ++r) o[dt][r] *= al;
        }
        float rsum = 0.f;
#pragma unroll
        for (int r = 0; r < 16; ++r) { S[r] = fexp2(S[r]); rsum += S[r]; }
        lp += rsum;
        bf16x8 pb[2];
#pragma unroll
        for (int s2 = 0; s2 < 2; ++s2) { u32x4 w; w.x = pk2(S[8 * s2], S[8 * s2 + 1]); w.y = pk2(S[8 * s2 + 2], S[8 * s2 + 3]); w.z = pk2(S[8 * s2 + 4], S[8 * s2 + 5]); w.w = pk2(S[8 * s2 + 6], S[8 * s2 + 7]); pb[s2] = __builtin_bit_cast(bf16x8, w); }
        const LAS unsigned char* trp = lds + A_VOFF + slot0 * A_VS + troff;
#pragma unroll
        for (int dt = 0; dt < 2; ++dt)
#pragma unroll
            for (int s2 = 0; s2 < 2; ++s2) {
                const s16x4 lo = vtr(trp + (16 * s2) * A_VS + dt * 64), hi = vtr(trp + (16 * s2 + 8) * A_VS + dt * 64);
                const bf16x8 va = __builtin_shufflevector(lo, hi, 0, 1, 2, 3, 4, 5, 6, 7);
                o[dt] = MFMA32(va, pb[s2], o[dt]);
            }
    }
    const float l = lp + __shfl_xor(lp, 32), inv = 1.f / l;
    if (h == 0) LSE[((size_t)gi * NTOK + rowq) * 4 + hs] = m + __builtin_amdgcn_logf(l);
    __syncthreads();
    { LAS unsigned char* ot = lds + wave * 4096;
#pragma unroll
      for (int dt = 0; dt < 2; ++dt)
#pragma unroll
          for (int g4 = 0; g4 < 4; ++g4) { u32x2 w; w.x = pk2(o[dt][4 * g4] * inv, o[dt][4 * g4 + 1] * inv); w.y = pk2(o[dt][4 * g4 + 2] * inv, o[dt][4 * g4 + 3] * inv);
              *(LAS u32x2*)(ot + r32 * 128 + (32 * dt + 8 * g4 + 4 * h) * 2) = w; }
      asm volatile("s_waitcnt lgkmcnt(0)" ::: "memory");
#pragma unroll
      for (int i = 0; i < 4; ++i) { const int q = i * 8 + (lane >> 3), c16 = lane & 7;
          const u32x4 w = *(const LAS u32x4*)(ot + q * 128 + c16 * 16);
          const size_t rq = rowb + (size_t)(qsub + q) * dl + jq;
          *(u32x4*)(PO + ((size_t)gi * NTOK + rq) * 256 + hs * 64 + c16 * 8) = w; }
    }
    __syncthreads();
}


DI void attnM_wg(int wu, const bf16_t* QM, const bf16_t* KM, const bf16_t* VM, const float* gqm, const float* gkm, bf16_t* AM, LAS unsigned char* lds, int tid, int lane, int wave) {
    const int qblk = wu & 7, head = (wu >> 3) & 3, b = wu >> 5;
    { const bf16_t* kb = KM + (size_t)b * NMEM * 512 + head * 128; const bf16_t* vb = VM + (size_t)b * NMEM * 512 + head * 128;
      u32x4 kv[8], vv[8];
#pragma unroll
      for (int i = 0; i < 8; ++i) { const int p = tid + i * 512, row = p >> 4, ch = p & 15;
          kv[i] = *(const u32x4*)(kb + (size_t)row * 512 + ch * 8); vv[i] = *(const u32x4*)(vb + (size_t)row * 512 + ch * 8); }
      const int chl = tid & 15; const f32x4 g0 = *(const f32x4*)(gkm + chl * 8), g1 = *(const f32x4*)(gkm + chl * 8 + 4);
#pragma unroll
      for (int i = 0; i < 8; ++i) { const int p = tid + i * 512, row = p >> 4, ch = p & 15;
          float x[8]; x[0] = bf_lo(kv[i].x); x[1] = bf_hi(kv[i].x); x[2] = bf_lo(kv[i].y); x[3] = bf_hi(kv[i].y); x[4] = bf_lo(kv[i].z); x[5] = bf_hi(kv[i].z); x[6] = bf_lo(kv[i].w); x[7] = bf_hi(kv[i].w);
          float ss = (x[0] * x[0] + x[1] * x[1]) + (x[2] * x[2] + x[3] * x[3]) + (x[4] * x[4] + x[5] * x[5]) + (x[6] * x[6] + x[7] * x[7]);
          ss += __shfl_xor(ss, 1); ss += __shfl_xor(ss, 2); ss += __shfl_xor(ss, 4); ss += __shfl_xor(ss, 8);
          const float rs = __builtin_amdgcn_rsqf(ss * (1.f / 128.f) + EPS);
          u32x4 kn; kn.x = pk2(x[0] * rs * g0.x, x[1] * rs * g0.y); kn.y = pk2(x[2] * rs * g0.z, x[3] * rs * g0.w); kn.z = pk2(x[4] * rs * g1.x, x[5] * rs * g1.y); kn.w = pk2(x[6] * rs * g1.z, x[7] * rs * g1.w);
          const int off = img256(row, ch); *(LAS u32x4*)(lds + off) = kn; *(LAS u32x4*)(lds + M_VOFF + off) = vv[i]; } }
    __syncthreads();
    const int r32 = lane & 31, h = lane >> 5;
    const int q4 = (lane & 15) >> 2, p4 = lane & 3, blk = (lane >> 4) & 1;
    const int kxor = ((r32 & 3) << 2) | ((r32 >> 2) & 3);
    const int vlow0 = ((2 * blk + (p4 >> 1)) ^ (h & 3)) << 4, vlow1 = ((2 * blk + (p4 >> 1)) ^ ((h + 2) & 3)) << 4;
    {
        const size_t rowq = (size_t)b * SEQ + qblk * 256 + wave * 32 + r32;
        const bf16_t* qrow = QM + rowq * 512 + head * 128;
        bf16x8 qf[8];
#pragma unroll
        for (int s = 0; s < 8; ++s) qf[s] = *(const bf16x8*)(qrow + 16 * s + 8 * h);
        { float ss = 0.f;
#pragma unroll
          for (int s = 0; s < 8; ++s)
#pragma unroll
              for (int jx = 0; jx < 8; ++jx) { const float x = bf2f(qf[s][jx]); ss += x * x; }
          ss += __shfl_xor(ss, 32);
          const float rs = __builtin_amdgcn_rsqf(ss * (1.f / 128.f) + EPS) * QSCALE_M;
#pragma unroll
          for (int s = 0; s < 8; ++s) {
              const f32x4 g0 = *(const f32x4*)(gqm + 16 * s + 8 * h), g1 = *(const f32x4*)(gqm + 16 * s + 8 * h + 4);
              u32x4 w;
              w.x = pk2(bf2f(qf[s][0]) * rs * g0.x, bf2f(qf[s][1]) * rs * g0.y); w.y = pk2(bf2f(qf[s][2]) * rs * g0.z, bf2f(qf[s][3]) * rs * g0.w);
              w.z = pk2(bf2f(qf[s][4]) * rs * g1.x, bf2f(qf[s][5]) * rs * g1.y); w.w = pk2(bf2f(qf[s][6]) * rs * g1.z, bf2f(qf[s][7]) * rs * g1.w);
              qf[s] = __builtin_bit_cast(bf16x8, w); } }
        f32x16 o[4];
#pragma unroll
        for (int dt = 0; dt < 4; ++dt)
#pragma unroll
            for (int r = 0; r < 16; ++r) o[dt][r] = 0.f;
        float m = -INFINITY, lp = 0.f;
#pragma unroll 1
        for (int c = 0; c < 8; ++c) {
            const int slot0 = 32 * c;
            const LAS unsigned char* kp = lds + (slot0 + r32) * 256;
            f32x16 S;
            const float ninit = (c == 0) ? 0.f : -m;
#pragma unroll
            for (int r = 0; r < 16; ++r) S[r] = ninit;
#pragma unroll
            for (int s = 0; s < 8; ++s) { const bf16x8 kf = *(const LAS bf16x8*)(kp + (((2 * s + h) ^ kxor) << 4)); S = MFMA32(kf, qf[s], S); }
            float mx = S[0];
#pragma unroll
            for (int r = 1; r < 16; ++r) mx = fmaxf(mx, S[r]);
            mx = fmaxf(mx, __shfl_xor(mx, 32));
            if (c == 0 || __builtin_amdgcn_ballot_w64(mx > 8.f) != 0ull) {
                const float d = (c == 0) ? mx : fmaxf(mx, 0.f), al = fexp2(-d);
                m = ((c == 0) ? 0.f : m) + d; lp *= al;
#pragma unroll
                for (int r = 0; r < 16; ++r) S[r] -= d;
#pragma unroll
                for (int dt = 0; dt < 4; ++dt)
#pragma unroll
                    for (int r = 0; r < 16; ++r) o[dt][r] *= al;
            }
            float rsum = 0.f;
#pragma unroll
            for (int r = 0; r < 16; ++r) { S[r] = fexp2(S[r]); rsum += S[r]; }
            lp += rsum;
            bf16x8 pb[2];
#pragma unroll
            for (int s2 = 0; s2 < 2; ++s2) { u32x4 w; w.x = pk2(S[8 * s2], S[8 * s2 + 1]); w.y = pk2(S[8 * s2 + 2], S[8 * s2 + 3]); w.z = pk2(S[8 * s2 + 4], S[8 * s2 + 5]); w.w = pk2(S[8 * s2 + 6], S[8 * s2 + 7]); pb[s2] = __builtin_bit_cast(bf16x8, w); }
            const LAS unsigned char* vp = lds + M_VOFF + (slot0 + 4 * h + q4) * 256 + (p4 & 1) * 8;
#pragma unroll
            for (int dt = 0; dt < 4; ++dt)
#pragma unroll
                for (int s2 = 0; s2 < 2; ++s2) {
                    const s16x4 lo = vtr(vp + (16 * s2) * 256 + ((dt ^ q4) << 6) + vlow0), hi = vtr(vp + (16 * s2 + 8) * 256 + ((dt ^ q4) << 6) + vlow1);
                    const bf16x8 va = __builtin_shufflevector(lo, hi, 0, 1, 2, 3, 4, 5, 6, 7);
                    o[dt] = MFMA32(va, pb[s2], o[dt]);
                }
        }
        const float l = lp + __shfl_xor(lp, 32), inv = 1.f / l;
        __syncthreads();
        LAS unsigned char* ot = lds + wave * 8192;
#pragma unroll
        for (int dt = 0; dt < 4; ++dt)
#pragma unroll
            for (int g4 = 0; g4 < 4; ++g4) { u32x2 w; w.x = pk2(o[dt][4 * g4] * inv, o[dt][4 * g4 + 1] * inv); w.y = pk2(o[dt][4 * g4 + 2] * inv, o[dt][4 * g4 + 3] * inv);
                *(LAS u32x2*)(ot + r32 * 256 + (32 * dt + 8 * g4 + 4 * h) * 2) = w; }
        asm volatile("s_waitcnt lgkmcnt(0)" ::: "memory");
        const size_t rowq0 = (size_t)b * SEQ + qblk * 256 + wave * 32;
#pragma unroll
        for (int i = 0; i < 8; ++i) { const int q = i * 4 + (lane >> 4), c16 = lane & 15;
            const u32x4 w = *(const LAS u32x4*)(ot + q * 256 + c16 * 16);
            *(u32x4*)(AM + (rowq0 + q) * 1536 + 1024 + head * 128 + c16 * 8) = w; }
    }
    __syncthreads();
}

DI void p2_attnA(const Args& a, LAS unsigned char* lds, int tid, int lane, int wave) {
    unsigned char* ws = a.ws; const int G = gridDim.x; const int vcu = (G % 8 == 0) ? ((int)blockIdx.x % 8) * (G / 8) + (int)blockIdx.x / 8 : (int)blockIdx.x;
    const bf16_t* Q = (const bf16_t*)(ws + WS_Q); const bf16_t* K = (const bf16_t*)(ws + WS_K); const bf16_t* V = (const bf16_t*)(ws + WS_V);
    bf16_t* PO = (bf16_t*)(ws + WS_PO); float* LSE = (float*)(ws + WS_LSE);
    constexpr int NU = NB * 12 * 8;
    const int per = (NU + G - 1) / G, u0 = vcu * per, u1 = (u0 + per < NU) ? u0 + per : NU;
    if (u0 >= u1) return;
    u32x4 kv[6], vv[6]; unsigned okm; bf16x8 qn[4];
    AUnit cu = a_decode(u0);
    a_issue(cu, Q, K, V, tid, lane, wave, kv, vv, okm, qn);
    for (int u = u0; u < u1; ++u) {
        a_fill(lds, tid, kv, vv, okm);
        bf16x8 qf[4];
#pragma unroll
        for (int s = 0; s < 4; ++s) qf[s] = qn[s];
        __syncthreads();
        AUnit nu = cu;
        if (u + 1 < u1) { nu = a_decode(u + 1); a_issue(nu, Q, K, V, tid, lane, wave, kv, vv, okm, qn); }
        a_compute(cu, qf, PO, LSE, lds, lane, wave);
        cu = nu;
    }
}
DI void p2_attnM(const Args& a, LAS unsigned char* lds, int tid, int lane, int wave) {
    unsigned char* ws = a.ws; unsigned char* dob = (unsigned char*)a.out; const int G = gridDim.x; const int vcu = (G % 8 == 0) ? ((int)blockIdx.x % 8) * (G / 8) + (int)blockIdx.x / 8 : (int)blockIdx.x;
    bf16_t* AM = (bf16_t*)(ws + WS_AM);
    const bf16_t* QM = (const bf16_t*)(dob + DO_QM); const bf16_t* KM = (const bf16_t*)(dob + DO_KM); const bf16_t* VM = (const bf16_t*)(dob + DO_VM);
    for (int u = vcu; u < NB * 4 * 8; u += G) attnM_wg(u, QM, KM, VM, (const float*)a.in[I_GQM], (const float*)a.in[I_GKM], AM, lds, tid, lane, wave);
}
DI void p2_conv(const Args& a, int tid) {
    unsigned char* ws = a.ws; bf16_t* AM = (bf16_t*)(ws + WS_AM);
    const bf16_t* U = (const bf16_t*)(ws + WS_U); const bf16_t* CB = (const bf16_t*)(ws + WS_CB); const float* wc = (const float*)a.in[I_WCONV];
    const int gt = blockIdx.x * 512 + tid, NT = gridDim.x * 512;
    constexpr int TB = 8;
    for (int idx = gt; idx < (NTOK / TB) * 96; idx += NT) {
        const int tb = idx / 96, c8 = (idx % 96) * 8, row0 = tb * TB, s0 = row0 & (SEQ - 1);
        u32x4 uu[TB + 2], cb[TB];
        const u32x4 zero = {0u, 0u, 0u, 0u};
        uu[0] = (s0 > 0) ? *(const u32x4*)(U + (size_t)(row0 - 1) * 768 + c8) : zero;
#pragma unroll
        for (int t = 0; t < TB; ++t) { uu[t + 1] = *(const u32x4*)(U + (size_t)(row0 + t) * 768 + c8); cb[t] = *(const u32x4*)(CB + (size_t)(row0 + t) * 768 + c8); }
        uu[TB + 1] = (s0 + TB < SEQ) ? *(const u32x4*)(U + (size_t)(row0 + TB) * 768 + c8) : zero;
        float k0[8], k1[8], k2[8];
        { const f32x4 a0 = *(const f32x4*)(wc + c8), a1 = *(const f32x4*)(wc + c8 + 4), b0 = *(const f32x4*)(wc + 768 + c8), b1 = *(const f32x4*)(wc + 768 + c8 + 4),
                      d0 = *(const f32x4*)(wc + 1536 + c8), d1 = *(const f32x4*)(wc + 1536 + c8 + 4);
#pragma unroll
          for (int q = 0; q < 4; ++q) { k0[q] = a0[q]; k0[4 + q] = a1[q]; k1[q] = b0[q]; k1[4 + q] = b1[q]; k2[q] = d0[q]; k2[4 + q] = d1[q]; } }
#pragma unroll
        for (int t = 0; t < TB; ++t) {
            u32x4 o;
#pragma unroll
            for (int w = 0; w < 4; ++w) {
                const float y0 = k0[2 * w] * bf_lo(uu[t][w]) + k1[2 * w] * bf_lo(uu[t + 1][w]) + k2[2 * w] * bf_lo(uu[t + 2][w]);
                const float y1 = k0[2 * w + 1] * bf_hi(uu[t][w]) + k1[2 * w + 1] * bf_hi(uu[t + 1][w]) + k2[2 * w + 1] * bf_hi(uu[t + 2][w]);
                o[w] = pk2(bf_lo(cb[t][w]) * y0, bf_hi(cb[t][w]) * y1);
            }
            *(u32x4*)(AM + (size_t)(row0 + t) * 1536 + 256 + c8) = o;
        }
    }
}
#ifndef P2_REP
#define P2_REP 0
#endif
DI void phase2(const Args& a, LAS unsigned char* lds, int tid, int lane, int wave) {
#ifndef P2_PARTS
#define P2_PARTS 7
#endif
    if constexpr (P2_PARTS & 1) p2_attnA(a, lds, tid, lane, wave);
    if constexpr (P2_REP & 1) p2_attnA(a, lds, tid, lane, wave);
    __builtin_amdgcn_sched_barrier(0); asm volatile("" ::: "memory");
    if constexpr (P2_PARTS & 2) p2_attnM(a, lds, tid, lane, wave);
    if constexpr (P2_REP & 2) p2_attnM(a, lds, tid, lane, wave);
    if constexpr (P2_PARTS & 4) p2_conv(a, tid);
    if constexpr (P2_REP & 4) p2_conv(a, tid);
}

DI void attn_combine(const Args& a, int tid) {
    unsigned char* ws = a.ws;
    const bf16_t* PO = (const bf16_t*)(ws + WS_PO); const float* LSE = (const float*)(ws + WS_LSE); bf16_t* AM = (bf16_t*)(ws + WS_AM);
    const int gt = blockIdx.x * 512 + tid, NT = gridDim.x * 512;
    for (int idx = gt; idx < NTOK * 32; idx += NT) {
        const int row = idx >> 5, c8 = (idx & 31) * 8, hs = c8 >> 6;
        const float l0 = LSE[(size_t)row * 4 + hs], l1 = LSE[((size_t)NTOK + row) * 4 + hs], l2 = LSE[((size_t)2 * NTOK + row) * 4 + hs];
        const float mx = fmaxf(l0, fmaxf(l1, l2)); float w0 = fexp2(l0 - mx), w1 = fexp2(l1 - mx), w2 = fexp2(l2 - mx);
        const float inv = 1.f / (w0 + w1 + w2); w0 *= inv; w1 *= inv; w2 *= inv;
        const u32x4 a0 = *(const u32x4*)(PO + (size_t)row * 256 + c8), a1 = *(const u32x4*)(PO + ((size_t)NTOK + row) * 256 + c8), a2 = *(const u32x4*)(PO + ((size_t)2 * NTOK + row) * 256 + c8);
        u32x4 o;
#pragma unroll
        for (int w = 0; w < 4; ++w) o[w] = pk2(w0 * bf_lo(a0[w]) + w1 * bf_lo(a1[w]) + w2 * bf_lo(a2[w]), w0 * bf_hi(a0[w]) + w1 * bf_hi(a1[w]) + w2 * bf_hi(a2[w]));
        *(u32x4*)(AM + (size_t)row * 1536 + c8) = o;
    }
}

DI void phase6(const Args& a, LAS unsigned char* lds, int tid, int lane, int wave) {
    unsigned char* ws = a.ws;
    const bf16_t* XB = (const bf16_t*)(ws + WS_XB);
    const bf16_t* WH = (const bf16_t*)(ws + WS_WRH); const bf16_t* WL = (const bf16_t*)(ws + WS_WRL);
    const float* brg = (const float*)a.in[I_BRG]; const float* bre = (const float*)a.in[I_BRE];
    int* tok_e = (int*)(ws + WS_RT + RT_TOKE); int* tok_rank = (int*)(ws + WS_RT + RT_RANK); float* tok_w = (float*)(ws + WS_RT + RT_W);
    float* tok_rstd = (float*)(ws + WS_RT + RT_RSTD); int* ccnt = (int*)(ws + WS_RT + RT_CCNT);
    LAS int* asg = (LAS int*)(lds + 32768);
    LAS int* rnk = (LAS int*)(lds + 32768 + 1024);
    bool first = true;
    for (int chunk = blockIdx.x; chunk < NTOK / 128; chunk += gridDim.x) {
        {
            constexpr int WP = 272;
            constexpr int SLB = 48 * WP;
            LAS unsigned char* wbuf = lds + 40960;
            LAS float* lg = (LAS float*)(lds + wave * 4096);
            const int t0 = chunk * 128 + wave * 16, row = lane & 15, kq = lane >> 4;
            const bf16_t* xp = XB + (size_t)(t0 + row) * 1024 + 8 * kq;
            u32x4 wst[3];
#define RT_STAGE_LOAD(sl) do { _Pragma("unroll") for (int i = 0; i < 3; ++i) { const int p = tid + i * 512, arr = p / 768, q = p % 768, r = q >> 4, c = q & 15; \
                wst[i] = *(const u32x4*)((arr ? WL : WH) + (size_t)r * 1024 + (sl) * 128 + c * 8); } } while (0)
#define RT_STAGE_WRITE(buf) do { _Pragma("unroll") for (int i = 0; i < 3; ++i) { const int p = tid + i * 512, arr = p / 768, q = p % 768, r = q >> 4, c = q & 15; \
                *(LAS u32x4*)(wbuf + ((buf) * 2 + arr) * SLB + r * WP + c * 16) = wst[i]; } } while (0)
            RT_STAGE_LOAD(0); RT_STAGE_WRITE(0);
            __syncthreads();
            pg8::f32x4 acc[3]; acc[0] = acc[1] = acc[2] = (pg8::f32x4){0.f, 0.f, 0.f, 0.f};
            float ss = 0.f;
#pragma unroll 1
            for (int sl = 0; sl < 8; ++sl) {
                if (sl + 1 < 8) RT_STAGE_LOAD(sl + 1);
                u32x4 xv[4];
#pragma unroll
                for (int ks = 0; ks < 4; ++ks) xv[ks] = *(const u32x4*)(xp + sl * 128 + 32 * ks);
                const LAS unsigned char* wb = wbuf + (sl & 1) * 2 * SLB;
#pragma unroll
                for (int ks = 0; ks < 4; ++ks) {
                    const u32x4 hi = xv[ks];
#pragma unroll
                    for (int w = 0; w < 4; ++w) { const float e0 = bf_lo(hi[w]), e1 = bf_hi(hi[w]); ss += e0 * e0 + e1 * e1; }
                    const bf16x8 ah = __builtin_bit_cast(bf16x8, hi);
#pragma unroll
                    for (int nt = 0; nt < 3; ++nt) {
                        const bf16x8 bh = *(const LAS bf16x8*)(wb + (16 * nt + row) * WP + (32 * ks + 8 * kq) * 2);
                        const bf16x8 bl = *(const LAS bf16x8*)(wb + SLB + (16 * nt + row) * WP + (32 * ks + 8 * kq) * 2);
                        acc[nt] = MFMA16(ah, bh, acc[nt]); acc[nt] = MFMA16(ah, bl, acc[nt]);
                    }
                }
                if (sl + 1 < 8) RT_STAGE_WRITE((sl + 1) & 1);
                __syncthreads();
            }
#undef RT_STAGE_LOAD
#undef RT_STAGE_WRITE
            ss += __shfl_xor(ss, 16); ss += __shfl_xor(ss, 32);
#pragma unroll
            for (int nt = 0; nt < 3; ++nt)
#pragma unroll
                for (int r = 0; r < 4; ++r) lg[(kq * 4 + r) * 48 + 16 * nt + row] = acc[nt][r];
            asm volatile("s_waitcnt lgkmcnt(0)" ::: "memory");
            if (lane < 16) {
                const int tok = t0 + lane; const float rstd = __builtin_amdgcn_rsqf(ss * (1.f / 1024.f) + EPS);
                const LAS float* lp = lg + lane * 48;
                float gv[4]; int g = 0;
#pragma unroll
                for (int n = 0; n < 4; ++n) gv[n] = lp[n] * rstd + brg[n];
                float gm = gv[0];
#pragma unroll
                for (int n = 1; n < 4; ++n) if (gv[n] > gm) { gm = gv[n]; g = n; }
                float gz = 0.f;
#pragma unroll
                for (int n = 0; n < 4; ++n) gz += fexp(gv[n] - gm);
                const float pg = 1.f / gz;
                float sv[8];
#pragma unroll
                for (int e = 0; e < 8; ++e) sv[e] = lp[4 + 8 * g + e] * rstd + bre[8 * g + e];
                int i0 = 0; float s0 = sv[0];
#pragma unroll
                for (int e = 1; e < 8; ++e) if (sv[e] > s0) { s0 = sv[e]; i0 = e; }
                int i1 = -1; float s1 = -INFINITY;
#pragma unroll
                for (int e = 0; e < 8; ++e) if (e != i0 && sv[e] > s1) { s1 = sv[e]; i1 = e; }
                const float r = fexp(s1 - s0), w0 = pg / (1.f + r), w1 = w0 * r;
                const int al2 = (wave * 16 + lane) * 2;
                asg[al2] = g * 8 + i0; asg[al2 + 1] = g * 8 + i1;
                tok_w[tok * 2] = w0; tok_w[tok * 2 + 1] = w1; tok_rstd[tok] = rstd;
            }
        }
        first = false;
        __syncthreads();
        int my_e = 0, my_rank = 0;
        if (tid < 256) { my_e = asg[tid];
            for (int ee = 0; ee < 32; ++ee) { const unsigned long long mk = __ballot(my_e == ee);
                if (my_e == ee) my_rank = __popcll(mk & ((1ull << lane) - 1ull));
                if (lane == 0) rnk[wave * 32 + ee] = __popcll(mk); } }
        __syncthreads();
        if (tid < 256) { int base = 0;
            for (int w = 0; w < wave; ++w) base += rnk[w * 32 + my_e];
            const int tok = chunk * 128 + (tid >> 1); tok_e[tok * 2 + (tid & 1)] = my_e; tok_rank[tok * 2 + (tid & 1)] = base + my_rank; }
        if (tid < 32) ccnt[chunk * 32 + tid] = rnk[tid] + rnk[32 + tid] + rnk[64 + tid] + rnk[96 + tid];
        __syncthreads();
    }
}

DI void moe_weight_convert(const Args& a, int cw, int NCW, int lane) {
    unsigned char* ws = a.ws;
    bf16_t* WGU = (bf16_t*)(ws + WS_WGU); bf16_t* WD = (bf16_t*)(ws + WS_WD);
    const float* wg = (const float*)a.in[I_WGATE]; const float* wu = (const float*)a.in[I_WUP]; const float* wd = (const float*)a.in[I_WDOWN]; const float* gf = (const float*)a.in[I_GFFN];
    constexpr int I_GU = 32 * 16 * 32, I_D = 32 * 8 * 32;
    for (int it = cw; it < I_GU + I_D; it += NCW) {
        if (it < I_GU) { const int e = it >> 9, r = it & 511, kb = r >> 5, nb = r & 31;
            const int t = nb >> 3, c = (nb & 7) * 32; const bool up = c >= 128; const int ff = 128 * t + (up ? c - 128 : c);
            transpose_item((up ? wu : wg) + (size_t)e * 1024 * 512, 512, kb * 64, ff, WGU + (size_t)e * 1024 * 1024, 1024, nb * 32, kb * 64, gf, nullptr, lane);
        } else { const int r2 = it - I_GU, e = r2 >> 8, r = r2 & 255, kb = r >> 5, nb = r & 31;
            transpose_item(wd + (size_t)e * 512 * 1024, 1024, kb * 64, nb * 32, WD + (size_t)e * 1024 * 512, 512, nb * 32, kb * 64, nullptr, nullptr, lane); }
    }
}

DI void phase7(const Args& a, LAS unsigned char* lds, int tid, int lane, int wave) {
    unsigned char* ws = a.ws;
    const int* tok_e = (const int*)(ws + WS_RT + RT_TOKE); const int* tok_rank = (const int*)(ws + WS_RT + RT_RANK); const float* tok_w = (const float*)(ws + WS_RT + RT_W);
    const float* tok_rstd = (const float*)(ws + WS_RT + RT_RSTD); const int* ccnt = (const int*)(ws + WS_RT + RT_CCNT); int* meta = (int*)(ws + WS_RT + RT_META);
    u32x2* sr_dw = (u32x2*)(ws + WS_SROW);
    int* rowtok = (int*)(ws + WS_SROW + 640 * 1024); float* sr_rstd = (float*)(ws + WS_SROW + 960 * 1024);
    LAS int* red = (LAS int*)lds;
    LAS int* tot = red + 1024;
    LAS int* bef = tot + 32;
    LAS int* pst = bef + 32;
    for (int chunk = blockIdx.x; chunk < NTOK / 128; chunk += gridDim.x) {
        { const int e = tid & 31, cgp = tid >> 5; int pt = 0, pb = 0;
          for (int c = cgp * 16; c < cgp * 16 + 16; ++c) { const int v = ccnt[c * 32 + e]; pt += v; if (c < chunk) pb += v; }
          red[cgp * 32 + e] = pt; red[512 + cgp * 32 + e] = pb; }
        __syncthreads();
        if (tid < 32) { int t = 0, b = 0; for (int q = 0; q < 16; ++q) { t += red[q * 32 + tid]; b += red[512 + q * 32 + tid]; } tot[tid] = t; bef[tid] = b; }
        __syncthreads();
        if (tid == 0) { int p = 0; for (int e = 0; e < 32; ++e) { pst[e] = p; p += (tot[e] + 255) & ~255; } pst[32] = p; }
        __syncthreads();
        if (lane < 16) {
            const int tokl = chunk * 128 + wave * 16 + lane;
            const int e0 = tok_e[tokl * 2], e1 = tok_e[tokl * 2 + 1], r0 = tok_rank[tokl * 2], r1 = tok_rank[tokl * 2 + 1];
            const float w0 = tok_w[tokl * 2], w1 = tok_w[tokl * 2 + 1], rs = tok_rstd[tokl];
            const int d0 = pst[e0] + bef[e0] + r0, d1 = pst[e1] + bef[e1] + r1;
            u32x2 r0v; r0v.x = (unsigned)(tokl * 2); r0v.y = __float_as_uint(w0); sr_dw[d0] = r0v; u32x2 r1v; r1v.x = (unsigned)(tokl * 2 + 1); r1v.y = __float_as_uint(w1); sr_dw[d1] = r1v;
            rowtok[d0] = tokl; rowtok[d1] = tokl; sr_rstd[d0] = rs; sr_rstd[d1] = rs;
        }
        if (chunk < 32) { const int e = chunk, p0 = pst[e], pe = pst[e + 1];
            for (int r = p0 + tot[e] + tid; r < pe; r += 512) { u32x2 z; z.x = 0xffffffffu; z.y = 0u; sr_dw[r] = z; rowtok[r] = 0; sr_rstd[r] = 0.f; } }
        if (chunk == 0) { const int nt = pst[32] >> 8; if (tid == 0) meta[0] = nt;
            for (int t = tid; t < nt; t += 512) { int e = 0; for (int q = 1; q < 32; ++q) if ((pst[q] >> 8) <= t) e = q; meta[1 + t] = e; } }
        __syncthreads();
    }
}

DI int load_tile_table(const Args& a, LAS unsigned char* lds, int tid) {
    const int* meta = (const int*)(a.ws + WS_RT + RT_META); LAS int* tbl = (LAS int*)(lds + MISC_OFF);
    const int nt = meta[0];
    for (int i = tid; i < nt; i += 512) tbl[i] = meta[1 + i];
    __syncthreads();
    return nt;
}

DI void phase10(const Args& a, int lane, int wave) {
    const bf16_t* Y = (const bf16_t*)(a.ws + WS_Y); const bf16_t* XB = (const bf16_t*)(a.ws + WS_XB); float* O = a.out;
    const int gw = blockIdx.x * 8 + wave, NGW = gridDim.x * 8;
    for (int tok = gw; tok < NTOK; tok += NGW) {
        u32x4 xv[2], y0[2], y1[2];
#pragma unroll
        for (int j = 0; j < 2; ++j) { const size_t c = (size_t)j * 512 + lane * 8;
            xv[j] = *(const u32x4*)(XB + (size_t)tok * 1024 + c); y0[j] = *(const u32x4*)(Y + (size_t)(tok * 2) * 1024 + c); y1[j] = *(const u32x4*)(Y + (size_t)(tok * 2 + 1) * 1024 + c); }
#pragma unroll
        for (int j = 0; j < 2; ++j) { const size_t c = (size_t)j * 512 + lane * 8;
            f32x4 o0, o1;
            o0.x = bf_lo(xv[j].x) + bf_lo(y0[j].x) + bf_lo(y1[j].x); o0.y = bf_hi(xv[j].x) + bf_hi(y0[j].x) + bf_hi(y1[j].x);
            o0.z = bf_lo(xv[j].y) + bf_lo(y0[j].y) + bf_lo(y1[j].y); o0.w = bf_hi(xv[j].y) + bf_hi(y0[j].y) + bf_hi(y1[j].y);
            o1.x = bf_lo(xv[j].z) + bf_lo(y0[j].z) + bf_lo(y1[j].z); o1.y = bf_hi(xv[j].z) + bf_hi(y0[j].z) + bf_hi(y1[j].z);
            o1.z = bf_lo(xv[j].w) + bf_lo(y0[j].w) + bf_lo(y1[j].w); o1.w = bf_hi(xv[j].w) + bf_hi(y0[j].w) + bf_hi(y1[j].w);
            __builtin_nontemporal_store(o0, (f32x4*)(O + (size_t)tok * 1024 + c)); __builtin_nontemporal_store(o1, (f32x4*)(O + (size_t)tok * 1024 + c + 4)); }
    }
}

#define VM_WAIT() asm volatile("s_waitcnt vmcnt(0)" ::: "memory")
#define XB_TMO      128
#define XB_XCNT(j)  (256  + 64 * (j))
#define XB_XSUB(j)  (1280 + 64 * (j))
#define XB_XGEN(j)  (2304 + 64 * (j))
#define XB_TOP      3328
#define XB_TOPGEN   3392
#define XCD_BAR_WORDS 3456
#define XB_SPIN_CAP (1u << 18)

__device__ __forceinline__ unsigned xb_ld(unsigned* p)              { return __hip_atomic_load(p, __ATOMIC_RELAXED, __HIP_MEMORY_SCOPE_AGENT); }
__device__ __forceinline__ unsigned xb_add(unsigned* p, unsigned v) { return __hip_atomic_fetch_add(p, v, __ATOMIC_RELAXED, __HIP_MEMORY_SCOPE_AGENT); }
__device__ __forceinline__ unsigned xb_xcc_id() { return (unsigned)__builtin_amdgcn_s_getreg((3 << 11) | 20) & 0xFu; }
#define XB_SPIN(cond, bar) do { unsigned _sp = 0; while (cond) { __builtin_amdgcn_s_sleep(1); \
    if ((++_sp & 255u) == 0u) { if (xb_ld(&(bar)[XB_TMO])) break; if (_sp > XB_SPIN_CAP) { atomicAdd(&(bar)[XB_TMO], 1u); break; } } } } while (0)

struct XcdBarrier {
    unsigned* bar; unsigned x;
    volatile LAS unsigned* st;
};

__device__ __forceinline__ XcdBarrier xcd_barrier_post(unsigned* bar, volatile LAS unsigned* st) {
    XcdBarrier b; b.bar = bar; b.x = xb_xcc_id(); b.st = st;
    if (threadIdx.x == 0) (void)xb_add(&bar[XB_XCNT(b.x)], 1u);
    return b;
}
__device__ __forceinline__ void xcd_barrier_complete(unsigned* bar, unsigned x, unsigned& nloc, unsigned& nx) {
    const unsigned G = gridDim.x * gridDim.y * gridDim.z;
    unsigned sum, cnt, mine, sp = 0u;
    for (;;) {
        sum = 0u; cnt = 0u; mine = 0u;
#pragma unroll
        for (unsigned j = 0; j < 16; ++j) { const unsigned c = xb_ld(&bar[XB_XCNT(j)]); sum += c; cnt += (c > 0u) ? 1u : 0u; mine = (j == x) ? c : mine; }
        if (sum == G) break;
        __builtin_amdgcn_s_sleep(1);
        if ((++sp & 255u) == 0u) { if (xb_ld(&bar[XB_TMO])) break; if (sp > XB_SPIN_CAP) { atomicAdd(&bar[XB_TMO], 1u); break; } }
    }
    nloc = mine > 0u ? mine : 1u; nx = cnt > 0u ? cnt : 1u;
}

__device__ __forceinline__ void xcd_barrier(const XcdBarrier& b) {
    asm volatile("s_waitcnt vmcnt(0)" ::: "memory");
    __syncthreads();
    if (threadIdx.x == 0) {
        unsigned* bar = b.bar;
        __builtin_amdgcn_s_waitcnt(0);
        unsigned nloc = b.st[0], nx = b.st[1];
        if (nloc == 0u) { xcd_barrier_complete(bar, b.x, nloc, nx); b.st[0] = nloc; b.st[1] = nx; }
        const unsigned old = xb_add(&bar[XB_XSUB(b.x)], 1u);
        const unsigned gen = old / nloc;
        if (old + 1u == (gen + 1u) * nloc) {
            __builtin_amdgcn_fence(__ATOMIC_RELEASE, "agent");
            asm volatile("s_waitcnt vmcnt(0)" ::: "memory");
            const unsigned og = xb_add(&bar[XB_TOP], 1u);
            const unsigned tg = og / nx;
            if (og + 1u == (tg + 1u) * nx) xb_add(&bar[XB_TOPGEN], 1u);
            else XB_SPIN(xb_ld(&bar[XB_TOPGEN]) == tg, bar);
            __builtin_amdgcn_fence(__ATOMIC_ACQUIRE, "agent");
            xb_add(&bar[XB_XGEN(b.x)], 1u);
            asm volatile("s_waitcnt vmcnt(0)" ::: "memory");
        } else {
            XB_SPIN(xb_ld(&bar[XB_XGEN(b.x)]) == gen, bar);
            __builtin_amdgcn_fence(__ATOMIC_ACQUIRE, "agent");
            asm volatile("s_waitcnt vmcnt(0)" ::: "memory");
        }
    }
    __syncthreads();
}

constexpr int N_PHASES = 11;
template <int K> DI void run_phase(const Args& a, LAS unsigned char* lds) {
    int tid = threadIdx.x; asm volatile("" : "+v"(tid));
    const int lane = tid & 63, wave = __builtin_amdgcn_readfirstlane(tid >> 6);
    unsigned char* ws = a.ws; unsigned char* dob = (unsigned char*)a.out; const int G = gridDim.x;
    if constexpr (K == 0) { phase0(a, lds, tid, lane, wave); }
    if constexpr (K == 1) {
        pg8::Gemm g{(const pg8::bf16_t*)(dob + DO_H), (const pg8::bf16_t*)(ws + WS_WIN), NTOK + NMROW, 9216, 1024};
        InOrder S; S.so.init(NTOK, 5120, G, (int)blockIdx.x); S.nmain = (NTOK / 256) * 20;
        EpiIn E{ws, (bf16_t*)(dob + DO_QM), (bf16_t*)(dob + DO_KM), (const float*)a.in[I_GQA], (const float*)a.in[I_GKA], (const float*)(ws + WS_ROPE)};
        pg8::gemm_phase<EpiIn, InOrder, true, true>(lds, g, S, E);
        {
            const int total = S.nmain + 64, rounds = (total + G - 1) / G, busy = total - (rounds - 1) * G;
            if ((int)blockIdx.x >= busy) moe_weight_convert(a, ((int)blockIdx.x - busy) * 8 + wave, (G - busy) * 8, lane);
            else if (busy == G) moe_weight_convert(a, (int)blockIdx.x * 8 + wave, G * 8, lane);
        }
    }
    if constexpr (K == 2) { phase2(a, lds, tid, lane, wave); }
    if constexpr (K == 3) {
        pg8::Gemm g{(const pg8::bf16_t*)(dob + DO_H), (const pg8::bf16_t*)(ws + WS_WIN) + (size_t)5120 * 1024, NTOK, 3072, 1024};
        pg8::StaticOrder S; S.init(NTOK, 3072, G, (int)blockIdx.x);
        EpiGate E{(unsigned char*)(ws + WS_G), 3072};
        pg8::gemm_phase<EpiGate, pg8::StaticOrder, true, true>(lds, g, S, E);
        attn_combine(a, tid);
    }
    if constexpr (K == 4) {
        pg8::Gemm g{(const pg8::bf16_t*)(ws + WS_AM), (const pg8::bf16_t*)(ws + WS_WMRG), NTOK, 1024, 1536};
        pg8::StaticOrder S; S.init(NTOK, 1024, G, (int)blockIdx.x);
        EpiMerge E{(const unsigned char*)(ws + WS_G), (bf16_t*)(ws + WS_MRG), 4, 16};
        pg8::gemm_phase<EpiMerge, pg8::StaticOrder, true, true>(lds, g, S, E);
    }
    if constexpr (K == 5) {
        pg8::Gemm g{(const pg8::bf16_t*)(ws + WS_MRG), (const pg8::bf16_t*)(ws + WS_WOUT), NTOK, 1024, 1024};
        pg8::StaticOrder S; S.init(NTOK, 1024, G, (int)blockIdx.x);
        EpiOut E{(const float*)a.in[I_X], a.out, (bf16_t*)(ws + WS_XB)};
        pg8::gemm_phase<EpiOut, pg8::StaticOrder, true, true>(lds, g, S, E);
    }
    if constexpr (K == 6) { phase6(a, lds, tid, lane, wave); }
    if constexpr (K == 7) { phase7(a, lds, tid, lane, wave); }
    if constexpr (K == 8) {
        const int nt = load_tile_table(a, lds, tid);
        LAS int* rowtab = (LAS int*)(lds + MISC_OFF + 1536);
        MoeOrder<true> S{(const LAS int*)(lds + MISC_OFF), nt, G, (int)blockIdx.x, rowtab};
        { const int* rowtok = (const int*)(ws + WS_SROW + 640 * 1024); Unit uu;
          for (int ui = 0; ui < 6; ++ui) { if (!S.next(ui, uu)) break; if (tid < 256) rowtab[ui * 256 + tid] = rowtok[uu.pm * 256 + tid]; } }
        __syncthreads();
        pg8::Gemm g{(const pg8::bf16_t*)(ws + WS_XB), (const pg8::bf16_t*)(ws + WS_WGU), nt * 256, 1024, 1024};
        EpiUp E{(const float*)(ws + WS_SROW + 960 * 1024), (bf16_t*)(ws + WS_ACT)};
        pg8::gemm_phase<EpiUp, MoeOrder<true>, true, true>(lds, g, S, E);
    }
    if constexpr (K == 9) {
        const int nt = load_tile_table(a, lds, tid);
        pg8::Gemm g{(const pg8::bf16_t*)(ws + WS_ACT), (const pg8::bf16_t*)(ws + WS_WD), nt * 256, 1024, 512};
        MoeOrder<false> S{(const LAS int*)(lds + MISC_OFF), nt, G, (int)blockIdx.x, nullptr};
        EpiDown E{(const u32x2*)(ws + WS_SROW), (bf16_t*)(ws + WS_Y)};
        pg8::gemm_phase<EpiDown, MoeOrder<false>, true, true>(lds, g, S, E);
    }
    if constexpr (K == 10) { phase10(a, lane, wave); }
}

#ifndef PH_MASK
#define PH_MASK 0x7ff
#endif
#ifndef USE_CG_SEAM0
#define USE_CG_SEAM0 0
#endif
#ifndef REP_MASK
#define REP_MASK 0x000
#endif
__global__ void __launch_bounds__(512, 2) mk_fwd(Args a) {
    extern __shared__ __attribute__((aligned(16))) unsigned char lds_raw[];
    LAS unsigned char* lds = (LAS unsigned char*)lds_raw;
    const int tid = threadIdx.x;
    const int lo = a.ph_lo, hi = a.ph_hi;
    cg::grid_group grid = cg::this_grid();
    volatile LAS unsigned* bst = (volatile LAS unsigned*)(lds + MISC_OFF + 8192);
    if (tid < 2) bst[tid] = 0u;
    __syncthreads();
    XcdBarrier bar = xcd_barrier_post((unsigned*)(a.ws + WS_CTL) + 1024, bst);
#define IN(k) ((((PH_MASK) >> (k)) & 1) && lo <= (k) && (k) < hi)
#define RUN(k) do { if (IN(k)) { run_phase<k>(a, lds); if constexpr (((REP_MASK) >> (k)) & 1) { __syncthreads(); run_phase<k>(a, lds); } } \
                    if (IN(k) && IN((k) + 1)) { if (USE_CG_SEAM0 && (k) == 0) grid.sync(); else xcd_barrier(bar); } } while (0)
    RUN(0); RUN(1); RUN(2); RUN(3); RUN(4); RUN(5); RUN(6);
    RUN(7); RUN(8); RUN(9); RUN(10);
#undef IN
#undef RUN
}

#ifndef MK_MULTI
#define MK_MULTI 0
#endif
extern "C" void kernel_launch(void* const* d_in, const int* in_sizes, int n_in, void* d_out, int out_size, void* d_ws, size_t ws_size, hipStream_t stream) {
    static int grid = 0;
    if (grid == 0) {
        if (n_in != 24 || out_size != NTOK * DM || ws_size < WS_NEED) { fprintf(stderr, "kernel_launch: unexpected shapes (n_in %d, out %d, ws %zu)\n", n_in, out_size, ws_size); grid = -1; return; }
        int dev = 0, cus = 0, per_cu = 0;
        (void)hipGetDevice(&dev); (void)hipDeviceGetAttribute(&cus, hipDeviceAttributeMultiprocessorCount, dev);
        (void)hipFuncSetAttribute((const void*)mk_fwd, hipFuncAttributeMaxDynamicSharedMemorySize, LDS_BYTES);
        (void)hipOccupancyMaxActiveBlocksPerMultiprocessor(&per_cu, (const void*)mk_fwd, 512, LDS_BYTES);
        (void)hipGetLastError();
        if (per_cu < 1) { fprintf(stderr, "kernel_launch: occupancy query says %d blocks per CU: this kernel cannot be made resident, nothing launched\n", per_cu); grid = -1; return; }
        grid = cus;
    }
    if (grid < 0) return;
    Args a{};
    for (int i = 0; i < 24; ++i) a.in[i] = d_in[i];
    a.out = (float*)d_out; a.ws = (unsigned char*)d_ws;
#if MK_MULTI
    for (int p = 0; p < N_PHASES; ++p) { a.ph_lo = p; a.ph_hi = p + 1; hipLaunchKernelGGL(mk_fwd, dim3(grid), dim3(512), LDS_BYTES, stream, a); }
#else
    a.ph_lo = 0; a.ph_hi = N_PHASES;
    if (hipMemsetAsync((char*)d_ws + WS_CTL, 0, CTL_BYTES, stream) != hipSuccess) { fprintf(stderr, "kernel_launch: memset failed\n"); return; }
    void* args[] = {&a};
    hipError_t e = hipLaunchCooperativeKernel((const void*)mk_fwd, dim3(grid), dim3(512), args, LDS_BYTES, stream);
    if (e != hipSuccess) fprintf(stderr, "cooperative launch failed: %s (grid %d)\n", hipGetErrorString(e), grid);
#endif
}
```

```cpp
#include <hip/hip_runtime.h>
#include <hip/hip_cooperative_groups.h>
#include <cstdio>
#include <cstdint>
namespace cg = cooperative_groups;
namespace pg8 {
#define PG8_LAS __attribute__((address_space(3)))
typedef unsigned short bf16_t;
typedef short bf16x8 __attribute__((ext_vector_type(8)));
typedef float f32x4 __attribute__((ext_vector_type(4)));
typedef unsigned u32x4 __attribute__((ext_vector_type(4)));
constexpr int BM = 256, BK = 64, HALF = 128, HTB = HALF * BK * 2  , STAGE_BYTES = 8 * HTB, NXCD = 8, WGM = 8;

__host__ __device__ __forceinline__ int lds_byte(int r, int c) { const int st = (r >> 4) * 2 + (c >> 5), rr = r & 15, cc = c & 31, ob = rr * 64 + cc * 2; return st * 1024 + (ob ^ (((ob >> 9) & 1) << 5)); }
__host__ __device__ __forceinline__ void stage_rc(int b, int& R, int& C) { const int st = b / 1024, sb = b % 1024, swz = sb ^ (((sb >> 9) & 1) << 5); R = (st >> 1) * 16 + swz / 64; C = (st & 1) * 32 + (swz % 64) / 2; }
__host__ __device__ __forceinline__ int perm32(int rho) { const int n = rho >> 4, i = rho & 15; return 8 * (i >> 2) + 4 * n + (i & 3); }

struct Unit { int pm, pn, aux; };
struct Gemm { const bf16_t* A; const bf16_t* Bt; int M, N, K; };

struct StaticOrder {
    static constexpr bool GATHER = false; __device__ __forceinline__ int row(int, int) const { return 0; }
    int nM, nN, nwg, G, c;
    __host__ __device__ void init(int M, int N, int G_, int c_) { nM = M / BM; nN = N / BM; nwg = nM * nN; G = G_; c = c_; }
    __host__ __device__ bool next(int i, Unit& u) const {
        const long L = (long)i * G + c; if (L >= nwg) return false;
        int wgid = (int)L; { const int q = nwg / NXCD, r = nwg % NXCD, xcd = wgid % NXCD, off = wgid / NXCD; wgid = (xcd < r ? xcd * (q + 1) : r * (q + 1) + (xcd - r) * q) + off; }
        const int nig = WGM * nN, gid = wgid / nig, fm = gid * WGM, gsz = (nM - fm) < WGM ? (nM - fm) : WGM;
        u.pm = fm + ((wgid % nig) % gsz); u.pn = (wgid % nig) / gsz; u.aux = u.pn; return true;
    }
    __device__ __forceinline__ void a_ready(const Unit&) const {}
    __device__ __forceinline__ void done(const Unit&) const {}
};

__device__ __forceinline__ unsigned cvt_pk_bf16(float lo, float hi) { unsigned r; asm volatile("v_cvt_pk_bf16_f32 %0, %1, %2" : "=v"(r) : "v"(lo), "v"(hi)); return r; }
template <class Epi, class Sched, bool ALIGN_EPI = false, bool SP2 = false, bool I8 = false>
__device__ __forceinline__ void gemm_phase(PG8_LAS unsigned char* lds, const Gemm g, const Sched& S, const Epi& E) {
    const int tid = threadIdx.x, wid = __builtin_amdgcn_readfirstlane(tid >> 6), lane = tid & 63, wr = wid >> 2, wc = wid & 3, fr = lane & 15, fq = lane >> 4;
    const int K = g.K, nt = K / BK;
    unsigned voffA[2], voffB[2];
    constexpr bool GATHER = Sched::GATHER;
    static_assert(!GATHER || SP2, "gather is implemented for the SP2 loop");
    unsigned gA[2][2], gN[2][2];
#pragma unroll
    for (int i = 0; i < 2; ++i) { int R, C; stage_rc(tid * 16 + i * 8192, R, C); const int Rb = Epi::PERM ? ((R & ~31) + perm32(R & 31)) : R;
        voffA[i] = (unsigned)(R * K + C) * 2u; voffB[i] = (unsigned)(Rb * K + C) * 2u; }
#define PG8_ROWS(dst, ui_) do { _Pragma("unroll") for (int h_ = 0; h_ < 2; ++h_) _Pragma("unroll") for (int i_ = 0; i_ < 2; ++i_) { int R_, C_; stage_rc(tid * 16 + i_ * 8192, R_, C_); \
        dst[h_][i_] = (unsigned)S.row(ui_, h_ * HALF + R_) * (unsigned)(K * 2) + (unsigned)(C_ * 2); } } while (0)
    const size_t kstep = (size_t)(BK * 2);
    const size_t hstep = (size_t)HALF * K * 2;
    const size_t hstepA = GATHER ? (size_t)0 : hstep;
    const size_t tstep = 2 * hstep;
    const unsigned ldsw = (unsigned)wid * 1024u;
    const int aoff = lds_byte(wr * 64 + fr, fq * 8), boff = lds_byte(wc * 32 + fr, fq * 8);
#define PG8_SA(b, h) (((b) * 2 + (h)) * HTB)
#define PG8_SB(b, h) ((4 + (b) * 2 + (h)) * HTB)
#define PG8_STAGE(bufoff, gbase, voff) do { _Pragma("unroll") for (int _i = 0; _i < 2; ++_i) \
        __builtin_amdgcn_global_load_lds((const unsigned*)((const char*)(gbase) + (voff)[_i]), (PG8_LAS unsigned*)(lds + (bufoff) + ldsw + _i * 8192), 16, 0, 0); } while (0)
#define PG8_LDA(dst, b, h) do { _Pragma("unroll") for (int m = 0; m < 4; ++m) _Pragma("unroll") for (int k = 0; k < 2; ++k) dst[m][k] = *(const PG8_LAS bf16x8*)(lds + PG8_SA(b, h) + aoff + m * 2048 + k * 1024); } while (0)
#define PG8_LDB(dst, b, h) do { _Pragma("unroll") for (int n = 0; n < 2; ++n) _Pragma("unroll") for (int k = 0; k < 2; ++k) dst[n][k] = *(const PG8_LAS bf16x8*)(lds + PG8_SB(b, h) + boff + n * 2048 + k * 1024); } while (0)
typedef int pg8_i32x4 __attribute__((ext_vector_type(4)));
#define PG8_MMA(ai, bj, At, Bt) do { __builtin_amdgcn_s_setprio(1); _Pragma("unroll") for (int m = 0; m < 4; ++m) _Pragma("unroll") for (int n = 0; n < 2; ++n) _Pragma("unroll") for (int k = 0; k < 2; ++k) { \
        if constexpr (I8) acc[ai][bj][m][n] = __builtin_bit_cast(f32x4, __builtin_amdgcn_mfma_i32_16x16x64_i8(__builtin_bit_cast(pg8_i32x4, Bt[n][k]), __builtin_bit_cast(pg8_i32x4, At[m][k]), __builtin_bit_cast(pg8_i32x4, acc[ai][bj][m][n]), 0, 0, 0)); \
        else acc[ai][bj][m][n] = __builtin_amdgcn_mfma_f32_16x16x32_bf16(Bt[n][k], At[m][k], acc[ai][bj][m][n], 0, 0, 0); } \
        __builtin_amdgcn_s_setprio(0); } while (0)
#define PG8_WAIT_V(n) asm volatile("s_waitcnt vmcnt(" #n ")" ::: "memory")
#define PG8_WAIT_L(n) asm volatile("s_waitcnt lgkmcnt(" #n ")" ::: "memory")
#define PG8_BAR __builtin_amdgcn_s_barrier()
#define PG8_SCHED __builtin_amdgcn_sched_barrier(0)
    Unit cur, nxt; int ui = 0;
    if (!S.next(0, cur)) return;
    f32x4 acc[2][2][4][2];
#pragma unroll
    for (int a = 0; a < 2; ++a)
#pragma unroll
        for (int b = 0; b < 2; ++b)
#pragma unroll
            for (int m = 0; m < 4; ++m)
#pragma unroll
                for (int n = 0; n < 2; ++n) acc[a][b][m][n] = (f32x4){0.f, 0.f, 0.f, 0.f};
    bf16x8 At[4][2], B0[2][2], B1[2][2];
    const char* cA = (const char*)g.A + (GATHER ? (size_t)0 : (size_t)cur.pm * tstep); const char* cB = (const char*)g.Bt + (size_t)cur.pn * tstep;
    if constexpr (GATHER) { PG8_ROWS(gA, 0); PG8_ROWS(gN, 0); }
#define PG8_OA(h) (GATHER ? gA[h] : voffA)
    S.a_ready(cur);
    if constexpr (SP2) {
        PG8_STAGE(PG8_SB(0, 0), cB, voffB); PG8_STAGE(PG8_SB(0, 1), cB + hstep, voffB); PG8_STAGE(PG8_SA(0, 0), cA, PG8_OA(0)); PG8_STAGE(PG8_SA(0, 1), cA + hstepA, PG8_OA(1));
        if (wr == 1) PG8_BAR;
        PG8_WAIT_V(2); PG8_BAR;
        PG8_STAGE(PG8_SB(1, 0), cB + kstep, voffB); PG8_STAGE(PG8_SA(1, 0), cA + kstep, PG8_OA(0)); PG8_STAGE(PG8_SB(1, 1), cB + hstep + kstep, voffB);
        PG8_WAIT_V(6); PG8_BAR;
    } else {
        PG8_STAGE(PG8_SB(0, 0), cB, voffB); PG8_STAGE(PG8_SA(0, 0), cA, voffA); PG8_STAGE(PG8_SB(0, 1), cB + hstep, voffB); PG8_STAGE(PG8_SA(0, 1), cA + hstep, voffA);
        if (wr == 1) PG8_BAR;
        PG8_WAIT_V(4); PG8_BAR;
        PG8_STAGE(PG8_SB(1, 0), cB + kstep, voffB); PG8_STAGE(PG8_SA(1, 0), cA + kstep, voffA); PG8_STAGE(PG8_SB(1, 1), cB + hstep + kstep, voffB);
        PG8_WAIT_V(6); PG8_BAR;
    }
    for (;;) {
        const bool has_next = S.next(ui + 1, nxt);
        const char* nA = (has_next && !GATHER) ? (const char*)g.A + (size_t)nxt.pm * tstep : cA; const char* nB = has_next ? (const char*)g.Bt + (size_t)nxt.pn * tstep : cB;
        if constexpr (GATHER) { if (has_next) PG8_ROWS(gN, ui + 1); }
#pragma unroll 1
        for (int t = 0; t < nt; t += 2) {
            const bool last = (t == nt - 2);
            const char* a1 = cA + (size_t)(t + 1) * kstep;
            const char* a2 = last ? nA : cA + (size_t)(t + 2) * kstep; const char* b2 = last ? nB : cB + (size_t)(t + 2) * kstep;
            const char* a3 = a2 + kstep; const char* b3 = b2 + kstep;
            if (last && has_next) S.a_ready(nxt);
            if constexpr (Epi::HAS_MID) { if (t == E.mid0 || t == E.mid1) E.mid(acc, cur, t, wr, wc, fr, fq); }
            if constexpr (SP2) {
            unsigned on0[2], on1[2];
            on0[0] = GATHER ? (last ? gN[0][0] : gA[0][0]) : voffA[0]; on0[1] = GATHER ? (last ? gN[0][1] : gA[0][1]) : voffA[1];
            on1[0] = GATHER ? (last ? gN[1][0] : gA[1][0]) : voffA[0]; on1[1] = GATHER ? (last ? gN[1][1] : gA[1][1]) : voffA[1];
            PG8_LDB(B0, 0, 0); PG8_LDB(B1, 0, 1); PG8_SCHED; PG8_LDA(At, 0, 0); PG8_STAGE(PG8_SA(1, 1), a1 + hstepA, PG8_OA(1));
            PG8_WAIT_V(8); PG8_WAIT_L(0); PG8_BAR; PG8_MMA(0, 0, At, B0); PG8_MMA(0, 1, At, B1); PG8_BAR; PG8_SCHED;
            PG8_LDA(At, 0, 1); PG8_STAGE(PG8_SB(0, 0), b2, voffB); PG8_STAGE(PG8_SB(0, 1), b2 + hstep, voffB); PG8_STAGE(PG8_SA(0, 0), a2, on0);
            PG8_WAIT_V(8); PG8_WAIT_L(0); PG8_BAR; PG8_MMA(1, 0, At, B0); PG8_MMA(1, 1, At, B1); PG8_BAR; PG8_SCHED;
            PG8_LDB(B0, 1, 0); PG8_LDB(B1, 1, 1); PG8_SCHED; PG8_LDA(At, 1, 0); PG8_STAGE(PG8_SA(0, 1), a2 + hstepA, on1);
            PG8_WAIT_V(8); PG8_WAIT_L(0); PG8_BAR; PG8_MMA(0, 0, At, B0); PG8_MMA(0, 1, At, B1); PG8_BAR; PG8_SCHED;
            PG8_LDA(At, 1, 1); PG8_STAGE(PG8_SB(1, 0), b3, voffB); PG8_STAGE(PG8_SB(1, 1), b3 + hstep, voffB); PG8_STAGE(PG8_SA(1, 0), a3, on0);
            PG8_WAIT_V(8); PG8_WAIT_L(0); PG8_BAR; PG8_MMA(1, 0, At, B0); PG8_MMA(1, 1, At, B1); PG8_BAR; PG8_SCHED;
            } else {
            PG8_LDB(B0, 0, 0); PG8_SCHED; PG8_LDA(At, 0, 0); PG8_STAGE(PG8_SA(1, 1), a1 + hstep, voffA);
            PG8_WAIT_L(8); PG8_BAR; PG8_WAIT_L(0); PG8_MMA(0, 0, At, B0); PG8_BAR; PG8_SCHED;
            PG8_LDB(B1, 0, 1); PG8_STAGE(PG8_SB(0, 0), b2, voffB);
            PG8_BAR; PG8_WAIT_L(0); PG8_MMA(0, 1, At, B1); PG8_BAR;
            PG8_LDA(At, 0, 1); PG8_STAGE(PG8_SA(0, 0), a2, voffA);
            PG8_BAR; PG8_WAIT_L(0); PG8_MMA(1, 0, At, B0); PG8_BAR; PG8_SCHED;
            PG8_STAGE(PG8_SB(0, 1), b2 + hstep, voffB);
            PG8_WAIT_V(6); PG8_BAR; PG8_MMA(1, 1, At, B1); PG8_BAR;
            PG8_LDB(B0, 1, 0); PG8_SCHED; PG8_LDA(At, 1, 0); PG8_STAGE(PG8_SA(0, 1), a2 + hstep, voffA);
            PG8_WAIT_L(8); PG8_BAR; PG8_WAIT_L(0); PG8_MMA(0, 0, At, B0); PG8_BAR; PG8_SCHED;
            PG8_LDB(B1, 1, 1); PG8_STAGE(PG8_SB(1, 0), b3, voffB);
            PG8_BAR; PG8_WAIT_L(0); PG8_MMA(0, 1, At, B1); PG8_BAR;
            PG8_LDA(At, 1, 1); PG8_STAGE(PG8_SA(1, 0), a3, voffA);
            PG8_BAR; PG8_WAIT_L(0); PG8_MMA(1, 0, At, B0); PG8_BAR; PG8_SCHED;
            PG8_STAGE(PG8_SB(1, 1), b3 + hstep, voffB);
            PG8_WAIT_V(6); PG8_BAR; PG8_MMA(1, 1, At, B1); PG8_BAR;
            }
        }
        if constexpr (ALIGN_EPI) { if (wr == 0) PG8_BAR; }
        if constexpr (!Epi::AFTER_DRAIN) { E(acc, cur, wr, wc, fr, fq); S.done(cur); }
        if (!has_next) break;
#pragma unroll
        for (int a = 0; a < 2; ++a)
#pragma unroll
            for (int b = 0; b < 2; ++b)
#pragma unroll
                for (int m = 0; m < 4; ++m)
#pragma unroll
                    for (int n = 0; n < 2; ++n) acc[a][b][m][n] = (f32x4){0.f, 0.f, 0.f, 0.f};
        cur = nxt; cA = nA; cB = nB; ++ui;
        if constexpr (GATHER) { _Pragma("unroll") for (int h_ = 0; h_ < 2; ++h_) _Pragma("unroll") for (int i_ = 0; i_ < 2; ++i_) gA[h_][i_] = gN[h_][i_]; }
        if constexpr (ALIGN_EPI) { if (wr == 1) PG8_BAR; }
    }
    PG8_WAIT_V(0);
    if constexpr (!ALIGN_EPI) { if (wr == 0) PG8_BAR; }
    PG8_BAR;
    if constexpr (Epi::AFTER_DRAIN) { E.fused(acc, cur, wr, wc, fr, fq, lds, wid, lane); S.done(cur); }
#undef PG8_SA
#undef PG8_OA
#undef PG8_ROWS
#undef PG8_SB
#undef PG8_STAGE
#undef PG8_LDA
#undef PG8_LDB
#undef PG8_MMA
#undef PG8_WAIT_V
#undef PG8_WAIT_L
#undef PG8_BAR
#undef PG8_SCHED
}
}

#define DI __device__ __forceinline__
#define LAS __attribute__((address_space(3)))
typedef unsigned short bf16_t;
typedef float f32x4 __attribute__((ext_vector_type(4)));
typedef float f32x2 __attribute__((ext_vector_type(2)));
typedef float f32x16 __attribute__((ext_vector_type(16)));
typedef unsigned u32x4 __attribute__((ext_vector_type(4)));
typedef unsigned u32x2 __attribute__((ext_vector_type(2)));
typedef short bf16x8 __attribute__((ext_vector_type(8)));
typedef short s16x4 __attribute__((ext_vector_type(4)));
typedef __bf16 bf16x2_t __attribute__((ext_vector_type(2)));
using pg8::Unit;

constexpr int NB = 16, SEQ = 2048, DM = 1024, NTOK = NB * SEQ, NMEM = 256, NMROW = NB * NMEM;
constexpr float EPS = 1e-6f, LOG2E = 1.4426950408889634f;
constexpr float QSCALE_A = 0.125f * LOG2E, QSCALE_M = 0.08838834764831845f * LOG2E;
constexpr int MAXROWS = 73728, MAXTILES = MAXROWS / 256;

constexpr size_t MiB = 1u << 20;
constexpr size_t WS_CTL = 0, CTL_BYTES = 64 * 1024;
constexpr size_t WS_WIN = 1 * MiB, WS_WMKV = 17 * MiB, WS_WMRG = 19 * MiB, WS_WOUT = 22 * MiB;
constexpr size_t WS_ROPE = 24 * MiB, WS_WRH = 26 * MiB, WS_WRL = WS_WRH + 128 * 1024;
constexpr size_t WS_RT = 27 * MiB;
constexpr size_t RT_TOKE = 0, RT_RANK = 256 * 1024, RT_W = 512 * 1024, RT_RSTD = 768 * 1024, RT_CCNT = 896 * 1024, RT_META = 960 * 1024;
constexpr size_t WS_WGU = 28 * MiB, WS_WD = 92 * MiB;
constexpr size_t WS_Q = 124 * MiB, WS_K = 172 * MiB, WS_V = 220 * MiB, WS_U = 268 * MiB, WS_CB = 316 * MiB;
constexpr size_t WS_AM = 364 * MiB, WS_PO = 460 * MiB, WS_LSE = 508 * MiB, WS_SROW = 510 * MiB;
constexpr size_t WS_G = 124 * MiB;
constexpr size_t WS_MRG = 220 * MiB, WS_XB = 284 * MiB;
constexpr size_t SR_RSTD = 0, SR_DEST = 320 * 1024, SR_W = 640 * 1024;
constexpr size_t WS_XB8 = 124 * MiB, WS_ACT = 348 * MiB, WS_Y = 124 * MiB;
constexpr size_t WS_SB = WS_WRH + 512 * 1024;
constexpr size_t WS_NEED = 512 * MiB;
constexpr size_t DO_H = 0, DO_HM = 64 * MiB, DO_QM = 72 * MiB, DO_KM = 104 * MiB, DO_VM = 108 * MiB;
constexpr int RING_BYTES = 131072, MISC_OFF = 131072, LDS_BYTES = 147456;

DI unsigned pk2(float lo, float hi) { f32x2 v = {lo, hi}; bf16x2_t b = __builtin_convertvector(v, bf16x2_t); return __builtin_bit_cast(unsigned, b); }
DI float bf_lo(unsigned u) { return __uint_as_float(u << 16); }
DI float bf_hi(unsigned u) { return __uint_as_float(u & 0xffff0000u); }
DI float bf2f(short s) { return __uint_as_float(((unsigned)(unsigned short)s) << 16); }
DI float fexp2(float x) { return __builtin_amdgcn_exp2f(x); }
DI float fexp(float x) { return __builtin_amdgcn_exp2f(x * LOG2E); }
DI float frcp(float x) { return __builtin_amdgcn_rcpf(x); }
DI u32x4 pack8(const f32x4& a, const f32x4& b) { u32x4 w; w.x = pk2(a.x, a.y); w.y = pk2(a.z, a.w); w.z = pk2(b.x, b.y); w.w = pk2(b.z, b.w); return w; }
DI void st16(void* p, const u32x4& v) { __builtin_nontemporal_store(v, (u32x4*)p); }
DI void st16f(void* p, const f32x4& v) { __builtin_nontemporal_store(v, (f32x4*)p); }
DI void st8(void* p, const u32x2& v) { __builtin_nontemporal_store(v, (u32x2*)p); }
DI void st16d(void* p, const u32x4& v) { *(u32x4*)p = v; }
DI void st8d(void* p, const u32x2& v) { *(u32x2*)p = v; }
DI int crow(int reg, int h) { return (reg & 3) + 8 * (reg >> 2) + 4 * h; }
DI float wave_sum(float v) {
#pragma unroll
    for (int o = 1; o < 64; o <<= 1) v += __shfl_xor(v, o);
    return v;
}
#define MFMA32(a, b, c) __builtin_amdgcn_mfma_f32_32x32x16_bf16((a), (b), (c), 0, 0, 0)
#define MFMA16(a, b, c) __builtin_amdgcn_mfma_f32_16x16x32_bf16((a), (b), (c), 0, 0, 0)

struct EpiIn {
    static constexpr bool PERM = true, AFTER_DRAIN = false, HAS_MID = false;
    unsigned char* wsb; bf16_t* QM; bf16_t* KMVM; const float *gq, *gk, *cs;
    DI void operator()(const pg8::f32x4 (&acc)[2][2][4][2], const Unit& u, int wr, int wc, int fr, int fq) const {
        const int t = u.pn, row0 = u.pm * 256 + wr * 64 + fr;
        if (t >= 32) {
            bf16_t* dst = KMVM + (t >= 34 ? (size_t)NMROW * 512 : 0);
            const int col = (t & 1) * 256 + wc * 32 + 8 * fq;
#pragma unroll
            for (int ai = 0; ai < 2; ++ai)
#pragma unroll
                for (int m = 0; m < 4; ++m) {
                    bf16_t* rp = dst + (size_t)(row0 - NTOK + ai * 128 + m * 16) * 512 + col;
#pragma unroll
                    for (int bj = 0; bj < 2; ++bj) st16(rp + 128 * bj, pack8(acc[ai][bj][m][0], acc[ai][bj][m][1]));
                }
        } else if (t < 6) {
            const bool isq = t < 3; bf16_t* dst = (bf16_t*)(wsb + (isq ? WS_Q : WS_K)); const float* g = isq ? gq : gk; const float osc = isq ? QSCALE_A : 1.f;
            const int head = 4 * (isq ? t : t - 3) + wc;
            f32x4 gv[2][2];
#pragma unroll
            for (int bj = 0; bj < 2; ++bj)
#pragma unroll
                for (int n = 0; n < 2; ++n) gv[bj][n] = *(const f32x4*)(g + 32 * bj + 8 * fq + 4 * n) * osc;
#pragma unroll
            for (int ai = 0; ai < 2; ++ai) {
#pragma unroll
              for (int mp = 0; mp < 2; ++mp) {
                f32x4 csv[4][4];
#pragma unroll
                for (int m2 = 0; m2 < 2; ++m2) { const float* cr = cs + (size_t)(row0 + ai * 128 + (2 * mp + m2) * 16) * 16;
#pragma unroll
                    for (int q = 0; q < 4; ++q) csv[2 * mp + m2][q] = *(const f32x4*)(cr + 4 * q); }
#pragma unroll
                for (int m = 2 * mp; m < 2 * mp + 2; ++m) {
                    const int row = row0 + ai * 128 + m * 16;
                    float ss = 0.f;
#pragma unroll
                    for (int bj = 0; bj < 2; ++bj)
#pragma unroll
                        for (int n = 0; n < 2; ++n) { const f32x4 x = acc[ai][bj][m][n]; ss += (x.x * x.x + x.y * x.y) + (x.z * x.z + x.w * x.w); }
                    ss += __shfl_xor(ss, 16); ss += __shfl_xor(ss, 32);
                    const float rstd = __builtin_amdgcn_rsqf(ss * (1.f / 64.f) + EPS);
                    f32x4 v[2][2];
#pragma unroll
                    for (int bj = 0; bj < 2; ++bj)
#pragma unroll
                        for (int n = 0; n < 2; ++n) v[bj][n] = acc[ai][bj][m][n] * rstd * gv[bj][n];
                    f32x4 p0, p1;
#pragma unroll
                    for (int c = 0; c < 4; ++c) { p0[c] = __shfl_xor(v[0][0][c], 16); p1[c] = __shfl_xor(v[0][1][c], 16); }
                    if (fq < 2) {
                        const f32x4 c0 = csv[m][0], c1 = csv[m][1], s0 = csv[m][2], s1 = csv[m][3];
                        if (fq == 0) { v[0][0] = v[0][0] * c0 - p0 * s0; v[0][1] = v[0][1] * c1 - p1 * s1; }
                        else         { v[0][0] = v[0][0] * c0 + p0 * s0; v[0][1] = v[0][1] * c1 + p1 * s1; }
                    }
                    bf16_t* rp = dst + (size_t)row * 768 + head * 64 + 8 * fq;
#pragma unroll
                    for (int bj = 0; bj < 2; ++bj) st16(rp + 32 * bj, pack8(v[bj][0], v[bj][1]));
                }
                asm volatile("" ::: "memory");
              }
            }
        } else if (t >= 9 && t < 15) {
            bf16_t* U = (bf16_t*)(wsb + WS_U);
            const int c0 = (t - 9) * 128 + wc * 32 + 8 * fq;
#pragma unroll
            for (int ai = 0; ai < 2; ++ai)
#pragma unroll
                for (int m = 0; m < 4; ++m) {
                    const int row = row0 + ai * 128 + m * 16;
                    st16(U + (size_t)row * 768 + c0, pack8(acc[ai][0][m][0] * acc[ai][1][m][0], acc[ai][0][m][1] * acc[ai][1][m][1]));
                }
        } else {
            if (t >= 18) {
                const int col = (t - 18) * 256 + wc * 32 + 8 * fq;
#pragma unroll
                for (int ai = 0; ai < 2; ++ai)
#pragma unroll
                    for (int m = 0; m < 4; ++m) {
                        bf16_t* rp = QM + (size_t)(row0 + ai * 128 + m * 16) * 512 + col;
#pragma unroll
                        for (int bj = 0; bj < 2; ++bj) st16(rp + 128 * bj, pack8(acc[ai][bj][m][0], acc[ai][bj][m][1]));
                    }
            } else {
                bf16_t* dst = (bf16_t*)(wsb + (t < 9 ? WS_V : WS_CB));
                const int col = (t < 9 ? t - 6 : t - 15) * 256 + wc * 32 + 8 * fq;
#pragma unroll
                for (int ai = 0; ai < 2; ++ai)
#pragma unroll
                    for (int m = 0; m < 4; ++m) {
                        bf16_t* rp = dst + (size_t)(row0 + ai * 128 + m * 16) * 768 + col;
#pragma unroll
                        for (int bj = 0; bj < 2; ++bj) st16(rp + 128 * bj, pack8(acc[ai][bj][m][0], acc[ai][bj][m][1]));
                    }
            }
        }
    }
};

DI float sigm(float x) { return frcp(1.f + fexp(-fminf(fmaxf(x, -60.f), 60.f))); }
DI f32x4 sigm4(const f32x4& v) { f32x4 r; r.x = sigm(v.x); r.y = sigm(v.y); r.z = sigm(v.z); r.w = sigm(v.w); return r; }
DI unsigned gq1(float x) { return (unsigned)fminf(fmaxf(__builtin_rintf(sigm(x) * 255.f), 1.f), 255.f); }
DI unsigned gq4(const f32x4& v) { return gq1(v.x) | (gq1(v.y) << 8) | (gq1(v.z) << 16) | (gq1(v.w) << 24); }
DI float ub(unsigned w, int k) { return (float)((w >> (8 * k)) & 0xffu); }
struct EpiGate {
    static constexpr bool PERM = true, AFTER_DRAIN = false, HAS_MID = false;
    unsigned char* O; int ld;
    DI void operator()(const pg8::f32x4 (&acc)[2][2][4][2], const Unit& u, int wr, int wc, int fr, int fq) const {
        const int row0 = u.pm * 256 + wr * 64 + fr, col = u.pn * 256 + wc * 64 + 16 * fq;
#pragma unroll
        for (int ai = 0; ai < 2; ++ai)
#pragma unroll
            for (int m = 0; m < 4; ++m) {
                u32x4 w; w.x = gq4(acc[ai][0][m][0]); w.y = gq4(acc[ai][0][m][1]); w.z = gq4(acc[ai][1][m][0]); w.w = gq4(acc[ai][1][m][1]);
                st16d(O + (size_t)(row0 + ai * 128 + m * 16) * ld + col, w);
            }
    }
};

struct EpiMerge {
    static constexpr bool PERM = true, AFTER_DRAIN = false, HAS_MID = true;
    const unsigned char* G; bf16_t* O; int mid0, mid1;
    DI void mid(pg8::f32x4 (&acc)[2][2][4][2], const Unit& u, int t, int wr, int wc, int fr, int fq) const {
        const int ga = (t == mid0) ? 0 : 1;
        int row0 = u.pm * 256 + wr * 64 + fr; const int col = u.pn * 256 + wc * 64 + 16 * fq;
        asm volatile("" : "+v"(row0));
        u32x4 la[2][4], lb[2][4];
#pragma unroll
        for (int ai = 0; ai < 2; ++ai)
#pragma unroll
            for (int m = 0; m < 4; ++m) { const unsigned char* gp = G + (size_t)(row0 + ai * 128 + m * 16) * 3072 + ga * 1024 + col; la[ai][m] = *(const u32x4*)gp; lb[ai][m] = *(const u32x4*)(gp + 1024); }
#pragma unroll
        for (int ai = 0; ai < 2; ++ai)
#pragma unroll
            for (int m = 0; m < 4; ++m)
#pragma unroll
                for (int bj = 0; bj < 2; ++bj)
#pragma unroll
                    for (int n = 0; n < 2; ++n)
#pragma unroll
                        for (int c = 0; c < 4; ++c) acc[ai][bj][m][n][c] *= ub(la[ai][m][2 * bj + n], c) * frcp(ub(lb[ai][m][2 * bj + n], c));
        asm volatile("" ::: "memory");
    }
    DI void operator()(const pg8::f32x4 (&acc)[2][2][4][2], const Unit& u, int wr, int wc, int fr, int fq) const {
        const int row0 = u.pm * 256 + wr * 64 + fr, col = u.pn * 256 + wc * 64 + 16 * fq;
        u32x4 lq[2][4];
#pragma unroll
        for (int ai = 0; ai < 2; ++ai)
#pragma unroll
            for (int m = 0; m < 4; ++m) lq[ai][m] = *(const u32x4*)(G + (size_t)(row0 + ai * 128 + m * 16) * 3072 + 2048 + col);
#pragma unroll
        for (int ai = 0; ai < 2; ++ai)
#pragma unroll
            for (int m = 0; m < 4; ++m) {
                const size_t row = (size_t)(row0 + ai * 128 + m * 16);
#pragma unroll
                for (int bj = 0; bj < 2; ++bj) {
                    const float k = 1.f / 255.f; const unsigned q0 = lq[ai][m][2 * bj], q1 = lq[ai][m][2 * bj + 1];
                    const f32x4 g0 = {ub(q0, 0) * k, ub(q0, 1) * k, ub(q0, 2) * k, ub(q0, 3) * k}, g1 = {ub(q1, 0) * k, ub(q1, 1) * k, ub(q1, 2) * k, ub(q1, 3) * k};
                    st16d(O + row * 1024 + col + 8 * bj, pack8(acc[ai][bj][m][0] * g0, acc[ai][bj][m][1] * g1));
                }
            }
    }
};

struct EpiOut {
    static constexpr bool PERM = true, AFTER_DRAIN = false, HAS_MID = false;
    const float* X; float* O; bf16_t* XB;
    DI void operator()(const pg8::f32x4 (&acc)[2][2][4][2], const Unit& u, int wr, int wc, int fr, int fq) const {
        const int row0 = u.pm * 256 + wr * 64 + fr, col = u.pn * 256 + wc * 32 + 8 * fq;
#pragma unroll
        for (int ai = 0; ai < 2; ++ai)
#pragma unroll
            for (int m = 0; m < 4; ++m) {
                const size_t off = (size_t)(row0 + ai * 128 + m * 16) * 1024 + col;
#pragma unroll
                for (int bj = 0; bj < 2; ++bj) {
                    const f32x4 o0 = *(const f32x4*)(X + off + 128 * bj) + acc[ai][bj][m][0], o1 = *(const f32x4*)(X + off + 128 * bj + 4) + acc[ai][bj][m][1];
                    st16d(XB + off + 128 * bj, pack8(o0, o1));
                }
            }
    }
};

struct EpiUp {
    static constexpr bool PERM = true, AFTER_DRAIN = false, HAS_MID = false;
    const float* sa; const float* sb; bf16_t* ACT;
    DI void operator()(const pg8::f32x4 (&acc)[2][2][4][2], const Unit& u, int wr, int wc, int fr, int fq) const {
        const int row0 = u.pm * 256 + wr * 64 + fr, col = u.aux * 128 + wc * 32 + 8 * fq;
        const float* sbp = sb + (size_t)(u.pn >> 2) * 1024 + u.aux * 256 + wc * 32 + 8 * fq;
        const f32x4 sg0 = *(const f32x4*)(sbp), sg1 = *(const f32x4*)(sbp + 4), su0 = *(const f32x4*)(sbp + 128), su1 = *(const f32x4*)(sbp + 132);
#pragma unroll
        for (int ai = 0; ai < 2; ++ai)
#pragma unroll
            for (int m = 0; m < 4; ++m) {
                const int row = row0 + ai * 128 + m * 16; const float rs = sa[row];
                f32x4 o[2];
#pragma unroll
                for (int n = 0; n < 2; ++n)
#pragma unroll
                    for (int c = 0; c < 4; ++c) {
                        const float a = (float)__float_as_int(acc[ai][0][m][n][c]) * rs * (n ? sg1[c] : sg0[c]), b = (float)__float_as_int(acc[ai][1][m][n][c]) * rs * (n ? su1[c] : su0[c]);
                        o[n][c] = a * b * frcp(1.f + fexp(-a)); }
                st16d(ACT + (size_t)row * 512 + col, pack8(o[0], o[1]));
            }
    }
};

struct EpiDown {
    static constexpr bool PERM = true, AFTER_DRAIN = false, HAS_MID = false;
    const u32x2* dw; bf16_t* Y;
    DI void operator()(const pg8::f32x4 (&acc)[2][2][4][2], const Unit& u, int wr, int wc, int fr, int fq) const {
        const int row0 = u.pm * 256 + wr * 64 + fr, col = u.aux * 256 + wc * 32 + 8 * fq;
#pragma unroll
        for (int ai = 0; ai < 2; ++ai)
#pragma unroll
            for (int m = 0; m < 4; ++m) {
                const int row = row0 + ai * 128 + m * 16; const u32x2 rec = dw[row]; const int d = (int)rec.x;
                if (d >= 0) { const float ww = __uint_as_float(rec.y); bf16_t* rp = Y + (size_t)d * 1024 + col;
#pragma unroll
                    for (int bj = 0; bj < 2; ++bj) st16d(rp + 128 * bj, pack8(acc[ai][bj][m][0] * ww, acc[ai][bj][m][1] * ww)); }
            }
    }
};

struct InOrder {
    static constexpr bool GATHER = false; DI int row(int, int) const { return 0; }
    pg8::StaticOrder so; int nmain;
    DI bool next(int i, Unit& u) const {
        const long L = (long)i * so.G + so.c;
        if (L < nmain) return so.next(i, u);
        const int idx = (int)(L - nmain); if (idx >= 64) return false;
        u.pm = NTOK / 256 + (idx >> 2); u.pn = 32 + (idx & 3); u.aux = u.pn; return true;
    }
    DI void a_ready(const Unit&) const {}
    DI void done(const Unit&) const {}
};
template <bool GATHER_> struct MoeOrder {
    static constexpr bool GATHER = GATHER_;
    const LAS int* tile_exp; int ntiles, G, c; const LAS int* rowtab;
    DI int row(int ui, int r) const { return rowtab[ui * 256 + r]; }
    DI bool next(int i, Unit& u) const {
        const int nwg = ntiles * 4; const long L = (long)i * G + c; if (L >= nwg) return false;
        int wgid = (int)L; { const int q = nwg / 8, r = nwg % 8, xcd = wgid % 8, off = wgid / 8; wgid = (xcd < r ? xcd * (q + 1) : r * (q + 1) + (xcd - r) * q) + off; }
        u.pm = wgid >> 2; u.aux = wgid & 3; u.pn = tile_exp[u.pm] * 4 + u.aux; return true;
    }
    DI void a_ready(const Unit&) const {}
    DI void done(const Unit&) const {}
};

struct Args { const void* in[24]; float* out; unsigned char* ws; int ph_lo, ph_hi; };
enum { I_X = 0, I_MEM, I_POS, I_GMIX, I_GMEM, I_WIN, I_GQA, I_GKA, I_WCONV, I_WMKV, I_GQM, I_GKM, I_WPA, I_WPC, I_WPM, I_WOUT, I_GFFN, I_WRG, I_BRG, I_WRE, I_BRE, I_WGATE, I_WUP, I_WDOWN };

DI void transpose_item(const float* src, int ldsrc, int k0, int col0, bf16_t* dst, int lddst, int drow0, int dk0, const float* kgain, LAS float* scr, int lane, bool gmode = false) {
    (void)scr;
    const int kg = lane >> 3, nq = lane & 7;
    const float* sp = src + (size_t)(k0 + 8 * kg) * ldsrc + col0 + (gmode ? 16 * (nq >> 1) + 4 * (nq & 1) : 4 * nq);
    f32x4 v[8];
#pragma unroll
    for (int j = 0; j < 8; ++j) v[j] = *(const f32x4*)(sp + (size_t)j * ldsrc);
    if (kgain) { const f32x4 g0 = *(const f32x4*)(kgain + k0 + 8 * kg), g1 = *(const f32x4*)(kgain + k0 + 8 * kg + 4);
        v[0] *= g0.x; v[1] *= g0.y; v[2] *= g0.z; v[3] *= g0.w; v[4] *= g1.x; v[5] *= g1.y; v[6] *= g1.z; v[7] *= g1.w; }
    bf16_t* dp = dst + (size_t)(drow0 + 4 * nq) * lddst + dk0 + 8 * kg;
#pragma unroll
    for (int q = 0; q < 4; ++q) { u32x4 o; o.x = pk2(v[0][q], v[1][q]); o.y = pk2(v[2][q], v[3][q]); o.z = pk2(v[4][q], v[5][q]); o.w = pk2(v[6][q], v[7][q]);
        *(u32x4*)(dp + (size_t)q * lddst) = o; }
}
DI unsigned q8x4(float a, float b, float c, float d) {
    const int ia = (int)__builtin_rintf(a), ib = (int)__builtin_rintf(b), ic = (int)__builtin_rintf(c), id = (int)__builtin_rintf(d);
    return ((unsigned)ia & 0xffu) | (((unsigned)ib & 0xffu) << 8) | (((unsigned)ic & 0xffu) << 16) | ((unsigned)id << 24);
}
DI void quant_gu_item(const float* src  , int col0, unsigned char* dst  , int drow0, const float* kgain, float* sb  , int lane) {
    const float* sp = src + (size_t)(16 * lane) * 512 + col0;
    f32x4 v[16][2];
#pragma unroll
    for (int j = 0; j < 16; ++j) { v[j][0] = *(const f32x4*)(sp + (size_t)j * 512); v[j][1] = *(const f32x4*)(sp + (size_t)j * 512 + 4); }
    float g[16];
#pragma unroll
    for (int j4 = 0; j4 < 4; ++j4) { const f32x4 gg = *(const f32x4*)(kgain + 16 * lane + 4 * j4); g[4 * j4] = gg.x; g[4 * j4 + 1] = gg.y; g[4 * j4 + 2] = gg.z; g[4 * j4 + 3] = gg.w; }
    float cm[8];
#pragma unroll
    for (int c = 0; c < 8; ++c) cm[c] = 0.f;
#pragma unroll
    for (int j = 0; j < 16; ++j) { v[j][0] *= g[j]; v[j][1] *= g[j];
#pragma unroll
        for (int c = 0; c < 4; ++c) { cm[c] = fmaxf(cm[c], fabsf(v[j][0][c])); cm[4 + c] = fmaxf(cm[4 + c], fabsf(v[j][1][c])); } }
#pragma unroll
    for (int c = 0; c < 8; ++c) {
#pragma unroll
        for (int o = 1; o < 64; o <<= 1) cm[c] = fmaxf(cm[c], __shfl_xor(cm[c], o)); }
    if (lane < 8) { float mine = cm[0];
#pragma unroll
        for (int c = 1; c < 8; ++c) mine = (lane == c) ? cm[c] : mine;
        sb[lane] = mine * (1.f / 127.f); }
#pragma unroll
    for (int c = 0; c < 8; ++c) { const float sc = cm[c] > 0.f ? 127.f / cm[c] : 0.f; u32x4 o;
#pragma unroll
        for (int w = 0; w < 4; ++w) o[w] = q8x4(v[4 * w][c >> 2][c & 3] * sc, v[4 * w + 1][c >> 2][c & 3] * sc, v[4 * w + 2][c >> 2][c & 3] * sc, v[4 * w + 3][c >> 2][c & 3] * sc);
        *(u32x4*)(dst + (size_t)(drow0 + c) * 1024 + 16 * lane) = o; }
}
DI int gperm_col0(int c) { return 64 * ((c >> 5) & 3) + 8 * (c >> 7); }
DI int in_orig_col(int n0) {
    const int t = n0 >> 8, c = n0 & 255;
    if (t < 3)  return (4 * t + ((c >> 5) & 3)) * 64 + 32 * (c >> 7) + (c & 31);
    if (t < 6)  return 768 + (4 * (t - 3) + ((c >> 5) & 3)) * 64 + 32 * (c >> 7) + (c & 31);
    if (t < 9)  return 1536 + (t - 6) * 256 + c;
    if (t < 15) return (c < 128) ? 2304 + 128 * (t - 9) + c : 3840 + 128 * (t - 9) + c - 128;
    if (t < 18) return 3072 + (t - 15) * 256 + c;
    if (t < 20) return 4608 + (t - 18) * 256 + c;
    return 5120 + (t - 20) * 256 + gperm_col0(c);
}
DI void rms_row_to_bf16(const float* xrow, const float* g, bf16_t* orow, int lane) {
    const f32x4* xr = (const f32x4*)xrow + lane; const f32x4* gr = (const f32x4*)g + lane;
    f32x4 v[4]; float s = 0.f;
#pragma unroll
    for (int j = 0; j < 4; ++j) { v[j] = xr[64 * j]; s += (v[j].x * v[j].x + v[j].y * v[j].y) + (v[j].z * v[j].z + v[j].w * v[j].w); }
    const float rstd = __builtin_amdgcn_rsqf(wave_sum(s) * (1.f / 1024.f) + EPS);
    u32x2* o8 = (u32x2*)orow + lane;
#pragma unroll
    for (int j = 0; j < 4; ++j) { const f32x4 gg = gr[64 * j]; u32x2 w; w.x = pk2(v[j].x * rstd * gg.x, v[j].y * rstd * gg.y); w.y = pk2(v[j].z * rstd * gg.z, v[j].w * rstd * gg.w); o8[64 * j] = w; }
}

DI void phase0(const Args& a, LAS unsigned char* lds, int tid, int lane, int wave) {
    const int gw = blockIdx.x * 8 + wave, NGW = gridDim.x * 8;
    LAS float* scr = (LAS float*)(lds + wave * 16384);
    unsigned char* ws = a.ws; unsigned char* dob = (unsigned char*)a.out;
    bf16_t* Wt_in = (bf16_t*)(ws + WS_WIN); bf16_t* Wt_mkv = (bf16_t*)(ws + WS_WMKV); bf16_t* Wt_mrg = (bf16_t*)(ws + WS_WMRG); bf16_t* Wt_out = (bf16_t*)(ws + WS_WOUT);
    constexpr int I_IN = 16 * 256, I_MKV = 16 * 32, I_PA = 4 * 32, I_PC = 12 * 32, I_PM = 8 * 32, I_OUT = 16 * 32;
    constexpr int NITEMS = I_IN + I_MKV + I_PA + I_PC + I_PM + I_OUT;
    for (int it = gw; it < NITEMS; it += NGW) {
        int r = it;
        if (r < I_IN) { const int kb = r >> 8, nb = r & 255; transpose_item((const float*)a.in[I_WIN], 8192, kb * 64, in_orig_col(nb * 32), Wt_in, 1024, nb * 32, kb * 64, nullptr, scr, lane, nb >= 160); continue; } r -= I_IN;
        if (r < I_MKV) { const int kb = r >> 5, nb = r & 31; transpose_item((const float*)a.in[I_WMKV], 1024, kb * 64, nb * 32, Wt_mkv, 1024, nb * 32, kb * 64, nullptr, scr, lane); continue; } r -= I_MKV;
        if (r < I_PA) { const int kb = r >> 5, nb = r & 31; transpose_item((const float*)a.in[I_WPA], 1024, kb * 64, (nb >> 3) * 256 + gperm_col0((nb & 7) * 32), Wt_mrg, 1536, nb * 32, kb * 64, nullptr, scr, lane, true); continue; } r -= I_PA;
        if (r < I_PC) { const int kb = r >> 5, nb = r & 31; transpose_item((const float*)a.in[I_WPC], 1024, kb * 64, (nb >> 3) * 256 + gperm_col0((nb & 7) * 32), Wt_mrg, 1536, nb * 32, 256 + kb * 64, nullptr, scr, lane, true); continue; } r -= I_PC;
        if (r < I_PM) { const int kb = r >> 5, nb = r & 31; transpose_item((const float*)a.in[I_WPM], 1024, kb * 64, (nb >> 3) * 256 + gperm_col0((nb & 7) * 32), Wt_mrg, 1536, nb * 32, 1024 + kb * 64, nullptr, scr, lane, true); continue; } r -= I_PM;
        { const int kb = r >> 5, nb = r & 31; transpose_item((const float*)a.in[I_WOUT], 1024, kb * 64, nb * 32, Wt_out, 1024, nb * 32, kb * 64, nullptr, scr, lane); }
    }
    { const float* x = (const float*)a.in[I_X]; const float* g = (const float*)a.in[I_GMIX]; bf16_t* H = (bf16_t*)(dob + DO_H);
      const f32x4* gr = (const f32x4*)g + lane; f32x4 gg[4];
#pragma unroll
      for (int j = 0; j < 4; ++j) gg[j] = gr[64 * j];
      for (int m0 = 4 * gw; m0 < NTOK; m0 += 4 * NGW) {
          f32x4 v[4][4];
#pragma unroll
          for (int r = 0; r < 4; ++r)
#pragma unroll
              for (int j = 0; j < 4; ++j) v[r][j] = ((const f32x4*)(x + (size_t)(m0 + r) * 1024) + lane)[64 * j];
#pragma unroll
          for (int r = 0; r < 4; ++r) {
              float s = 0.f;
#pragma unroll
              for (int j = 0; j < 4; ++j) s += (v[r][j].x * v[r][j].x + v[r][j].y * v[r][j].y) + (v[r][j].z * v[r][j].z + v[r][j].w * v[r][j].w);
              const float rstd = __builtin_amdgcn_rsqf(wave_sum(s) * (1.f / 1024.f) + EPS);
              u32x2* o8 = (u32x2*)(H + (size_t)(m0 + r) * 1024) + lane;
#pragma unroll
              for (int j = 0; j < 4; ++j) { u32x2 w; w.x = pk2(v[r][j].x * rstd * gg[j].x, v[r][j].y * rstd * gg[j].y); w.y = pk2(v[r][j].z * rstd * gg[j].z, v[r][j].w * rstd * gg[j].w); o8[64 * j] = w; }
          }
      } }
    { const float* x = (const float*)a.in[I_MEM]; const float* g = (const float*)a.in[I_GMEM]; bf16_t* H = (bf16_t*)(dob + DO_HM);
      for (int m = gw; m < NMROW; m += NGW) rms_row_to_bf16(x + (size_t)m * 1024, g, H + (size_t)m * 1024, lane); }
    const int gt = blockIdx.x * 512 + tid, NT = gridDim.x * 512;
    { const float* wrg = (const float*)a.in[I_WRG]; const float* wre = (const float*)a.in[I_WRE]; const float* gf = (const float*)a.in[I_GFFN];
      bf16_t* WH = (bf16_t*)(ws + WS_WRH); bf16_t* WL = (bf16_t*)(ws + WS_WRL);
      for (int idx = gt; idx < 48 * 1024; idx += NT) { const int n = idx >> 10, k = idx & 1023;
          float v = 0.f; if (n < 4) v = wrg[k * 4 + n] * gf[k]; else if (n < 36) v = wre[k * 32 + (n - 4)] * gf[k];
          const unsigned hi = pk2(v, 0.f) & 0xffffu; const float lo = v - __uint_as_float(hi << 16);
          WH[idx] = (bf16_t)hi; WL[idx] = (bf16_t)(pk2(lo, 0.f) & 0xffffu); } }
    { const int* pos = (const int*)a.in[I_POS]; float* cs = (float*)(ws + WS_ROPE);
      for (int idx = gt; idx < NTOK * 8; idx += NT) { const int row = idx >> 3, j = idx & 7;
          const double inv = exp2(-(double)j * (18.931568569324174 / 8.0));
          const float invf = (float)inv; const float ang = (float)pos[row] * invf;
          const double ad = (double)ang; cs[row * 16 + j] = (float)cos(ad); cs[row * 16 + 8 + j] = (float)sin(ad); } }
}

typedef short v4i16_t __attribute__((ext_vector_type(4)));
DI s16x4 vtr(const LAS unsigned char* p) { return __builtin_bit_cast(s16x4, __builtin_amdgcn_ds_read_tr16_b64_v4i16((LAS v4i16_t*)p)); }

DI int kimg64(int slot, int c16) { return slot * 128 + ((c16 ^ ((slot >> 1) & 7)) << 4); }
DI int img256(int row, int ch) { return row * 256 + ((ch ^ (((row & 3) << 2) | ((row >> 2) & 3))) << 4); }
constexpr int A_VOFF = 49152, A_VS = 192;
constexpr int M_VOFF = 65536;

struct AUnit { int b, head, gi, hs, dl, L, j, Q0; size_t rowb; };
DI AUnit a_decode(int wu) {
    AUnit u; const int blk8 = wu & 7; const int bh = wu >> 3; u.head = bh % 12; u.b = bh / 12; u.gi = u.head >> 2; u.hs = u.head & 3;
    u.dl = (u.gi == 0) ? 1 : (u.gi == 1) ? 4 : 16; u.L = SEQ / u.dl;
    if (u.gi < 2) { const int npj = u.L >> 8; u.j = blk8 / npj; u.Q0 = (blk8 % npj) << 8; } else { u.j = 2 * blk8; u.Q0 = 0; }
    u.rowb = (size_t)u.b * SEQ; return u;
}
DI void a_wave_geom(const AUnit& u, int wave, int& qsub, int& kj_first, int& slot_first, int& jq) {
    jq = u.j;
    if (u.gi < 2) { qsub = u.Q0 + 32 * wave; kj_first = qsub - 64; slot_first = 32 * wave; }
    else { const int sub = wave >> 2; jq = u.j + sub; qsub = 32 * (wave & 3); kj_first = qsub - 64; slot_first = sub * 128 + kj_first; }
}
DI void a_issue(const AUnit& u, const bf16_t* Q, const bf16_t* K, const bf16_t* V, int tid, int lane, int wave, u32x4 (&kv)[6], u32x4 (&vv)[6], unsigned& okm, bf16x8 (&qf)[4]) {
    const int nsl = (u.gi < 2) ? 384 : 256; okm = 0u;
#pragma unroll
    for (int i = 0; i < 6; ++i) {
        const int p = tid + i * 512, slot = p >> 3, c16 = p & 7; size_t row; bool ok = slot < nsl;
        if (u.gi < 2) { const int kj = u.Q0 - 64 + slot; ok = ok && (kj >= 0 && kj < u.L); row = u.rowb + (size_t)kj * u.dl + u.j; }
        else { row = u.rowb + (size_t)(slot & 127) * 16 + u.j + (slot >> 7); }
        if (ok) { kv[i] = *(const u32x4*)(K + row * 768 + u.head * 64 + c16 * 8); vv[i] = *(const u32x4*)(V + row * 768 + u.head * 64 + c16 * 8); okm |= 1u << i; }
    }
    int qsub, kj_first, slot_first, jq; a_wave_geom(u, wave, qsub, kj_first, slot_first, jq);
    const size_t rowq = u.rowb + (size_t)(qsub + (lane & 31)) * u.dl + jq;
    const bf16_t* qrow = Q + rowq * 768 + u.head * 64;
#pragma unroll
    for (int s = 0; s < 4; ++s) qf[s] = *(const bf16x8*)(qrow + 16 * s + 8 * (lane >> 5));
}
DI void a_fill(LAS unsigned char* lds, int tid, const u32x4 (&kv)[6], const u32x4 (&vv)[6], unsigned okm) {
#pragma unroll
    for (int i = 0; i < 6; ++i) { const int p = tid + i * 512, slot = p >> 3, c16 = p & 7;
        if (okm & (1u << i)) { *(LAS u32x4*)(lds + kimg64(slot, c16)) = kv[i]; *(LAS u32x4*)(lds + A_VOFF + slot * A_VS + c16 * 16) = vv[i]; } }
}
DI void a_compute(const AUnit& u, const bf16x8 (&qf)[4], bf16_t* PO, float* LSE, LAS unsigned char* lds, int lane, int wave) {
    const int gi = u.gi, hs = u.hs, dl = u.dl, L = u.L; const size_t rowb = u.rowb;
    const int r32 = lane & 31, h = lane >> 5;
    int qsub, kj_first, slot_first, jq; a_wave_geom(u, wave, qsub, kj_first, slot_first, jq);
    const size_t rowq = rowb + (size_t)(qsub + r32) * dl + jq;
    f32x16 o[2];
#pragma unroll
    for (int dt = 0; dt < 2; ++dt)
#pragma unroll
        for (int r = 0; r < 16; ++r) o[dt][r] = 0.f;
    float m = -INFINITY, lp = 0.f;
    const int q4 = (lane & 15) >> 2, p4 = lane & 3, blk = (lane >> 4) & 1;
    const int troff = (4 * h + q4) * A_VS + blk * 32 + p4 * 8;
#pragma unroll
    for (int ci = 0; ci < 5; ++ci) {
        const int c = (ci == 0 ? 2 : ci == 1 ? 1 : ci == 2 ? 3 : ci == 3 ? 0 : 4);
        const int kj = kj_first + 32 * c;
        if (kj < 0 || kj >= L) continue;
        const int slot0 = slot_first + 32 * c, ks = slot0 + r32;
        const LAS unsigned char* kp = lds + ks * 128; const int kx = (ks >> 1) & 7;
        f32x16 S;
        const float ninit = (ci == 0) ? 0.f : -m;
#pragma unroll
        for (int r = 0; r < 16; ++r) S[r] = ninit;
#pragma unroll
        for (int s = 0; s < 4; ++s) { const bf16x8 kf = *(const LAS bf16x8*)(kp + (((2 * s + h) ^ kx) << 4)); S = MFMA32(kf, qf[s], S); }
        if (c == 0) {
#pragma unroll
            for (int r = 0; r < 16; ++r) if (crow(r, h) < r32) S[r] = -INFINITY;
        }
        if (c == 4) {
#pragma unroll
            for (int r = 0; r < 16; ++r) if (crow(r, h) > r32) S[r] = -INFINITY;
        }
        float mx = S[0];
#pragma unroll
        for (int r = 1; r < 16; ++r) mx = fmaxf(mx, S[r]);
        mx = fmaxf(mx, __shfl_xor(mx, 32));
        if (ci == 0 || __builtin_amdgcn_ballot_w64(mx > 8.f) != 0ull) {
            const float d = (ci == 0) ? mx : fmaxf(mx, 0.f), al = fexp2(-d);
            m = ((ci == 0) ? 0.f : m) + d; lp *= al;
#pragma unroll
            for (int r = 0; r < 16; ++r) S[r] -= d;
#pragma unroll
            for (int dt = 0; dt < 2; ++dt)
#pragma unroll
                for (int r = 0; r < 16; ++r) o[dt][r] *= al;
        }
        float rsum = 0.f;
#pragma unroll
        for (int r = 0; r < 16; ++r) { S[r] = fexp2(S[r]); rsum += S[r]; }
        lp += rsum;
        bf16x8 pb[2];
#pragma unroll
        for (int s2 = 0; s2 < 2; ++s2) { u32x4 w; w.x = pk2(S[8 * s2], S[8 * s2 + 1]); w.y = pk2(S[8 * s2 + 2], S[8 * s2 + 3]); w.z = pk2(S[8 * s2 + 4], S[8 * s2 + 5]); w.w = pk2(S[8 * s2 + 6], S[8 * s2 + 7]); pb[s2] = __builtin_bit_cast(bf16x8, w); }
        const LAS unsigned char* trp = lds + A_VOFF + slot0 * A_VS + troff;
#pragma unroll
        for (int dt = 0; dt < 2; ++dt)
#pragma unroll
            for (int s2 = 0; s2 < 2; ++s2) {
                const s16x4 lo = vtr(trp + (16 * s2) * A_VS + dt * 64), hi = vtr(trp + (16 * s2 + 8) * A_VS + dt * 64);
                const bf16x8 va = __builtin_shufflevector(lo, hi, 0, 1, 2, 3, 4, 5, 6, 7);
                o[dt] = MFMA32(va, pb[s2], o[dt]);
            }
    }
    const float l = lp + __shfl_xor(lp, 32), inv = 1.f / l;
    if (h == 0) LSE[((size_t)gi * NTOK + rowq) * 4 + hs] = m + __builtin_amdgcn_logf(l);
    __syncthreads();
    { LAS unsigned char* ot = lds + wave * 4096;
#pragma unroll
      for (int dt = 0; dt < 2; ++dt)
#pragma unroll
          for (int g4 = 0; g4 < 4; ++g4) { u32x2 w; w.x = pk2(o[dt][4 * g4] * inv, o[dt][4 * g4 + 1] * inv); w.y = pk2(o[dt][4 * g4 + 2] * inv, o[dt][4 * g4 + 3] * inv);
              *(LAS u32x2*)(ot + r32 * 128 + (32 * dt + 8 * g4 + 4 * h) * 2) = w; }
      asm volatile("s_waitcnt lgkmcnt(0)" ::: "memory");
#pragma unroll
      for (int i = 0; i < 4; ++i) { const int q = i * 8 + (lane >> 3), c16 = lane & 7;
          const u32x4 w = *(const LAS u32x4*)(ot + q * 128 + c16 * 16);
          const size_t rq = rowb + (size_t)(qsub + q) * dl + jq;
          *(u32x4*)(PO + ((size_t)gi * NTOK + rq) * 256 + hs * 64 + c16 * 8) = w; }
    }
    __syncthreads();
}


DI void attnM_wg(int wu, const bf16_t* QM, const bf16_t* KM, const bf16_t* VM, const float* gqm, const float* gkm, bf16_t* AM, LAS unsigned char* lds, int tid, int lane, int wave) {
    const int qblk = wu & 7, head = (wu >> 3) & 3, b = wu >> 5;
    { const bf16_t* kb = KM + (size_t)b * NMEM * 512 + head * 128; const bf16_t* vb = VM + (size_t)b * NMEM * 512 + head * 128;
      u32x4 kv[8], vv[8];
#pragma unroll
      for (int i = 0; i < 8; ++i) { const int p = tid + i * 512, row = p >> 4, ch = p & 15;
          kv[i] = *(const u32x4*)(kb + (size_t)row * 512 + ch * 8); vv[i] = *(const u32x4*)(vb + (size_t)row * 512 + ch * 8); }
      const int chl = tid & 15; const f32x4 g0 = *(const f32x4*)(gkm + chl * 8), g1 = *(const f32x4*)(gkm + chl * 8 + 4);
#pragma unroll
      for (int i = 0; i < 8; ++i) { const int p = tid + i * 512, row = p >> 4, ch = p & 15;
          float x[8]; x[0] = bf_lo(kv[i].x); x[1] = bf_hi(kv[i].x); x[2] = bf_lo(kv[i].y); x[3] = bf_hi(kv[i].y); x[4] = bf_lo(kv[i].z); x[5] = bf_hi(kv[i].z); x[6] = bf_lo(kv[i].w); x[7] = bf_hi(kv[i].w);
          float ss = (x[0] * x[0] + x[1] * x[1]) + (x[2] * x[2] + x[3] * x[3]) + (x[4] * x[4] + x[5] * x[5]) + (x[6] * x[6] + x[7] * x[7]);
          ss += __shfl_xor(ss, 1); ss += __shfl_xor(ss, 2); ss += __shfl_xor(ss, 4); ss += __shfl_xor(ss, 8);
          const float rs = __builtin_amdgcn_rsqf(ss * (1.f / 128.f) + EPS);
          u32x4 kn; kn.x = pk2(x[0] * rs * g0.x, x[1] * rs * g0.y); kn.y = pk2(x[2] * rs * g0.z, x[3] * rs * g0.w); kn.z = pk2(x[4] * rs * g1.x, x[5] * rs * g1.y); kn.w = pk2(x[6] * rs * g1.z, x[7] * rs * g1.w);
          const int off = img256(row, ch); *(LAS u32x4*)(lds + off) = kn; *(LAS u32x4*)(lds + M_VOFF + off) = vv[i]; } }
    __syncthreads();
    const int r32 = lane & 31, h = lane >> 5;
    const int q4 = (lane & 15) >> 2, p4 = lane & 3, blk = (lane >> 4) & 1;
    const int kxor = ((r32 & 3) << 2) | ((r32 >> 2) & 3);
    const int vlow0 = ((2 * blk + (p4 >> 1)) ^ (h & 3)) << 4, vlow1 = ((2 * blk + (p4 >> 1)) ^ ((h + 2) & 3)) << 4;
    {
        const size_t rowq = (size_t)b * SEQ + qblk * 256 + wave * 32 + r32;
        const bf16_t* qrow = QM + rowq * 512 + head * 128;
        bf16x8 qf[8];
#pragma unroll
        for (int s = 0; s < 8; ++s) qf[s] = *(const bf16x8*)(qrow + 16 * s + 8 * h);
        { float ss = 0.f;
#pragma unroll
          for (int s = 0; s < 8; ++s)
#pragma unroll
              for (int jx = 0; jx < 8; ++jx) { const float x = bf2f(qf[s][jx]); ss += x * x; }
          ss += __shfl_xor(ss, 32);
          const float rs = __builtin_amdgcn_rsqf(ss * (1.f / 128.f) + EPS) * QSCALE_M;
#pragma unroll
          for (int s = 0; s < 8; ++s) {
              const f32x4 g0 = *(const f32x4*)(gqm + 16 * s + 8 * h), g1 = *(const f32x4*)(gqm + 16 * s + 8 * h + 4);
              u32x4 w;
              w.x = pk2(bf2f(qf[s][0]) * rs * g0.x, bf2f(qf[s][1]) * rs * g0.y); w.y = pk2(bf2f(qf[s][2]) * rs * g0.z, bf2f(qf[s][3]) * rs * g0.w);
              w.z = pk2(bf2f(qf[s][4]) * rs * g1.x, bf2f(qf[s][5]) * rs * g1.y); w.w = pk2(bf2f(qf[s][6]) * rs * g1.z, bf2f(qf[s][7]) * rs * g1.w);
              qf[s] = __builtin_bit_cast(bf16x8, w); } }
        f32x16 o[4];
#pragma unroll
        for (int dt = 0; dt < 4; ++dt)
#pragma unroll
            for (int r = 0; r < 16; ++r) o[dt][r] = 0.f;
        float m = -INFINITY, lp = 0.f;
#pragma unroll 1
        for (int c = 0; c < 8; ++c) {
            const int slot0 = 32 * c;
            const LAS unsigned char* kp = lds + (slot0 + r32) * 256;
            f32x16 S;
            const float ninit = (c == 0) ? 0.f : -m;
#pragma unroll
            for (int r = 0; r < 16; ++r) S[r] = ninit;
#pragma unroll
            for (int s = 0; s < 8; ++s) { const bf16x8 kf = *(const LAS bf16x8*)(kp + (((2 * s + h) ^ kxor) << 4)); S = MFMA32(kf, qf[s], S); }
            float mx = S[0];
#pragma unroll
            for (int r = 1; r < 16; ++r) mx = fmaxf(mx, S[r]);
            mx = fmaxf(mx, __shfl_xor(mx, 32));
            if (c == 0 || __builtin_amdgcn_ballot_w64(mx > 8.f) != 0ull) {
                const float d = (c == 0) ? mx : fmaxf(mx, 0.f), al = fexp2(-d);
                m = ((c == 0) ? 0.f : m) + d; lp *= al;
#pragma unroll
                for (int r = 0; r < 16; ++r) S[r] -= d;
#pragma unroll
                for (int dt = 0; dt < 4; ++dt)
#pragma unroll
                    for (int r = 0; r < 16; ++r) o[dt][r] *= al;
            }
            float rsum = 0.f;
#pragma unroll
            for (int r = 0; r < 16; ++r) { S[r] = fexp2(S[r]); rsum += S[r]; }
            lp += rsum;
            bf16x8 pb[2];
#pragma unroll
            for (int s2 = 0; s2 < 2; ++s2) { u32x4 w; w.x = pk2(S[8 * s2], S[8 * s2 + 1]); w.y = pk2(S[8 * s2 + 2], S[8 * s2 + 3]); w.z = pk2(S[8 * s2 + 4], S[8 * s2 + 5]); w.w = pk2(S[8 * s2 + 6], S[8 * s2 + 7]); pb[s2] = __builtin_bit_cast(bf16x8, w); }
            const LAS unsigned char* vp = lds + M_VOFF + (slot0 + 4 * h + q4) * 256 + (p4 & 1) * 8;
#pragma unroll
            for (int dt = 0; dt < 4; ++dt)
#pragma unroll
                for (int s2 = 0; s2 < 2; ++s2) {
                    const s16x4 lo = vtr(vp + (16 * s2) * 256 + ((dt ^ q4) << 6) + vlow0), hi = vtr(vp + (16 * s2 + 8) * 256 + ((dt ^ q4) << 6) + vlow1);
                    const bf16x8 va = __builtin_shufflevector(lo, hi, 0, 1, 2, 3, 4, 5, 6, 7);
                    o[dt] = MFMA32(va, pb[s2], o[dt]);
                }
        }
        const float l = lp + __shfl_xor(lp, 32), inv = 1.f / l;
        __syncthreads();
        LAS unsigned char* ot = lds + wave * 8192;
#pragma unroll
        for (int dt = 0; dt < 4; ++dt)
#pragma unroll
            for (int g4 = 0; g4 < 4; ++g4) { u32x2 w; w.x = pk2(o[dt][4 * g4] * inv, o[dt][4 * g4 + 1] * inv); w.y = pk2(o[dt][4 * g4 + 2] * inv, o[dt][4 * g4 + 3] * inv);
                *(LAS u32x2*)(ot + r32 * 256 + (32 * dt + 8 * g4 + 4 * h) * 2) = w; }
        asm volatile("s_waitcnt lgkmcnt(0)" ::: "memory");
        const size_t rowq0 = (size_t)b * SEQ + qblk * 256 + wave * 32;
#pragma unroll
        for (int i = 0; i < 8; ++i) { const int q = i * 4 + (lane >> 4), c16 = lane & 15;
            const u32x4 w = *(const LAS u32x4*)(ot + q * 256 + c16 * 16);
            *(u32x4*)(AM + (rowq0 + q) * 1536 + 1024 + head * 128 + c16 * 8) = w; }
    }
    __syncthreads();
}

DI void p2_attnA(const Args& a, LAS unsigned char* lds, int tid, int lane, int wave) {
    unsigned char* ws = a.ws; const int G = gridDim.x; const int vcu = (G % 8 == 0) ? ((int)blockIdx.x % 8) * (G / 8) + (int)blockIdx.x / 8 : (int)blockIdx.x;
    const bf16_t* Q = (const bf16_t*)(ws + WS_Q); const bf16_t* K = (const bf16_t*)(ws + WS_K); const bf16_t* V = (const bf16_t*)(ws + WS_V);
    bf16_t* PO = (bf16_t*)(ws + WS_PO); float* LSE = (float*)(ws + WS_LSE);
    constexpr int NU = NB * 12 * 8;
    const int per = (NU + G - 1) / G, u0 = vcu * per, u1 = (u0 + per < NU) ? u0 + per : NU;
    if (u0 >= u1) return;
    u32x4 kv[6], vv[6]; unsigned okm; bf16x8 qn[4];
    AUnit cu = a_decode(u0);
    a_issue(cu, Q, K, V, tid, lane, wave, kv, vv, okm, qn);
    for (int u = u0; u < u1; ++u) {
        a_fill(lds, tid, kv, vv, okm);
        bf16x8 qf[4];
#pragma unroll
        for (int s = 0; s < 4; ++s) qf[s] = qn[s];
        __syncthreads();
        AUnit nu = cu;
        if (u + 1 < u1) { nu = a_decode(u + 1); a_issue(nu, Q, K, V, tid, lane, wave, kv, vv, okm, qn); }
        a_compute(cu, qf, PO, LSE, lds, lane, wave);
        cu = nu;
    }
}
DI void p2_attnM(const Args& a, LAS unsigned char* lds, int tid, int lane, int wave) {
    unsigned char* ws = a.ws; unsigned char* dob = (unsigned char*)a.out; const int G = gridDim.x; const int vcu = (G % 8 == 0) ? ((int)blockIdx.x % 8) * (G / 8) + (int)blockIdx.x / 8 : (int)blockIdx.x;
    bf16_t* AM = (bf16_t*)(ws + WS_AM);
    const bf16_t* QM = (const bf16_t*)(dob + DO_QM); const bf16_t* KM = (const bf16_t*)(dob + DO_KM); const bf16_t* VM = (const bf16_t*)(dob + DO_VM);
    for (int u = vcu; u < NB * 4 * 8; u += G) attnM_wg(u, QM, KM, VM, (const float*)a.in[I_GQM], (const float*)a.in[I_GKM], AM, lds, tid, lane, wave);
}
DI void p2_conv(const Args& a, int tid) {
    unsigned char* ws = a.ws; bf16_t* AM = (bf16_t*)(ws + WS_AM);
    const bf16_t* U = (const bf16_t*)(ws + WS_U); const bf16_t* CB = (const bf16_t*)(ws + WS_CB); const float* wc = (const float*)a.in[I_WCONV];
    const int gt = blockIdx.x * 512 + tid, NT = gridDim.x * 512;
    constexpr int TB = 8;
    for (int idx = gt; idx < (NTOK / TB) * 96; idx += NT) {
        const int tb = idx / 96, c8 = (idx % 96) * 8, row0 = tb * TB, s0 = row0 & (SEQ - 1);
        u32x4 uu[TB + 2], cb[TB];
        const u32x4 zero = {0u, 0u, 0u, 0u};
        uu[0] = (s0 > 0) ? *(const u32x4*)(U + (size_t)(row0 - 1) * 768 + c8) : zero;
#pragma unroll
        for (int t = 0; t < TB; ++t) { uu[t + 1] = *(const u32x4*)(U + (size_t)(row0 + t) * 768 + c8); cb[t] = *(const u32x4*)(CB + (size_t)(row0 + t) * 768 + c8); }
        uu[TB + 1] = (s0 + TB < SEQ) ? *(const u32x4*)(U + (size_t)(row0 + TB) * 768 + c8) : zero;
        float k0[8], k1[8], k2[8];
        { const f32x4 a0 = *(const f32x4*)(wc + c8), a1 = *(const f32x4*)(wc + c8 + 4), b0 = *(const f32x4*)(wc + 768 + c8), b1 = *(const f32x4*)(wc + 768 + c8 + 4),
                      d0 = *(const f32x4*)(wc + 1536 + c8), d1 = *(const f32x4*)(wc + 1536 + c8 + 4);
#pragma unroll
          for (int q = 0; q < 4; ++q) { k0[q] = a0[q]; k0[4 + q] = a1[q]; k1[q] = b0[q]; k1[4 + q] = b1[q]; k2[q] = d0[q]; k2[4 + q] = d1[q]; } }
#pragma unroll
        for (int t = 0; t < TB; ++t) {
            u32x4 o;
#pragma unroll
            for (int w = 0; w < 4; ++w) {
                const float y0 = k0[2 * w] * bf_lo(uu[t][w]) + k1[2 * w] * bf_lo(uu[t + 1][w]) + k2[2 * w] * bf_lo(uu[t + 2][w]);
                const float y1 = k0[2 * w + 1] * bf_hi(uu[t][w]) + k1[2 * w + 1] * bf_hi(uu[t + 1][w]) + k2[2 * w + 1] * bf_hi(uu[t + 2][w]);
                o[w] = pk2(bf_lo(cb[t][w]) * y0, bf_hi(cb[t][w]) * y1);
            }
            *(u32x4*)(AM + (size_t)(row0 + t) * 1536 + 256 + c8) = o;
        }
    }
}
#ifndef P2_REP
#define P2_REP 0
#endif
DI void phase2(const Args& a, LAS unsigned char* lds, int tid, int lane, int wave) {
#ifndef P2_PARTS
#define P2_PARTS 7
#endif
    if constexpr (P2_PARTS & 1) p2_attnA(a, lds, tid, lane, wave);
    if constexpr (P2_REP & 1) p2_attnA(a, lds, tid, lane, wave);
    __builtin_amdgcn_sched_barrier(0); asm volatile("" ::: "memory");
    if constexpr (P2_PARTS & 2) p2_attnM(a, lds, tid, lane, wave);
    if constexpr (P2_REP & 2) p2_attnM(a, lds, tid, lane, wave);
    if constexpr (P2_PARTS & 4) p2_conv(a, tid);
    if constexpr (P2_REP & 4) p2_conv(a, tid);
}

DI void attn_combine(const Args& a, int tid) {
    unsigned char* ws = a.ws;
    const bf16_t* PO = (const bf16_t*)(ws + WS_PO); const float* LSE = (const float*)(ws + WS_LSE); bf16_t* AM = (bf16_t*)(ws + WS_AM);
    const int gt = blockIdx.x * 512 + tid, NT = gridDim.x * 512;
    for (int idx = gt; idx < NTOK * 32; idx += NT) {
        const int row = idx >> 5, c8 = (idx & 31) * 8, hs = c8 >> 6;
        const float l0 = LSE[(size_t)row * 4 + hs], l1 = LSE[((size_t)NTOK + row) * 4 + hs], l2 = LSE[((size_t)2 * NTOK + row) * 4 + hs];
        const float mx = fmaxf(l0, fmaxf(l1, l2)); float w0 = fexp2(l0 - mx), w1 = fexp2(l1 - mx), w2 = fexp2(l2 - mx);
        const float inv = 1.f / (w0 + w1 + w2); w0 *= inv; w1 *= inv; w2 *= inv;
        const u32x4 a0 = *(const u32x4*)(PO + (size_t)row * 256 + c8), a1 = *(const u32x4*)(PO + ((size_t)NTOK + row) * 256 + c8), a2 = *(const u32x4*)(PO + ((size_t)2 * NTOK + row) * 256 + c8);
        u32x4 o;
#pragma unroll
        for (int w = 0; w < 4; ++w) o[w] = pk2(w0 * bf_lo(a0[w]) + w1 * bf_lo(a1[w]) + w2 * bf_lo(a2[w]), w0 * bf_hi(a0[w]) + w1 * bf_hi(a1[w]) + w2 * bf_hi(a2[w]));
        *(u32x4*)(AM + (size_t)row * 1536 + c8) = o;
    }
}

DI void phase6(const Args& a, LAS unsigned char* lds, int tid, int lane, int wave) {
    unsigned char* ws = a.ws;
    const bf16_t* XB = (const bf16_t*)(ws + WS_XB);
    const bf16_t* WH = (const bf16_t*)(ws + WS_WRH); const bf16_t* WL = (const bf16_t*)(ws + WS_WRL);
    const float* brg = (const float*)a.in[I_BRG]; const float* bre = (const float*)a.in[I_BRE];
    int* tok_e = (int*)(ws + WS_RT + RT_TOKE); int* tok_rank = (int*)(ws + WS_RT + RT_RANK); float* tok_w = (float*)(ws + WS_RT + RT_W);
    float* tok_rstd = (float*)(ws + WS_RT + RT_RSTD); int* ccnt = (int*)(ws + WS_RT + RT_CCNT);
    LAS int* asg = (LAS int*)(lds + 32768);
    LAS int* rnk = (LAS int*)(lds + 32768 + 1024);
    bool first = true;
    for (int chunk = blockIdx.x; chunk < NTOK / 128; chunk += gridDim.x) {
        {
            constexpr int WP = 272;
            constexpr int SLB = 48 * WP;
            LAS unsigned char* wbuf = lds + 40960;
            LAS float* lg = (LAS float*)(lds + wave * 4096);
            const int t0 = chunk * 128 + wave * 16, row = lane & 15, kq = lane >> 4;
            const bf16_t* xp = XB + (size_t)(t0 + row) * 1024 + 8 * kq;
            u32x4 wst[3];
#define RT_STAGE_LOAD(sl) do { _Pragma("unroll") for (int i = 0; i < 3; ++i) { const int p = tid + i * 512, arr = p / 768, q = p % 768, r = q >> 4, c = q & 15; \
                wst[i] = *(const u32x4*)((arr ? WL : WH) + (size_t)r * 1024 + (sl) * 128 + c * 8); } } while (0)
#define RT_STAGE_WRITE(buf) do { _Pragma("unroll") for (int i = 0; i < 3; ++i) { const int p = tid + i * 512, arr = p / 768, q = p % 768, r = q >> 4, c = q & 15; \
                *(LAS u32x4*)(wbuf + ((buf) * 2 + arr) * SLB + r * WP + c * 16) = wst[i]; } } while (0)
            RT_STAGE_LOAD(0); RT_STAGE_WRITE(0);
            __syncthreads();
            pg8::f32x4 acc[3]; acc[0] = acc[1] = acc[2] = (pg8::f32x4){0.f, 0.f, 0.f, 0.f};
            float ss = 0.f, amax = 0.f;
#pragma unroll 1
            for (int sl = 0; sl < 8; ++sl) {
                if (sl + 1 < 8) RT_STAGE_LOAD(sl + 1);
                u32x4 xv[4];
#pragma unroll
                for (int ks = 0; ks < 4; ++ks) xv[ks] = *(const u32x4*)(xp + sl * 128 + 32 * ks);
                const LAS unsigned char* wb = wbuf + (sl & 1) * 2 * SLB;
#pragma unroll
                for (int ks = 0; ks < 4; ++ks) {
                    const u32x4 hi = xv[ks];
#pragma unroll
                    for (int w = 0; w < 4; ++w) { const float e0 = bf_lo(hi[w]), e1 = bf_hi(hi[w]); ss += e0 * e0 + e1 * e1; amax = fmaxf(amax, fmaxf(fabsf(e0), fabsf(e1))); }
                    const bf16x8 ah = __builtin_bit_cast(bf16x8, hi);
#pragma unroll
                    for (int nt = 0; nt < 3; ++nt) {
                        const bf16x8 bh = *(const LAS bf16x8*)(wb + (16 * nt + row) * WP + (32 * ks + 8 * kq) * 2);
                        const bf16x8 bl = *(const LAS bf16x8*)(wb + SLB + (16 * nt + row) * WP + (32 * ks + 8 * kq) * 2);
                        acc[nt] = MFMA16(ah, bh, acc[nt]); acc[nt] = MFMA16(ah, bl, acc[nt]);
                    }
                }
                if (sl + 1 < 8) RT_STAGE_WRITE((sl + 1) & 1);
                __syncthreads();
            }
#undef RT_STAGE_LOAD
#undef RT_STAGE_WRITE
            ss += __shfl_xor(ss, 16); ss += __shfl_xor(ss, 32);
            amax = fmaxf(amax, __shfl_xor(amax, 16)); amax = fmaxf(amax, __shfl_xor(amax, 32));
            {
#pragma unroll 4
                for (int r = 0; r < 16; ++r) { const float am = __shfl(amax, r); const float inv = am > 0.f ? 127.f / am : 0.f;
                    const bf16_t* rp = XB + (size_t)(t0 + r) * 1024 + 16 * lane; const u32x4 x0 = *(const u32x4*)rp, x1 = *(const u32x4*)(rp + 8);
                    u32x4 o; o.x = q8x4(bf_lo(x0.x) * inv, bf_hi(x0.x) * inv, bf_lo(x0.y) * inv, bf_hi(x0.y) * inv); o.y = q8x4(bf_lo(x0.z) * inv, bf_hi(x0.z) * inv, bf_lo(x0.w) * inv, bf_hi(x0.w) * inv);
                    o.z = q8x4(bf_lo(x1.x) * inv, bf_hi(x1.x) * inv, bf_lo(x1.y) * inv, bf_hi(x1.y) * inv); o.w = q8x4(bf_lo(x1.z) * inv, bf_hi(x1.z) * inv, bf_lo(x1.w) * inv, bf_hi(x1.w) * inv);
                    *(u32x4*)(ws + WS_XB8 + (size_t)(t0 + r) * 1024 + 16 * lane) = o; }
            }
#pragma unroll
            for (int nt = 0; nt < 3; ++nt)
#pragma unroll
                for (int r = 0; r < 4; ++r) lg[(kq * 4 + r) * 48 + 16 * nt + row] = acc[nt][r];
            asm volatile("s_waitcnt lgkmcnt(0)" ::: "memory");
            if (lane < 16) {
                const int tok = t0 + lane; const float rstd = __builtin_amdgcn_rsqf(ss * (1.f / 1024.f) + EPS);
                const LAS float* lp = lg + lane * 48;
                float gv[4]; int g = 0;
#pragma unroll
                for (int n = 0; n < 4; ++n) gv[n] = lp[n] * rstd + brg[n];
                float gm = gv[0];
#pragma unroll
                for (int n = 1; n < 4; ++n) if (gv[n] > gm) { gm = gv[n]; g = n; }
                float gz = 0.f;
#pragma unroll
                for (int n = 0; n < 4; ++n) gz += fexp(gv[n] - gm);
                const float pg = 1.f / gz;
                float sv[8];
#pragma unroll
                for (int e = 0; e < 8; ++e) sv[e] = lp[4 + 8 * g + e] * rstd + bre[8 * g + e];
                int i0 = 0; float s0 = sv[0];
#pragma unroll
                for (int e = 1; e < 8; ++e) if (sv[e] > s0) { s0 = sv[e]; i0 = e; }
                int i1 = -1; float s1 = -INFINITY;
#pragma unroll
                for (int e = 0; e < 8; ++e) if (e != i0 && sv[e] > s1) { s1 = sv[e]; i1 = e; }
                const float r = fexp(s1 - s0), w0 = pg / (1.f + r), w1 = w0 * r;
                const int al2 = (wave * 16 + lane) * 2;
                asg[al2] = g * 8 + i0; asg[al2 + 1] = g * 8 + i1;
                tok_w[tok * 2] = w0; tok_w[tok * 2 + 1] = w1; tok_rstd[tok] = rstd * amax * (1.f / 127.f);
            }
        }
        first = false;
        __syncthreads();
        int my_e = 0, my_rank = 0;
        if (tid < 256) { my_e = asg[tid];
            for (int ee = 0; ee < 32; ++ee) { const unsigned long long mk = __ballot(my_e == ee);
                if (my_e == ee) my_rank = __popcll(mk & ((1ull << lane) - 1ull));
                if (lane == 0) rnk[wave * 32 + ee] = __popcll(mk); } }
        __syncthreads();
        if (tid < 256) { int base = 0;
            for (int w = 0; w < wave; ++w) base += rnk[w * 32 + my_e];
            const int tok = chunk * 128 + (tid >> 1); tok_e[tok * 2 + (tid & 1)] = my_e; tok_rank[tok * 2 + (tid & 1)] = base + my_rank; }
        if (tid < 32) ccnt[chunk * 32 + tid] = rnk[tid] + rnk[32 + tid] + rnk[64 + tid] + rnk[96 + tid];
        __syncthreads();
    }
}

DI void moe_weight_convert(const Args& a, int cw, int NCW, int lane) {
    unsigned char* ws = a.ws;
    unsigned char* WGU = ws + WS_WGU; bf16_t* WD = (bf16_t*)(ws + WS_WD); float* SB = (float*)(ws + WS_SB);
    const float* wg = (const float*)a.in[I_WGATE]; const float* wu = (const float*)a.in[I_WUP]; const float* wd = (const float*)a.in[I_WDOWN]; const float* gf = (const float*)a.in[I_GFFN];
    constexpr int I_GU = 32 * 128, I_D = 32 * 8 * 32;
    for (int it = cw; it < I_GU + I_D; it += NCW) {
        if (it < I_GU) { const int e = it >> 7, nb8 = it & 127;
            const int t = nb8 >> 5, c = (nb8 & 31) * 8; const bool up = c >= 128; const int ff = 128 * t + (up ? c - 128 : c);
            quant_gu_item((up ? wu : wg) + (size_t)e * 1024 * 512, ff, WGU + (size_t)e * 1024 * 1024, nb8 * 8, gf, SB + (size_t)e * 1024 + nb8 * 8, lane);
        } else { const int r2 = it - I_GU, e = r2 >> 8, r = r2 & 255, kb = r >> 5, nb = r & 31;
            transpose_item(wd + (size_t)e * 512 * 1024, 1024, kb * 64, nb * 32, WD + (size_t)e * 1024 * 512, 512, nb * 32, kb * 64, nullptr, nullptr, lane); }
    }
}

DI void phase7(const Args& a, LAS unsigned char* lds, int tid, int lane, int wave) {
    unsigned char* ws = a.ws;
    const int* tok_e = (const int*)(ws + WS_RT + RT_TOKE); const int* tok_rank = (const int*)(ws + WS_RT + RT_RANK); const float* tok_w = (const float*)(ws + WS_RT + RT_W);
    const float* tok_rstd = (const float*)(ws + WS_RT + RT_RSTD); const int* ccnt = (const int*)(ws + WS_RT + RT_CCNT); int* meta = (int*)(ws + WS_RT + RT_META);
    u32x2* sr_dw = (u32x2*)(ws + WS_SROW);
    int* rowtok = (int*)(ws + WS_SROW + 640 * 1024); float* sr_rstd = (float*)(ws + WS_SROW + 960 * 1024);
    LAS int* red = (LAS int*)lds;
    LAS int* tot = red + 1024;
    LAS int* bef = tot + 32;
    LAS int* pst = bef + 32;
    for (int chunk = blockIdx.x; chunk < NTOK / 128; chunk += gridDim.x) {
        { const int e = tid & 31, cgp = tid >> 5; int pt = 0, pb = 0;
          for (int c = cgp * 16; c < cgp * 16 + 16; ++c) { const int v = ccnt[c * 32 + e]; pt += v; if (c < chunk) pb += v; }
          red[cgp * 32 + e] = pt; red[512 + cgp * 32 + e] = pb; }
        __syncthreads();
        if (tid < 32) { int t = 0, b = 0; for (int q = 0; q < 16; ++q) { t += red[q * 32 + tid]; b += red[512 + q * 32 + tid]; } tot[tid] = t; bef[tid] = b; }
        __syncthreads();
        if (tid == 0) { int p = 0; for (int e = 0; e < 32; ++e) { pst[e] = p; p += (tot[e] + 255) & ~255; } pst[32] = p; }
        __syncthreads();
        if (lane < 16) {
            const int tokl = chunk * 128 + wave * 16 + lane;
            const int e0 = tok_e[tokl * 2], e1 = tok_e[tokl * 2 + 1], r0 = tok_rank[tokl * 2], r1 = tok_rank[tokl * 2 + 1];
            const float w0 = tok_w[tokl * 2], w1 = tok_w[tokl * 2 + 1], rs = tok_rstd[tokl];
            const int d0 = pst[e0] + bef[e0] + r0, d1 = pst[e1] + bef[e1] + r1;
            u32x2 r0v; r0v.x = (unsigned)(tokl * 2); r0v.y = __float_as_uint(w0); sr_dw[d0] = r0v; u32x2 r1v; r1v.x = (unsigned)(tokl * 2 + 1); r1v.y = __float_as_uint(w1); sr_dw[d1] = r1v;
            rowtok[d0] = tokl; rowtok[d1] = tokl; sr_rstd[d0] = rs; sr_rstd[d1] = rs;
        }
        if (chunk < 32) { const int e = chunk, p0 = pst[e], pe = pst[e + 1];
            for (int r = p0 + tot[e] + tid; r < pe; r += 512) { u32x2 z; z.x = 0xffffffffu; z.y = 0u; sr_dw[r] = z; rowtok[r] = 0; sr_rstd[r] = 0.f; } }
        if (chunk == 0) { const int nt = pst[32] >> 8; if (tid == 0) meta[0] = nt;
            for (int t = tid; t < nt; t += 512) { int e = 0; for (int q = 1; q < 32; ++q) if ((pst[q] >> 8) <= t) e = q; meta[1 + t] = e; } }
        __syncthreads();
    }
}

DI int load_tile_table(const Args& a, LAS unsigned char* lds, int tid) {
    const int* meta = (const int*)(a.ws + WS_RT + RT_META); LAS int* tbl = (LAS int*)(lds + MISC_OFF);
    const int nt = meta[0];
    for (int i = tid; i < nt; i += 512) tbl[i] = meta[1 + i];
    __syncthreads();
    return nt;
}

DI void phase10(const Args& a, int lane, int wave) {
    const bf16_t* Y = (const bf16_t*)(a.ws + WS_Y); const bf16_t* XB = (const bf16_t*)(a.ws + WS_XB); float* O = a.out;
    const int gw = blockIdx.x * 8 + wave, NGW = gridDim.x * 8;
    for (int tok = gw; tok < NTOK; tok += NGW) {
        u32x4 xv[2], y0[2], y1[2];
#pragma unroll
        for (int j = 0; j < 2; ++j) { const size_t c = (size_t)j * 512 + lane * 8;
            xv[j] = *(const u32x4*)(XB + (size_t)tok * 1024 + c); y0[j] = *(const u32x4*)(Y + (size_t)(tok * 2) * 1024 + c); y1[j] = *(const u32x4*)(Y + (size_t)(tok * 2 + 1) * 1024 + c); }
#pragma unroll
        for (int j = 0; j < 2; ++j) { const size_t c = (size_t)j * 512 + lane * 8;
            f32x4 o0, o1;
            o0.x = bf_lo(xv[j].x) + bf_lo(y0[j].x) + bf_lo(y1[j].x); o0.y = bf_hi(xv[j].x) + bf_hi(y0[j].x) + bf_hi(y1[j].x);
            o0.z = bf_lo(xv[j].y) + bf_lo(y0[j].y) + bf_lo(y1[j].y); o0.w = bf_hi(xv[j].y) + bf_hi(y0[j].y) + bf_hi(y1[j].y);
            o1.x = bf_lo(xv[j].z) + bf_lo(y0[j].z) + bf_lo(y1[j].z); o1.y = bf_hi(xv[j].z) + bf_hi(y0[j].z) + bf_hi(y1[j].z);
            o1.z = bf_lo(xv[j].w) + bf_lo(y0[j].w) + bf_lo(y1[j].w); o1.w = bf_hi(xv[j].w) + bf_hi(y0[j].w) + bf_hi(y1[j].w);
            __builtin_nontemporal_store(o0, (f32x4*)(O + (size_t)tok * 1024 + c)); __builtin_nontemporal_store(o1, (f32x4*)(O + (size_t)tok * 1024 + c + 4)); }
    }
}

#define VM_WAIT() asm volatile("s_waitcnt vmcnt(0)" ::: "memory")
#define XB_TMO      128
#define XB_XCNT(j)  (256  + 64 * (j))
#define XB_XSUB(j)  (1280 + 64 * (j))
#define XB_XGEN(j)  (2304 + 64 * (j))
#define XB_TOP      3328
#define XB_TOPGEN   3392
#define XCD_BAR_WORDS 3456
#define XB_SPIN_CAP (1u << 18)

__device__ __forceinline__ unsigned xb_ld(unsigned* p)              { return __hip_atomic_load(p, __ATOMIC_RELAXED, __HIP_MEMORY_SCOPE_AGENT); }
__device__ __forceinline__ unsigned xb_add(unsigned* p, unsigned v) { return __hip_atomic_fetch_add(p, v, __ATOMIC_RELAXED, __HIP_MEMORY_SCOPE_AGENT); }
__device__ __forceinline__ unsigned xb_xcc_id() { return (unsigned)__builtin_amdgcn_s_getreg((3 << 11) | 20) & 0xFu; }
#define XB_SPIN(cond, bar) do { unsigned _sp = 0; while (cond) { __builtin_amdgcn_s_sleep(1); \
    if ((++_sp & 255u) == 0u) { if (xb_ld(&(bar)[XB_TMO])) break; if (_sp > XB_SPIN_CAP) { atomicAdd(&(bar)[XB_TMO], 1u); break; } } } } while (0)

struct XcdBarrier {
    unsigned* bar; unsigned x;
    volatile LAS unsigned* st;
};

__device__ __forceinline__ XcdBarrier xcd_barrier_post(unsigned* bar, volatile LAS unsigned* st) {
    XcdBarrier b; b.bar = bar; b.x = xb_xcc_id(); b.st = st;
    if (threadIdx.x == 0) (void)xb_add(&bar[XB_XCNT(b.x)], 1u);
    return b;
}
__device__ __forceinline__ void xcd_barrier_complete(unsigned* bar, unsigned x, unsigned& nloc, unsigned& nx) {
    const unsigned G = gridDim.x * gridDim.y * gridDim.z;
    unsigned sum, cnt, mine, sp = 0u;
    for (;;) {
        sum = 0u; cnt = 0u; mine = 0u;
#pragma unroll
        for (unsigned j = 0; j < 16; ++j) { const unsigned c = xb_ld(&bar[XB_XCNT(j)]); sum += c; cnt += (c > 0u) ? 1u : 0u; mine = (j == x) ? c : mine; }
        if (sum == G) break;
        __builtin_amdgcn_s_sleep(1);
        if ((++sp & 255u) == 0u) { if (xb_ld(&bar[XB_TMO])) break; if (sp > XB_SPIN_CAP) { atomicAdd(&bar[XB_TMO], 1u); break; } }
    }
    nloc = mine > 0u ? mine : 1u; nx = cnt > 0u ? cnt : 1u;
}

__device__ __forceinline__ void xcd_barrier(const XcdBarrier& b) {
    asm volatile("s_waitcnt vmcnt(0)" ::: "memory");
    __syncthreads();
    if (threadIdx.x == 0) {
        unsigned* bar = b.bar;
        __builtin_amdgcn_s_waitcnt(0);
        unsigned nloc = b.st[0], nx = b.st[1];
        if (nloc == 0u) { xcd_barrier_complete(bar, b.x, nloc, nx); b.st[0] = nloc; b.st[1] = nx; }
        const unsigned old = xb_add(&bar[XB_XSUB(b.x)], 1u);
        const unsigned gen = old / nloc;
        if (old + 1u == (gen + 1u) * nloc) {
            __builtin_amdgcn_fence(__ATOMIC_RELEASE, "agent");
            asm volatile("s_waitcnt vmcnt(0)" ::: "memory");
            const unsigned og = xb_add(&bar[XB_TOP], 1u);
            const unsigned tg = og / nx;
            if (og + 1u == (tg + 1u) * nx) xb_add(&bar[XB_TOPGEN], 1u);
            else XB_SPIN(xb_ld(&bar[XB_TOPGEN]) == tg, bar);
            __builtin_amdgcn_fence(__ATOMIC_ACQUIRE, "agent");
            xb_add(&bar[XB_XGEN(b.x)], 1u);
            asm volatile("s_waitcnt vmcnt(0)" ::: "memory");
        } else {
            XB_SPIN(xb_ld(&bar[XB_XGEN(b.x)]) == gen, bar);
            __builtin_amdgcn_fence(__ATOMIC_ACQUIRE, "agent");
            asm volatile("s_waitcnt vmcnt(0)" ::: "memory");
        }
    }
    __syncthreads();
}

constexpr int N_PHASES = 11;
template <int K> DI void run_phase(const Args& a, LAS unsigned char* lds) {
    int tid = threadIdx.x; asm volatile("" : "+v"(tid));
    const int lane = tid & 63, wave = __builtin_amdgcn_readfirstlane(tid >> 6);
    unsigned char* ws = a.ws; unsigned char* dob = (unsigned char*)a.out; const int G = gridDim.x;
    if constexpr (K == 0) { phase0(a, lds, tid, lane, wave); }
    if constexpr (K == 1) {
        pg8::Gemm g{(const pg8::bf16_t*)(dob + DO_H), (const pg8::bf16_t*)(ws + WS_WIN), NTOK + NMROW, 9216, 1024};
        InOrder S; S.so.init(NTOK, 5120, G, (int)blockIdx.x); S.nmain = (NTOK / 256) * 20;
        EpiIn E{ws, (bf16_t*)(dob + DO_QM), (bf16_t*)(dob + DO_KM), (const float*)a.in[I_GQA], (const float*)a.in[I_GKA], (const float*)(ws + WS_ROPE)};
        pg8::gemm_phase<EpiIn, InOrder, true, true>(lds, g, S, E);
        {
            const int total = S.nmain + 64, rounds = (total + G - 1) / G, busy = total - (rounds - 1) * G;
            if ((int)blockIdx.x >= busy) moe_weight_convert(a, ((int)blockIdx.x - busy) * 8 + wave, (G - busy) * 8, lane);
            else if (busy == G) moe_weight_convert(a, (int)blockIdx.x * 8 + wave, G * 8, lane);
        }
    }
    if constexpr (K == 2) { phase2(a, lds, tid, lane, wave); }
    if constexpr (K == 3) {
        pg8::Gemm g{(const pg8::bf16_t*)(dob + DO_H), (const pg8::bf16_t*)(ws + WS_WIN) + (size_t)5120 * 1024, NTOK, 3072, 1024};
        pg8::StaticOrder S; S.init(NTOK, 3072, G, (int)blockIdx.x);
        EpiGate E{(unsigned char*)(ws + WS_G), 3072};
        pg8::gemm_phase<EpiGate, pg8::StaticOrder, true, true>(lds, g, S, E);
        attn_combine(a, tid);
    }
    if constexpr (K == 4) {
        pg8::Gemm g{(const pg8::bf16_t*)(ws + WS_AM), (const pg8::bf16_t*)(ws + WS_WMRG), NTOK, 1024, 1536};
        pg8::StaticOrder S; S.init(NTOK, 1024, G, (int)blockIdx.x);
        EpiMerge E{(const unsigned char*)(ws + WS_G), (bf16_t*)(ws + WS_MRG), 4, 16};
        pg8::gemm_phase<EpiMerge, pg8::StaticOrder, true, true>(lds, g, S, E);
    }
    if constexpr (K == 5) {
        pg8::Gemm g{(const pg8::bf16_t*)(ws + WS_MRG), (const pg8::bf16_t*)(ws + WS_WOUT), NTOK, 1024, 1024};
        pg8::StaticOrder S; S.init(NTOK, 1024, G, (int)blockIdx.x);
        EpiOut E{(const float*)a.in[I_X], a.out, (bf16_t*)(ws + WS_XB)};
        pg8::gemm_phase<EpiOut, pg8::StaticOrder, true, true>(lds, g, S, E);
    }
    if constexpr (K == 6) { phase6(a, lds, tid, lane, wave); }
    if constexpr (K == 7) { phase7(a, lds, tid, lane, wave); }
    if constexpr (K == 8) {
        const int nt = load_tile_table(a, lds, tid);
        LAS int* rowtab = (LAS int*)(lds + MISC_OFF + 1536);
        MoeOrder<true> S{(const LAS int*)(lds + MISC_OFF), nt, G, (int)blockIdx.x, rowtab};
        { const int* rowtok = (const int*)(ws + WS_SROW + 640 * 1024); Unit uu;
          for (int ui = 0; ui < 6; ++ui) { if (!S.next(ui, uu)) break; if (tid < 256) rowtab[ui * 256 + tid] = rowtok[uu.pm * 256 + tid]; } }
        __syncthreads();
        pg8::Gemm g{(const pg8::bf16_t*)(ws + WS_XB8), (const pg8::bf16_t*)(ws + WS_WGU), nt * 256, 1024, 512};
        EpiUp E{(const float*)(ws + WS_SROW + 960 * 1024), (const float*)(ws + WS_SB), (bf16_t*)(ws + WS_ACT)};
        pg8::gemm_phase<EpiUp, MoeOrder<true>, true, true, true>(lds, g, S, E);
    }
    if constexpr (K == 9) {
        const int nt = load_tile_table(a, lds, tid);
        pg8::Gemm g{(const pg8::bf16_t*)(ws + WS_ACT), (const pg8::bf16_t*)(ws + WS_WD), nt * 256, 1024, 512};
        MoeOrder<false> S{(const LAS int*)(lds + MISC_OFF), nt, G, (int)blockIdx.x, nullptr};
        EpiDown E{(const u32x2*)(ws + WS_SROW), (bf16_t*)(ws + WS_Y)};
        pg8::gemm_phase<EpiDown, MoeOrder<false>, true, true>(lds, g, S, E);
    }
    if constexpr (K == 10) { phase10(a, lane, wave); }
}

#ifndef PH_MASK
#define PH_MASK 0x7ff
#endif
#ifndef USE_CG_SEAM0
#define USE_CG_SEAM0 0
#endif
#ifndef REP_MASK
#define REP_MASK 0x000
#endif
__global__ void __launch_bounds__(512, 2) mk_fwd(Args a) {
    extern __shared__ __attribute__((aligned(16))) unsigned char lds_raw[];
    LAS unsigned char* lds = (LAS unsigned char*)lds_raw;
    const int tid = threadIdx.x;
    const int lo = a.ph_lo, hi = a.ph_hi;
    cg::grid_group grid = cg::this_grid();
    volatile LAS unsigned* bst = (volatile LAS unsigned*)(lds + MISC_OFF + 8192);
    if (tid < 2) bst[tid] = 0u;
    __syncthreads();
    XcdBarrier bar = xcd_barrier_post((unsigned*)(a.ws + WS_CTL) + 1024, bst);
#define IN(k) ((((PH_MASK) >> (k)) & 1) && lo <= (k) && (k) < hi)
#define RUN(k) do { if (IN(k)) { run_phase<k>(a, lds); if constexpr (((REP_MASK) >> (k)) & 1) { __syncthreads(); run_phase<k>(a, lds); } } \
                    if (IN(k) && IN((k) + 1)) { if (USE_CG_SEAM0 && (k) == 0) grid.sync(); else xcd_barrier(bar); } } while (0)
    RUN(0); RUN(1); RUN(2); RUN(3); RUN(4); RUN(5); RUN(6);
    RUN(7); RUN(8); RUN(9); RUN(10);
#undef IN
#undef RUN
}

#ifndef MK_MULTI
#define MK_MULTI 0
#endif
extern "C" void kernel_launch(void* const* d_in, const int* in_sizes, int n_in, void* d_out, int out_size, void* d_ws, size_t ws_size, hipStream_t stream) {
    static int grid = 0;
    if (grid == 0) {
        if (n_in != 24 || out_size != NTOK * DM || ws_size < WS_NEED) { fprintf(stderr, "kernel_launch: unexpected shapes (n_in %d, out %d, ws %zu)\n", n_in, out_size, ws_size); grid = -1; return; }
        int dev = 0, cus = 0, per_cu = 0;
        (void)hipGetDevice(&dev); (void)hipDeviceGetAttribute(&cus, hipDeviceAttributeMultiprocessorCount, dev);
        (void)hipFuncSetAttribute((const void*)mk_fwd, hipFuncAttributeMaxDynamicSharedMemorySize, LDS_BYTES);
        (void)hipOccupancyMaxActiveBlocksPerMultiprocessor(&per_cu, (const void*)mk_fwd, 512, LDS_BYTES);
        (void)hipGetLastError();
        if (per_cu < 1) { fprintf(stderr, "kernel_launch: occupancy query says %d blocks per CU: this kernel cannot be made resident, nothing launched\n", per_cu); grid = -1; return; }
        grid = cus;
    }
    if (grid < 0) return;
    Args a{};
    for (int i = 0; i < 24; ++i) a.in[i] = d_in[i];
    a.out = (float*)d_out; a.ws = (unsigned char*)d_ws;
#if MK_MULTI
    for (int p = 0; p < N_PHASES; ++p) { a.ph_lo = p; a.ph_hi = p + 1; hipLaunchKernelGGL(mk_fwd, dim3(grid), dim3(512), LDS_BYTES, stream, a); }
#else
    a.ph_lo = 0; a.ph_hi = N_PHASES;
    if (hipMemsetAsync((char*)d_ws + WS_CTL, 0, CTL_BYTES, stream) != hipSuccess) { fprintf(stderr, "kernel_launch: memset failed\n"); return; }
    void* args[] = {&a};
    hipError_t e = hipLaunchCooperativeKernel((const void*)mk_fwd, dim3(grid), dim3(512), args, LDS_BYTES, stream);
    if (e != hipSuccess) fprintf(stderr, "cooperative launch failed: %s (grid %d)\n", hipGetErrorString(e), grid);
#endif
}
```

```cpp
#include <hip/hip_runtime.h>
#include <hip/hip_cooperative_groups.h>
#include <cstdio>
#include <cstdint>
namespace cg = cooperative_groups;
namespace pg8 {
#define PG8_LAS __attribute__((address_space(3)))
typedef unsigned short bf16_t;
typedef short bf16x8 __attribute__((ext_vector_type(8)));
typedef float f32x4 __attribute__((ext_vector_type(4)));
typedef unsigned u32x4 __attribute__((ext_vector_type(4)));
constexpr int BM = 256, BK = 64, HALF = 128, HTB = HALF * BK * 2  , STAGE_BYTES = 8 * HTB, NXCD = 8, WGM = 8;

__host__ __device__ __forceinline__ int lds_byte(int r, int c) { const int st = (r >> 4) * 2 + (c >> 5), rr = r & 15, cc = c & 31, ob = rr * 64 + cc * 2; return st * 1024 + (ob ^ (((ob >> 9) & 1) << 5)); }
__host__ __device__ __forceinline__ void stage_rc(int b, int& R, int& C) { const int st = b / 1024, sb = b % 1024, swz = sb ^ (((sb >> 9) & 1) << 5); R = (st >> 1) * 16 + swz / 64; C = (st & 1) * 32 + (swz % 64) / 2; }
__host__ __device__ __forceinline__ int perm32(int rho) { const int n = rho >> 4, i = rho & 15; return 8 * (i >> 2) + 4 * n + (i & 3); }

struct Unit { int pm, pn, aux; };
struct Gemm { const bf16_t* A; const bf16_t* Bt; int M, N, K; };

struct StaticOrder {
    static constexpr bool GATHER = false; __device__ __forceinline__ int row(int, int) const { return 0; }
    int nM, nN, nwg, G, c;
    __host__ __device__ void init(int M, int N, int G_, int c_) { nM = M / BM; nN = N / BM; nwg = nM * nN; G = G_; c = c_; }
    __host__ __device__ bool next(int i, Unit& u) const {
        const long L = (long)i * G + c; if (L >= nwg) return false;
        int wgid = (int)L; { const int q = nwg / NXCD, r = nwg % NXCD, xcd = wgid % NXCD, off = wgid / NXCD; wgid = (xcd < r ? xcd * (q + 1) : r * (q + 1) + (xcd - r) * q) + off; }
        const int nig = WGM * nN, gid = wgid / nig, fm = gid * WGM, gsz = (nM - fm) < WGM ? (nM - fm) : WGM;
        u.pm = fm + ((wgid % nig) % gsz); u.pn = (wgid % nig) / gsz; u.aux = u.pn; return true;
    }
    __device__ __forceinline__ void a_ready(const Unit&) const {}
    __device__ __forceinline__ void done(const Unit&) const {}
};

__device__ __forceinline__ unsigned cvt_pk_bf16(float lo, float hi) { unsigned r; asm volatile("v_cvt_pk_bf16_f32 %0, %1, %2" : "=v"(r) : "v"(lo), "v"(hi)); return r; }
template <class Epi, class Sched, bool ALIGN_EPI = false, bool SP2 = false, bool I8 = false>
__device__ __forceinline__ void gemm_phase(PG8_LAS unsigned char* lds, const Gemm g, const Sched& S, const Epi& E) {
    const int tid = threadIdx.x, wid = __builtin_amdgcn_readfirstlane(tid >> 6), lane = tid & 63, wr = wid >> 2, wc = wid & 3, fr = lane & 15, fq = lane >> 4;
    const int K = g.K, nt = K / BK;
    unsigned voffA[2], voffB[2];
    constexpr bool GATHER = Sched::GATHER;
    static_assert(!GATHER || SP2, "gather is implemented for the SP2 loop");
    unsigned gA[2][2], gN[2][2];
#pragma unroll
    for (int i = 0; i < 2; ++i) { int R, C; stage_rc(tid * 16 + i * 8192, R, C); const int Rb = Epi::PERM ? ((R & ~31) + perm32(R & 31)) : R;
        voffA[i] = (unsigned)(R * K + C) * 2u; voffB[i] = (unsigned)(Rb * K + C) * 2u; }
#define PG8_ROWS(dst, ui_) do { _Pragma("unroll") for (int h_ = 0; h_ < 2; ++h_) _Pragma("unroll") for (int i_ = 0; i_ < 2; ++i_) { int R_, C_; stage_rc(tid * 16 + i_ * 8192, R_, C_); \
        dst[h_][i_] = (unsigned)S.row(ui_, h_ * HALF + R_) * (unsigned)(K * 2) + (unsigned)(C_ * 2); } } while (0)
    const size_t kstep = (size_t)(BK * 2);
    const size_t hstep = (size_t)HALF * K * 2;
    const size_t hstepA = GATHER ? (size_t)0 : hstep;
    const size_t tstep = 2 * hstep;
    const unsigned ldsw = (unsigned)wid * 1024u;
    const int aoff = lds_byte(wr * 64 + fr, fq * 8), boff = lds_byte(wc * 32 + fr, fq * 8);
#define PG8_SA(b, h) (((b) * 2 + (h)) * HTB)
#define PG8_SB(b, h) ((4 + (b) * 2 + (h)) * HTB)
#define PG8_STAGE(bufoff, gbase, voff) do { _Pragma("unroll") for (int _i = 0; _i < 2; ++_i) \
        __builtin_amdgcn_global_load_lds((const unsigned*)((const char*)(gbase) + (voff)[_i]), (PG8_LAS unsigned*)(lds + (bufoff) + ldsw + _i * 8192), 16, 0, 0); } while (0)
#define PG8_LDA(dst, b, h) do { _Pragma("unroll") for (int m = 0; m < 4; ++m) _Pragma("unroll") for (int k = 0; k < 2; ++k) dst[m][k] = *(const PG8_LAS bf16x8*)(lds + PG8_SA(b, h) + aoff + m * 2048 + k * 1024); } while (0)
#define PG8_LDB(dst, b, h) do { _Pragma("unroll") for (int n = 0; n < 2; ++n) _Pragma("unroll") for (int k = 0; k < 2; ++k) dst[n][k] = *(const PG8_LAS bf16x8*)(lds + PG8_SB(b, h) + boff + n * 2048 + k * 1024); } while (0)
typedef int pg8_i32x4 __attribute__((ext_vector_type(4)));
#define PG8_MMA(ai, bj, At, Bt) do { __builtin_amdgcn_s_setprio(1); _Pragma("unroll") for (int m = 0; m < 4; ++m) _Pragma("unroll") for (int n = 0; n < 2; ++n) _Pragma("unroll") for (int k = 0; k < 2; ++k) { \
        if constexpr (I8) acc[ai][bj][m][n] = __builtin_bit_cast(f32x4, __builtin_amdgcn_mfma_i32_16x16x64_i8(__builtin_bit_cast(pg8_i32x4, Bt[n][k]), __builtin_bit_cast(pg8_i32x4, At[m][k]), __builtin_bit_cast(pg8_i32x4, acc[ai][bj][m][n]), 0, 0, 0)); \
        else acc[ai][bj][m][n] = __builtin_amdgcn_mfma_f32_16x16x32_bf16(Bt[n][k], At[m][k], acc[ai][bj][m][n], 0, 0, 0); } \
        __builtin_amdgcn_s_setprio(0); } while (0)
#define PG8_WAIT_V(n) asm volatile("s_waitcnt vmcnt(" #n ")" ::: "memory")
#define PG8_WAIT_L(n) asm volatile("s_waitcnt lgkmcnt(" #n ")" ::: "memory")
#define PG8_BAR __builtin_amdgcn_s_barrier()
#define PG8_SCHED __builtin_amdgcn_sched_barrier(0)
    Unit cur, nxt; int ui = 0;
    if (!S.next(0, cur)) return;
    f32x4 acc[2][2][4][2];
#pragma unroll
    for (int a = 0; a < 2; ++a)
#pragma unroll
        for (int b = 0; b < 2; ++b)
#pragma unroll
            for (int m = 0; m < 4; ++m)
#pragma unroll
                for (int n = 0; n < 2; ++n) acc[a][b][m][n] = (f32x4){0.f, 0.f, 0.f, 0.f};
    bf16x8 At[4][2], B0[2][2], B1[2][2];
    const char* cA = (const char*)g.A + (GATHER ? (size_t)0 : (size_t)cur.pm * tstep); const char* cB = (const char*)g.Bt + (size_t)cur.pn * tstep;
    if constexpr (GATHER) { PG8_ROWS(gA, 0); PG8_ROWS(gN, 0); }
#define PG8_OA(h) (GATHER ? gA[h] : voffA)
    S.a_ready(cur);
    if constexpr (SP2) {
        PG8_STAGE(PG8_SB(0, 0), cB, voffB); PG8_STAGE(PG8_SB(0, 1), cB + hstep, voffB); PG8_STAGE(PG8_SA(0, 0), cA, PG8_OA(0)); PG8_STAGE(PG8_SA(0, 1), cA + hstepA, PG8_OA(1));
        if (wr == 1) PG8_BAR;
        PG8_WAIT_V(2); PG8_BAR;
        PG8_STAGE(PG8_SB(1, 0), cB + kstep, voffB); PG8_STAGE(PG8_SA(1, 0), cA + kstep, PG8_OA(0)); PG8_STAGE(PG8_SB(1, 1), cB + hstep + kstep, voffB);
        PG8_WAIT_V(6); PG8_BAR;
    } else {
        PG8_STAGE(PG8_SB(0, 0), cB, voffB); PG8_STAGE(PG8_SA(0, 0), cA, voffA); PG8_STAGE(PG8_SB(0, 1), cB + hstep, voffB); PG8_STAGE(PG8_SA(0, 1), cA + hstep, voffA);
        if (wr == 1) PG8_BAR;
        PG8_WAIT_V(4); PG8_BAR;
        PG8_STAGE(PG8_SB(1, 0), cB + kstep, voffB); PG8_STAGE(PG8_SA(1, 0), cA + kstep, voffA); PG8_STAGE(PG8_SB(1, 1), cB + hstep + kstep, voffB);
        PG8_WAIT_V(6); PG8_BAR;
    }
    for (;;) {
        const bool has_next = S.next(ui + 1, nxt);
        const char* nA = (has_next && !GATHER) ? (const char*)g.A + (size_t)nxt.pm * tstep : cA; const char* nB = has_next ? (const char*)g.Bt + (size_t)nxt.pn * tstep : cB;
        if constexpr (GATHER) { if (has_next) PG8_ROWS(gN, ui + 1); }
#pragma unroll 1
        for (int t = 0; t < nt; t += 2) {
            const bool last = (t == nt - 2);
            const char* a1 = cA + (size_t)(t + 1) * kstep;
            const char* a2 = last ? nA : cA + (size_t)(t + 2) * kstep; const char* b2 = last ? nB : cB + (size_t)(t + 2) * kstep;
            const char* a3 = a2 + kstep; const char* b3 = b2 + kstep;
            if (last && has_next) S.a_ready(nxt);
            if constexpr (Epi::HAS_MID) { if (t == E.mid0 || t == E.mid1) E.mid(acc, cur, t, wr, wc, fr, fq); }
            if constexpr (SP2) {
            unsigned on0[2], on1[2];
            on0[0] = GATHER ? (last ? gN[0][0] : gA[0][0]) : voffA[0]; on0[1] = GATHER ? (last ? gN[0][1] : gA[0][1]) : voffA[1];
            on1[0] = GATHER ? (last ? gN[1][0] : gA[1][0]) : voffA[0]; on1[1] = GATHER ? (last ? gN[1][1] : gA[1][1]) : voffA[1];
            PG8_LDB(B0, 0, 0); PG8_LDB(B1, 0, 1); PG8_SCHED; PG8_LDA(At, 0, 0); PG8_STAGE(PG8_SA(1, 1), a1 + hstepA, PG8_OA(1));
            PG8_WAIT_V(8); PG8_WAIT_L(0); PG8_BAR; PG8_MMA(0, 0, At, B0); PG8_MMA(0, 1, At, B1); PG8_BAR; PG8_SCHED;
            PG8_LDA(At, 0, 1); PG8_STAGE(PG8_SB(0, 0), b2, voffB); PG8_STAGE(PG8_SB(0, 1), b2 + hstep, voffB); PG8_STAGE(PG8_SA(0, 0), a2, on0);
            PG8_WAIT_V(8); PG8_WAIT_L(0); PG8_BAR; PG8_MMA(1, 0, At, B0); PG8_MMA(1, 1, At, B1); PG8_BAR; PG8_SCHED;
            PG8_LDB(B0, 1, 0); PG8_LDB(B1, 1, 1); PG8_SCHED; PG8_LDA(At, 1, 0); PG8_STAGE(PG8_SA(0, 1), a2 + hstepA, on1);
            PG8_WAIT_V(8); PG8_WAIT_L(0); PG8_BAR; PG8_MMA(0, 0, At, B0); PG8_MMA(0, 1, At, B1); PG8_BAR; PG8_SCHED;
            PG8_LDA(At, 1, 1); PG8_STAGE(PG8_SB(1, 0), b3, voffB); PG8_STAGE(PG8_SB(1, 1), b3 + hstep, voffB); PG8_STAGE(PG8_SA(1, 0), a3, on0);
            PG8_WAIT_V(8); PG8_WAIT_L(0); PG8_BAR; PG8_MMA(1, 0, At, B0); PG8_MMA(1, 1, At, B1); PG8_BAR; PG8_SCHED;
            } else {
            PG8_LDB(B0, 0, 0); PG8_SCHED; PG8_LDA(At, 0, 0); PG8_STAGE(PG8_SA(1, 1), a1 + hstep, voffA);
            PG8_WAIT_L(8); PG8_BAR; PG8_WAIT_L(0); PG8_MMA(0, 0, At, B0); PG8_BAR; PG8_SCHED;
            PG8_LDB(B1, 0, 1); PG8_STAGE(PG8_SB(0, 0), b2, voffB);
            PG8_BAR; PG8_WAIT_L(0); PG8_MMA(0, 1, At, B1); PG8_BAR;
            PG8_LDA(At, 0, 1); PG8_STAGE(PG8_SA(0, 0), a2, voffA);
            PG8_BAR; PG8_WAIT_L(0); PG8_MMA(1, 0, At, B0); PG8_BAR; PG8_SCHED;
            PG8_STAGE(PG8_SB(0, 1), b2 + hstep, voffB);
            PG8_WAIT_V(6); PG8_BAR; PG8_MMA(1, 1, At, B1); PG8_BAR;
            PG8_LDB(B0, 1, 0); PG8_SCHED; PG8_LDA(At, 1, 0); PG8_STAGE(PG8_SA(0, 1), a2 + hstep, voffA);
            PG8_WAIT_L(8); PG8_BAR; PG8_WAIT_L(0); PG8_MMA(0, 0, At, B0); PG8_BAR; PG8_SCHED;
            PG8_LDB(B1, 1, 1); PG8_STAGE(PG8_SB(1, 0), b3, voffB);
            PG8_BAR; PG8_WAIT_L(0); PG8_MMA(0, 1, At, B1); PG8_BAR;
            PG8_LDA(At, 1, 1); PG8_STAGE(PG8_SA(1, 0), a3, voffA);
            PG8_BAR; PG8_WAIT_L(0); PG8_MMA(1, 0, At, B0); PG8_BAR; PG8_SCHED;
            PG8_STAGE(PG8_SB(1, 1), b3 + hstep, voffB);
            PG8_WAIT_V(6); PG8_BAR; PG8_MMA(1, 1, At, B1); PG8_BAR;
            }
        }
        if constexpr (ALIGN_EPI) { if (wr == 0) PG8_BAR; }
        if constexpr (!Epi::AFTER_DRAIN) { E(acc, cur, wr, wc, fr, fq); S.done(cur); }
        if (!has_next) break;
#pragma unroll
        for (int a = 0; a < 2; ++a)
#pragma unroll
            for (int b = 0; b < 2; ++b)
#pragma unroll
                for (int m = 0; m < 4; ++m)
#pragma unroll
                    for (int n = 0; n < 2; ++n) acc[a][b][m][n] = (f32x4){0.f, 0.f, 0.f, 0.f};
        cur = nxt; cA = nA; cB = nB; ++ui;
        if constexpr (GATHER) { _Pragma("unroll") for (int h_ = 0; h_ < 2; ++h_) _Pragma("unroll") for (int i_ = 0; i_ < 2; ++i_) gA[h_][i_] = gN[h_][i_]; }
        if constexpr (ALIGN_EPI) { if (wr == 1) PG8_BAR; }
    }
    PG8_WAIT_V(0);
    if constexpr (!ALIGN_EPI) { if (wr == 0) PG8_BAR; }
    PG8_BAR;
    if constexpr (Epi::AFTER_DRAIN) { E.fused(acc, cur, wr, wc, fr, fq, lds, wid, lane); S.done(cur); }
#undef PG8_SA
#undef PG8_OA
#undef PG8_ROWS
#undef PG8_SB
#undef PG8_STAGE
#undef PG8_LDA
#undef PG8_LDB
#undef PG8_MMA
#undef PG8_WAIT_V
#undef PG8_WAIT_L
#undef PG8_BAR
#undef PG8_SCHED
}
}

#define DI __device__ __forceinline__
#define LAS __attribute__((address_space(3)))
typedef unsigned short bf16_t;
typedef float f32x4 __attribute__((ext_vector_type(4)));
typedef float f32x2 __attribute__((ext_vector_type(2)));
typedef float f32x16 __attribute__((ext_vector_type(16)));
typedef unsigned u32x4 __attribute__((ext_vector_type(4)));
typedef unsigned u32x2 __attribute__((ext_vector_type(2)));
typedef short bf16x8 __attribute__((ext_vector_type(8)));
typedef short s16x4 __attribute__((ext_vector_type(4)));
typedef __bf16 bf16x2_t __attribute__((ext_vector_type(2)));
using pg8::Unit;

constexpr int NB = 16, SEQ = 2048, DM = 1024, NTOK = NB * SEQ, NMEM = 256, NMROW = NB * NMEM;
constexpr float EPS = 1e-6f, LOG2E = 1.4426950408889634f;
constexpr float QSCALE_A = 0.125f * LOG2E, QSCALE_M = 0.08838834764831845f * LOG2E;
constexpr int MAXROWS = 73728, MAXTILES = MAXROWS / 256;

constexpr size_t MiB = 1u << 20;
constexpr size_t WS_CTL = 0, CTL_BYTES = 64 * 1024;
constexpr size_t WS_WIN = 1 * MiB, WS_WMKV = 17 * MiB, WS_WMRG = 19 * MiB, WS_WOUT = 22 * MiB;
constexpr size_t WS_ROPE = 24 * MiB, WS_WRH = 26 * MiB, WS_WRL = WS_WRH + 128 * 1024;
constexpr size_t WS_RT = 27 * MiB;
constexpr size_t RT_TOKE = 0, RT_RANK = 256 * 1024, RT_W = 512 * 1024, RT_RSTD = 768 * 1024, RT_CCNT = 896 * 1024, RT_META = 960 * 1024;
constexpr size_t WS_WGU = 28 * MiB, WS_WD = 92 * MiB;
constexpr size_t WS_Q = 124 * MiB, WS_K = 172 * MiB, WS_V = 220 * MiB, WS_U = 268 * MiB, WS_CB = 316 * MiB;
constexpr size_t WS_AM = 364 * MiB, WS_PO = 460 * MiB, WS_LSE = 508 * MiB, WS_SROW = 510 * MiB;
constexpr size_t WS_G = 124 * MiB;
constexpr size_t WS_MRG = 220 * MiB, WS_XB = 284 * MiB;
constexpr size_t SR_RSTD = 0, SR_DEST = 320 * 1024, SR_W = 640 * 1024;
constexpr size_t WS_XB8 = 124 * MiB, WS_ACT = 348 * MiB, WS_Y = 124 * MiB;
constexpr size_t WS_H8 = 60 * MiB;
constexpr size_t WS_WG8 = WS_WIN + (size_t)5120 * 2048;
constexpr size_t WS_SH = WS_WRH + 256 * 1024, WS_SG = WS_WRH + 640 * 1024;
constexpr size_t WS_SB = WS_WRH + 512 * 1024;
constexpr size_t WS_NEED = 512 * MiB;
constexpr size_t DO_H = 0, DO_HM = 64 * MiB, DO_QM = 72 * MiB, DO_KM = 104 * MiB, DO_VM = 108 * MiB;
constexpr int RING_BYTES = 131072, MISC_OFF = 131072, LDS_BYTES = 147456;

DI unsigned pk2(float lo, float hi) { f32x2 v = {lo, hi}; bf16x2_t b = __builtin_convertvector(v, bf16x2_t); return __builtin_bit_cast(unsigned, b); }
DI float bf_lo(unsigned u) { return __uint_as_float(u << 16); }
DI float bf_hi(unsigned u) { return __uint_as_float(u & 0xffff0000u); }
DI float bf2f(short s) { return __uint_as_float(((unsigned)(unsigned short)s) << 16); }
DI float fexp2(float x) { return __builtin_amdgcn_exp2f(x); }
DI float fexp(float x) { return __builtin_amdgcn_exp2f(x * LOG2E); }
DI float frcp(float x) { return __builtin_amdgcn_rcpf(x); }
DI u32x4 pack8(const f32x4& a, const f32x4& b) { u32x4 w; w.x = pk2(a.x, a.y); w.y = pk2(a.z, a.w); w.z = pk2(b.x, b.y); w.w = pk2(b.z, b.w); return w; }
DI void st16(void* p, const u32x4& v) { __builtin_nontemporal_store(v, (u32x4*)p); }
DI void st16f(void* p, const f32x4& v) { __builtin_nontemporal_store(v, (f32x4*)p); }
DI void st8(void* p, const u32x2& v) { __builtin_nontemporal_store(v, (u32x2*)p); }
DI void st16d(void* p, const u32x4& v) { *(u32x4*)p = v; }
DI void st8d(void* p, const u32x2& v) { *(u32x2*)p = v; }
DI int crow(int reg, int h) { return (reg & 3) + 8 * (reg >> 2) + 4 * h; }
DI float wave_sum(float v) {
#pragma unroll
    for (int o = 1; o < 64; o <<= 1) v += __shfl_xor(v, o);
    return v;
}
#define MFMA32(a, b, c) __builtin_amdgcn_mfma_f32_32x32x16_bf16((a), (b), (c), 0, 0, 0)
#define MFMA16(a, b, c) __builtin_amdgcn_mfma_f32_16x16x32_bf16((a), (b), (c), 0, 0, 0)

struct EpiIn {
    static constexpr bool PERM = true, AFTER_DRAIN = false, HAS_MID = false;
    unsigned char* wsb; bf16_t* QM; bf16_t* KMVM; const float *gq, *gk, *cs;
    DI void operator()(const pg8::f32x4 (&acc)[2][2][4][2], const Unit& u, int wr, int wc, int fr, int fq) const {
        const int t = u.pn, row0 = u.pm * 256 + wr * 64 + fr;
        if (t >= 32) {
            bf16_t* dst = KMVM + (t >= 34 ? (size_t)NMROW * 512 : 0);
            const int col = (t & 1) * 256 + wc * 32 + 8 * fq;
#pragma unroll
            for (int ai = 0; ai < 2; ++ai)
#pragma unroll
                for (int m = 0; m < 4; ++m) {
                    bf16_t* rp = dst + (size_t)(row0 - NTOK + ai * 128 + m * 16) * 512 + col;
#pragma unroll
                    for (int bj = 0; bj < 2; ++bj) st16(rp + 128 * bj, pack8(acc[ai][bj][m][0], acc[ai][bj][m][1]));
                }
        } else if (t < 6) {
            const bool isq = t < 3; bf16_t* dst = (bf16_t*)(wsb + (isq ? WS_Q : WS_K)); const float* g = isq ? gq : gk; const float osc = isq ? QSCALE_A : 1.f;
            const int head = 4 * (isq ? t : t - 3) + wc;
            f32x4 gv[2][2];
#pragma unroll
            for (int bj = 0; bj < 2; ++bj)
#pragma unroll
                for (int n = 0; n < 2; ++n) gv[bj][n] = *(const f32x4*)(g + 32 * bj + 8 * fq + 4 * n) * osc;
#pragma unroll
            for (int ai = 0; ai < 2; ++ai) {
#pragma unroll
              for (int mp = 0; mp < 2; ++mp) {
                f32x4 csv[4][4];
#pragma unroll
                for (int m2 = 0; m2 < 2; ++m2) { const float* cr = cs + (size_t)(row0 + ai * 128 + (2 * mp + m2) * 16) * 16;
#pragma unroll
                    for (int q = 0; q < 4; ++q) csv[2 * mp + m2][q] = *(const f32x4*)(cr + 4 * q); }
#pragma unroll
                for (int m = 2 * mp; m < 2 * mp + 2; ++m) {
                    const int row = row0 + ai * 128 + m * 16;
                    float ss = 0.f;
#pragma unroll
                    for (int bj = 0; bj < 2; ++bj)
#pragma unroll
                        for (int n = 0; n < 2; ++n) { const f32x4 x = acc[ai][bj][m][n]; ss += (x.x * x.x + x.y * x.y) + (x.z * x.z + x.w * x.w); }
                    ss += __shfl_xor(ss, 16); ss += __shfl_xor(ss, 32);
                    const float rstd = __builtin_amdgcn_rsqf(ss * (1.f / 64.f) + EPS);
                    f32x4 v[2][2];
#pragma unroll
                    for (int bj = 0; bj < 2; ++bj)
#pragma unroll
                        for (int n = 0; n < 2; ++n) v[bj][n] = acc[ai][bj][m][n] * rstd * gv[bj][n];
                    f32x4 p0, p1;
#pragma unroll
                    for (int c = 0; c < 4; ++c) { p0[c] = __shfl_xor(v[0][0][c], 16); p1[c] = __shfl_xor(v[0][1][c], 16); }
                    if (fq < 2) {
                        const f32x4 c0 = csv[m][0], c1 = csv[m][1], s0 = csv[m][2], s1 = csv[m][3];
                        if (fq == 0) { v[0][0] = v[0][0] * c0 - p0 * s0; v[0][1] = v[0][1] * c1 - p1 * s1; }
                        else         { v[0][0] = v[0][0] * c0 + p0 * s0; v[0][1] = v[0][1] * c1 + p1 * s1; }
                    }
                    bf16_t* rp = dst + (size_t)row * 768 + head * 64 + 8 * fq;
#pragma unroll
                    for (int bj = 0; bj < 2; ++bj) st16(rp + 32 * bj, pack8(v[bj][0], v[bj][1]));
                }
                asm volatile("" ::: "memory");
              }
            }
        } else if (t >= 9 && t < 15) {
            bf16_t* U = (bf16_t*)(wsb + WS_U);
            const int c0 = (t - 9) * 128 + wc * 32 + 8 * fq;
#pragma unroll
            for (int ai = 0; ai < 2; ++ai)
#pragma unroll
                for (int m = 0; m < 4; ++m) {
                    const int row = row0 + ai * 128 + m * 16;
                    st16(U + (size_t)row * 768 + c0, pack8(acc[ai][0][m][0] * acc[ai][1][m][0], acc[ai][0][m][1] * acc[ai][1][m][1]));
                }
        } else {
            if (t >= 18) {
                const int col = (t - 18) * 256 + wc * 32 + 8 * fq;
#pragma unroll
                for (int ai = 0; ai < 2; ++ai)
#pragma unroll
                    for (int m = 0; m < 4; ++m) {
                        bf16_t* rp = QM + (size_t)(row0 + ai * 128 + m * 16) * 512 + col;
#pragma unroll
                        for (int bj = 0; bj < 2; ++bj) st16(rp + 128 * bj, pack8(acc[ai][bj][m][0], acc[ai][bj][m][1]));
                    }
            } else {
                bf16_t* dst = (bf16_t*)(wsb + (t < 9 ? WS_V : WS_CB));
                const int col = (t < 9 ? t - 6 : t - 15) * 256 + wc * 32 + 8 * fq;
#pragma unroll
                for (int ai = 0; ai < 2; ++ai)
#pragma unroll
                    for (int m = 0; m < 4; ++m) {
                        bf16_t* rp = dst + (size_t)(row0 + ai * 128 + m * 16) * 768 + col;
#pragma unroll
                        for (int bj = 0; bj < 2; ++bj) st16(rp + 128 * bj, pack8(acc[ai][bj][m][0], acc[ai][bj][m][1]));
                    }
            }
        }
    }
};

DI float sigm(float x) { return frcp(1.f + fexp(-fminf(fmaxf(x, -60.f), 60.f))); }
DI f32x4 sigm4(const f32x4& v) { f32x4 r; r.x = sigm(v.x); r.y = sigm(v.y); r.z = sigm(v.z); r.w = sigm(v.w); return r; }
DI unsigned gq1(float x) { return (unsigned)fminf(fmaxf(__builtin_rintf(sigm(x) * 255.f), 1.f), 255.f); }
DI unsigned gq4(const f32x4& v) { return gq1(v.x) | (gq1(v.y) << 8) | (gq1(v.z) << 16) | (gq1(v.w) << 24); }
DI float ub(unsigned w, int k) { return (float)((w >> (8 * k)) & 0xffu); }
struct EpiGate {
    static constexpr bool PERM = true, AFTER_DRAIN = false, HAS_MID = false;
    unsigned char* O; int ld; const float* sh; const float* sg;
    DI void operator()(const pg8::f32x4 (&acc)[2][2][4][2], const Unit& u, int wr, int wc, int fr, int fq) const {
        const int row0 = u.pm * 256 + wr * 64 + fr, col = u.pn * 256 + wc * 64 + 16 * fq;
        const float* sp = sg + u.pn * 256 + wc * 32 + 8 * fq;
        f32x4 sc[2][2];
#pragma unroll
        for (int bj = 0; bj < 2; ++bj)
#pragma unroll
            for (int n = 0; n < 2; ++n) sc[bj][n] = *(const f32x4*)(sp + 128 * bj + 4 * n);
#pragma unroll
        for (int ai = 0; ai < 2; ++ai)
#pragma unroll
            for (int m = 0; m < 4; ++m) {
                const int row = row0 + ai * 128 + m * 16; const float rs = sh[row];
                f32x4 lg[2][2];
#pragma unroll
                for (int bj = 0; bj < 2; ++bj)
#pragma unroll
                    for (int n = 0; n < 2; ++n)
#pragma unroll
                        for (int c = 0; c < 4; ++c) lg[bj][n][c] = (float)__float_as_int(acc[ai][bj][m][n][c]) * rs * sc[bj][n][c];
                u32x4 w; w.x = gq4(lg[0][0]); w.y = gq4(lg[0][1]); w.z = gq4(lg[1][0]); w.w = gq4(lg[1][1]);
                st16d(O + (size_t)row * ld + col, w);
            }
    }
};
struct EpiMerge {
    static constexpr bool PERM = true, AFTER_DRAIN = false, HAS_MID = true;
    const unsigned char* G; bf16_t* O; int mid0, mid1;
    DI void mid(pg8::f32x4 (&acc)[2][2][4][2], const Unit& u, int t, int wr, int wc, int fr, int fq) const {
        const int ga = (t == mid0) ? 0 : 1;
        int row0 = u.pm * 256 + wr * 64 + fr; const int col = u.pn * 256 + wc * 64 + 16 * fq;
        asm volatile("" : "+v"(row0));
        u32x4 la[2][4], lb[2][4];
#pragma unroll
        for (int ai = 0; ai < 2; ++ai)
#pragma unroll
            for (int m = 0; m < 4; ++m) { const unsigned char* gp = G + (size_t)(row0 + ai * 128 + m * 16) * 3072 + ga * 1024 + col; la[ai][m] = *(const u32x4*)gp; lb[ai][m] = *(const u32x4*)(gp + 1024); }
#pragma unroll
        for (int ai = 0; ai < 2; ++ai)
#pragma unroll
            for (int m = 0; m < 4; ++m)
#pragma unroll
                for (int bj = 0; bj < 2; ++bj)
#pragma unroll
                    for (int n = 0; n < 2; ++n)
#pragma unroll
                        for (int c = 0; c < 4; ++c) acc[ai][bj][m][n][c] *= ub(la[ai][m][2 * bj + n], c) * frcp(ub(lb[ai][m][2 * bj + n], c));
        asm volatile("" ::: "memory");
    }
    DI void operator()(const pg8::f32x4 (&acc)[2][2][4][2], const Unit& u, int wr, int wc, int fr, int fq) const {
        const int row0 = u.pm * 256 + wr * 64 + fr, col = u.pn * 256 + wc * 64 + 16 * fq;
        u32x4 lq[2][4];
#pragma unroll
        for (int ai = 0; ai < 2; ++ai)
#pragma unroll
            for (int m = 0; m < 4; ++m) lq[ai][m] = *(const u32x4*)(G + (size_t)(row0 + ai * 128 + m * 16) * 3072 + 2048 + col);
#pragma unroll
        for (int ai = 0; ai < 2; ++ai)
#pragma unroll
            for (int m = 0; m < 4; ++m) {
                const size_t row = (size_t)(row0 + ai * 128 + m * 16);
#pragma unroll
                for (int bj = 0; bj < 2; ++bj) {
                    const float k = 1.f / 255.f; const unsigned q0 = lq[ai][m][2 * bj], q1 = lq[ai][m][2 * bj + 1];
                    const f32x4 g0 = {ub(q0, 0) * k, ub(q0, 1) * k, ub(q0, 2) * k, ub(q0, 3) * k}, g1 = {ub(q1, 0) * k, ub(q1, 1) * k, ub(q1, 2) * k, ub(q1, 3) * k};
                    st16d(O + row * 1024 + col + 8 * bj, pack8(acc[ai][bj][m][0] * g0, acc[ai][bj][m][1] * g1));
                }
            }
    }
};

struct EpiOut {
    static constexpr bool PERM = true, AFTER_DRAIN = false, HAS_MID = false;
    const float* X; float* O; bf16_t* XB;
    DI void operator()(const pg8::f32x4 (&acc)[2][2][4][2], const Unit& u, int wr, int wc, int fr, int fq) const {
        const int row0 = u.pm * 256 + wr * 64 + fr, col = u.pn * 256 + wc * 32 + 8 * fq;
#pragma unroll
        for (int ai = 0; ai < 2; ++ai)
#pragma unroll
            for (int m = 0; m < 4; ++m) {
                const size_t off = (size_t)(row0 + ai * 128 + m * 16) * 1024 + col;
#pragma unroll
                for (int bj = 0; bj < 2; ++bj) {
                    const f32x4 o0 = *(const f32x4*)(X + off + 128 * bj) + acc[ai][bj][m][0], o1 = *(const f32x4*)(X + off + 128 * bj + 4) + acc[ai][bj][m][1];
                    st16d(XB + off + 128 * bj, pack8(o0, o1));
                }
            }
    }
};

struct EpiUp {
    static constexpr bool PERM = true, AFTER_DRAIN = false, HAS_MID = false;
    const float* sa; const float* sb; bf16_t* ACT;
    DI void operator()(const pg8::f32x4 (&acc)[2][2][4][2], const Unit& u, int wr, int wc, int fr, int fq) const {
        const int row0 = u.pm * 256 + wr * 64 + fr, col = u.aux * 128 + wc * 32 + 8 * fq;
        const float* sbp = sb + (size_t)(u.pn >> 2) * 1024 + u.aux * 256 + wc * 32 + 8 * fq;
        const f32x4 sg0 = *(const f32x4*)(sbp), sg1 = *(const f32x4*)(sbp + 4), su0 = *(const f32x4*)(sbp + 128), su1 = *(const f32x4*)(sbp + 132);
#pragma unroll
        for (int ai = 0; ai < 2; ++ai)
#pragma unroll
            for (int m = 0; m < 4; ++m) {
                const int row = row0 + ai * 128 + m * 16; const float rs = sa[row];
                f32x4 o[2];
#pragma unroll
                for (int n = 0; n < 2; ++n)
#pragma unroll
                    for (int c = 0; c < 4; ++c) {
                        const float a = (float)__float_as_int(acc[ai][0][m][n][c]) * rs * (n ? sg1[c] : sg0[c]), b = (float)__float_as_int(acc[ai][1][m][n][c]) * rs * (n ? su1[c] : su0[c]);
                        o[n][c] = a * b * frcp(1.f + fexp(-a)); }
                st16d(ACT + (size_t)row * 512 + col, pack8(o[0], o[1]));
            }
    }
};

struct EpiDown {
    static constexpr bool PERM = true, AFTER_DRAIN = false, HAS_MID = false;
    const u32x2* dw; bf16_t* Y;
    DI void operator()(const pg8::f32x4 (&acc)[2][2][4][2], const Unit& u, int wr, int wc, int fr, int fq) const {
        const int row0 = u.pm * 256 + wr * 64 + fr, col = u.aux * 256 + wc * 32 + 8 * fq;
#pragma unroll
        for (int ai = 0; ai < 2; ++ai)
#pragma unroll
            for (int m = 0; m < 4; ++m) {
                const int row = row0 + ai * 128 + m * 16; const u32x2 rec = dw[row]; const int d = (int)rec.x;
                if (d >= 0) { const float ww = __uint_as_float(rec.y); bf16_t* rp = Y + (size_t)d * 1024 + col;
#pragma unroll
                    for (int bj = 0; bj < 2; ++bj) st16d(rp + 128 * bj, pack8(acc[ai][bj][m][0] * ww, acc[ai][bj][m][1] * ww)); }
            }
    }
};

struct InOrder {
    static constexpr bool GATHER = false; DI int row(int, int) const { return 0; }
    pg8::StaticOrder so; int nmain;
    DI bool next(int i, Unit& u) const {
        const long L = (long)i * so.G + so.c;
        if (L < nmain) return so.next(i, u);
        const int idx = (int)(L - nmain); if (idx >= 64) return false;
        u.pm = NTOK / 256 + (idx >> 2); u.pn = 32 + (idx & 3); u.aux = u.pn; return true;
    }
    DI void a_ready(const Unit&) const {}
    DI void done(const Unit&) const {}
};
template <bool GATHER_> struct MoeOrder {
    static constexpr bool GATHER = GATHER_;
    const LAS int* tile_exp; int ntiles, G, c; const LAS int* rowtab;
    DI int row(int ui, int r) const { return rowtab[ui * 256 + r]; }
    DI bool next(int i, Unit& u) const {
        const int nwg = ntiles * 4; const long L = (long)i * G + c; if (L >= nwg) return false;
        int wgid = (int)L; { const int q = nwg / 8, r = nwg % 8, xcd = wgid % 8, off = wgid / 8; wgid = (xcd < r ? xcd * (q + 1) : r * (q + 1) + (xcd - r) * q) + off; }
        u.pm = wgid >> 2; u.aux = wgid & 3; u.pn = tile_exp[u.pm] * 4 + u.aux; return true;
    }
    DI void a_ready(const Unit&) const {}
    DI void done(const Unit&) const {}
};

struct Args { const void* in[24]; float* out; unsigned char* ws; int ph_lo, ph_hi; };
enum { I_X = 0, I_MEM, I_POS, I_GMIX, I_GMEM, I_WIN, I_GQA, I_GKA, I_WCONV, I_WMKV, I_GQM, I_GKM, I_WPA, I_WPC, I_WPM, I_WOUT, I_GFFN, I_WRG, I_BRG, I_WRE, I_BRE, I_WGATE, I_WUP, I_WDOWN };

DI void transpose_item(const float* src, int ldsrc, int k0, int col0, bf16_t* dst, int lddst, int drow0, int dk0, const float* kgain, LAS float* scr, int lane, bool gmode = false) {
    (void)scr;
    const int kg = lane >> 3, nq = lane & 7;
    const float* sp = src + (size_t)(k0 + 8 * kg) * ldsrc + col0 + (gmode ? 16 * (nq >> 1) + 4 * (nq & 1) : 4 * nq);
    f32x4 v[8];
#pragma unroll
    for (int j = 0; j < 8; ++j) v[j] = *(const f32x4*)(sp + (size_t)j * ldsrc);
    if (kgain) { const f32x4 g0 = *(const f32x4*)(kgain + k0 + 8 * kg), g1 = *(const f32x4*)(kgain + k0 + 8 * kg + 4);
        v[0] *= g0.x; v[1] *= g0.y; v[2] *= g0.z; v[3] *= g0.w; v[4] *= g1.x; v[5] *= g1.y; v[6] *= g1.z; v[7] *= g1.w; }
    bf16_t* dp = dst + (size_t)(drow0 + 4 * nq) * lddst + dk0 + 8 * kg;
#pragma unroll
    for (int q = 0; q < 4; ++q) { u32x4 o; o.x = pk2(v[0][q], v[1][q]); o.y = pk2(v[2][q], v[3][q]); o.z = pk2(v[4][q], v[5][q]); o.w = pk2(v[6][q], v[7][q]);
        *(u32x4*)(dp + (size_t)q * lddst) = o; }
}
DI unsigned q8x4(float a, float b, float c, float d) {
    const int ia = (int)__builtin_rintf(a), ib = (int)__builtin_rintf(b), ic = (int)__builtin_rintf(c), id = (int)__builtin_rintf(d);
    return ((unsigned)ia & 0xffu) | (((unsigned)ib & 0xffu) << 8) | (((unsigned)ic & 0xffu) << 16) | ((unsigned)id << 24);
}
DI void quant_gu_item(const float* src  , int lds_, int col0, unsigned char* dst, int drow0, const float* kgain  , float* sb  , int lane) {
    const float* sp = src + (size_t)(16 * lane) * lds_ + col0;
    f32x4 v[16][2];
#pragma unroll
    for (int j = 0; j < 16; ++j) { v[j][0] = *(const f32x4*)(sp + (size_t)j * lds_); v[j][1] = *(const f32x4*)(sp + (size_t)j * lds_ + 4); }
    float g[16];
#pragma unroll
    for (int j4 = 0; j4 < 4; ++j4) { f32x4 gg = {1.f, 1.f, 1.f, 1.f}; if (kgain) gg = *(const f32x4*)(kgain + 16 * lane + 4 * j4); g[4 * j4] = gg.x; g[4 * j4 + 1] = gg.y; g[4 * j4 + 2] = gg.z; g[4 * j4 + 3] = gg.w; }
    float cm[8];
#pragma unroll
    for (int c = 0; c < 8; ++c) cm[c] = 0.f;
#pragma unroll
    for (int j = 0; j < 16; ++j) { v[j][0] *= g[j]; v[j][1] *= g[j];
#pragma unroll
        for (int c = 0; c < 4; ++c) { cm[c] = fmaxf(cm[c], fabsf(v[j][0][c])); cm[4 + c] = fmaxf(cm[4 + c], fabsf(v[j][1][c])); } }
#pragma unroll
    for (int c = 0; c < 8; ++c) {
#pragma unroll
        for (int o = 1; o < 64; o <<= 1) cm[c] = fmaxf(cm[c], __shfl_xor(cm[c], o)); }
    if (lane < 8) { float mine = cm[0];
#pragma unroll
        for (int c = 1; c < 8; ++c) mine = (lane == c) ? cm[c] : mine;
        sb[lane] = mine * (1.f / 127.f); }
#pragma unroll
    for (int c = 0; c < 8; ++c) { const float sc = cm[c] > 0.f ? 127.f / cm[c] : 0.f; u32x4 o;
#pragma unroll
        for (int w = 0; w < 4; ++w) o[w] = q8x4(v[4 * w][c >> 2][c & 3] * sc, v[4 * w + 1][c >> 2][c & 3] * sc, v[4 * w + 2][c >> 2][c & 3] * sc, v[4 * w + 3][c >> 2][c & 3] * sc);
        *(u32x4*)(dst + (size_t)(drow0 + c) * 1024 + 16 * lane) = o; }
}
DI int gperm_col0(int c) { return 64 * ((c >> 5) & 3) + 8 * (c >> 7); }
DI int in_orig_col(int n0) {
    const int t = n0 >> 8, c = n0 & 255;
    if (t < 3)  return (4 * t + ((c >> 5) & 3)) * 64 + 32 * (c >> 7) + (c & 31);
    if (t < 6)  return 768 + (4 * (t - 3) + ((c >> 5) & 3)) * 64 + 32 * (c >> 7) + (c & 31);
    if (t < 9)  return 1536 + (t - 6) * 256 + c;
    if (t < 15) return (c < 128) ? 2304 + 128 * (t - 9) + c : 3840 + 128 * (t - 9) + c - 128;
    if (t < 18) return 3072 + (t - 15) * 256 + c;
    if (t < 20) return 4608 + (t - 18) * 256 + c;
    return 5120 + (t - 20) * 256 + gperm_col0(c);
}
DI void rms_row_to_bf16(const float* xrow, const float* g, bf16_t* orow, int lane) {
    const f32x4* xr = (const f32x4*)xrow + lane; const f32x4* gr = (const f32x4*)g + lane;
    f32x4 v[4]; float s = 0.f;
#pragma unroll
    for (int j = 0; j < 4; ++j) { v[j] = xr[64 * j]; s += (v[j].x * v[j].x + v[j].y * v[j].y) + (v[j].z * v[j].z + v[j].w * v[j].w); }
    const float rstd = __builtin_amdgcn_rsqf(wave_sum(s) * (1.f / 1024.f) + EPS);
    u32x2* o8 = (u32x2*)orow + lane;
#pragma unroll
    for (int j = 0; j < 4; ++j) { const f32x4 gg = gr[64 * j]; u32x2 w; w.x = pk2(v[j].x * rstd * gg.x, v[j].y * rstd * gg.y); w.y = pk2(v[j].z * rstd * gg.z, v[j].w * rstd * gg.w); o8[64 * j] = w; }
}

DI void phase0(const Args& a, LAS unsigned char* lds, int tid, int lane, int wave) {
    const int gw = blockIdx.x * 8 + wave, NGW = gridDim.x * 8;
    LAS float* scr = (LAS float*)(lds + wave * 16384);
    unsigned char* ws = a.ws; unsigned char* dob = (unsigned char*)a.out;
    bf16_t* Wt_in = (bf16_t*)(ws + WS_WIN); bf16_t* Wt_mkv = (bf16_t*)(ws + WS_WMKV); bf16_t* Wt_mrg = (bf16_t*)(ws + WS_WMRG); bf16_t* Wt_out = (bf16_t*)(ws + WS_WOUT);
    constexpr int I_IN = 16 * 160, I_MKV = 16 * 32, I_PA = 4 * 32, I_PC = 12 * 32, I_PM = 8 * 32, I_OUT = 16 * 32, I_G8 = 384;
    constexpr int NITEMS = I_IN + I_MKV + I_PA + I_PC + I_PM + I_OUT + I_G8;
    for (int it = gw; it < NITEMS; it += NGW) {
        int r = it;
        if (r < I_IN) { const int kb = r / 160, nb = r % 160; transpose_item((const float*)a.in[I_WIN], 8192, kb * 64, in_orig_col(nb * 32), Wt_in, 1024, nb * 32, kb * 64, nullptr, scr, lane); continue; } r -= I_IN;
        if (r < I_MKV) { const int kb = r >> 5, nb = r & 31; transpose_item((const float*)a.in[I_WMKV], 1024, kb * 64, nb * 32, Wt_mkv, 1024, nb * 32, kb * 64, nullptr, scr, lane); continue; } r -= I_MKV;
        if (r < I_PA) { const int kb = r >> 5, nb = r & 31; transpose_item((const float*)a.in[I_WPA], 1024, kb * 64, (nb >> 3) * 256 + gperm_col0((nb & 7) * 32), Wt_mrg, 1536, nb * 32, kb * 64, nullptr, scr, lane, true); continue; } r -= I_PA;
        if (r < I_PC) { const int kb = r >> 5, nb = r & 31; transpose_item((const float*)a.in[I_WPC], 1024, kb * 64, (nb >> 3) * 256 + gperm_col0((nb & 7) * 32), Wt_mrg, 1536, nb * 32, 256 + kb * 64, nullptr, scr, lane, true); continue; } r -= I_PC;
        if (r < I_PM) { const int kb = r >> 5, nb = r & 31; transpose_item((const float*)a.in[I_WPM], 1024, kb * 64, (nb >> 3) * 256 + gperm_col0((nb & 7) * 32), Wt_mrg, 1536, nb * 32, 1024 + kb * 64, nullptr, scr, lane, true); continue; } r -= I_PM;
        if (r < I_OUT) { const int kb = r >> 5, nb = r & 31; transpose_item((const float*)a.in[I_WOUT], 1024, kb * 64, nb * 32, Wt_out, 1024, nb * 32, kb * 64, nullptr, scr, lane); continue; } r -= I_OUT;
        {
            const int n0 = r * 8, t = n0 >> 8, c = n0 & 255, bj = c >> 7, wcq = (c >> 5) & 3, fqq = (c >> 3) & 3;
            quant_gu_item((const float*)a.in[I_WIN], 8192, 5120 + t * 256 + 64 * wcq + 16 * fqq + 8 * bj, ws + WS_WG8, n0, nullptr, (float*)(ws + WS_SG) + n0, lane); }
    }
    { const float* x = (const float*)a.in[I_X]; const float* g = (const float*)a.in[I_GMIX]; bf16_t* H = (bf16_t*)(dob + DO_H);
      const f32x4* gr = (const f32x4*)g + lane; f32x4 gg[4];
#pragma unroll
      for (int j = 0; j < 4; ++j) gg[j] = gr[64 * j];
      for (int m0 = 4 * gw; m0 < NTOK; m0 += 4 * NGW) {
          f32x4 v[4][4];
#pragma unroll
          for (int r = 0; r < 4; ++r)
#pragma unroll
              for (int j = 0; j < 4; ++j) v[r][j] = ((const f32x4*)(x + (size_t)(m0 + r) * 1024) + lane)[64 * j];
#pragma unroll
          for (int r = 0; r < 4; ++r) {
              float s = 0.f;
#pragma unroll
              for (int j = 0; j < 4; ++j) s += (v[r][j].x * v[r][j].x + v[r][j].y * v[r][j].y) + (v[r][j].z * v[r][j].z + v[r][j].w * v[r][j].w);
              const float rstd = __builtin_amdgcn_rsqf(wave_sum(s) * (1.f / 1024.f) + EPS);
              u32x2* o8 = (u32x2*)(H + (size_t)(m0 + r) * 1024) + lane;
              float am = 0.f;
#pragma unroll
              for (int j = 0; j < 4; ++j) { v[r][j] = v[r][j] * rstd * gg[j]; u32x2 w; w.x = pk2(v[r][j].x, v[r][j].y); w.y = pk2(v[r][j].z, v[r][j].w); o8[64 * j] = w;
                  am = fmaxf(am, fmaxf(fmaxf(fabsf(v[r][j].x), fabsf(v[r][j].y)), fmaxf(fabsf(v[r][j].z), fabsf(v[r][j].w)))); }
#pragma unroll
              for (int o = 1; o < 64; o <<= 1) am = fmaxf(am, __shfl_xor(am, o));
              const float inv = am > 0.f ? 127.f / am : 0.f;
              unsigned* q8 = (unsigned*)(ws + WS_H8 + (size_t)(m0 + r) * 1024) + lane;
#pragma unroll
              for (int j = 0; j < 4; ++j) q8[64 * j] = q8x4(v[r][j].x * inv, v[r][j].y * inv, v[r][j].z * inv, v[r][j].w * inv);
              if (lane == 0) ((float*)(ws + WS_SH))[m0 + r] = am * (1.f / 127.f);
          }
      } }
    { const float* x = (const float*)a.in[I_MEM]; const float* g = (const float*)a.in[I_GMEM]; bf16_t* H = (bf16_t*)(dob + DO_HM);
      for (int m = gw; m < NMROW; m += NGW) rms_row_to_bf16(x + (size_t)m * 1024, g, H + (size_t)m * 1024, lane); }
    const int gt = blockIdx.x * 512 + tid, NT = gridDim.x * 512;
    { const float* wrg = (const float*)a.in[I_WRG]; const float* wre = (const float*)a.in[I_WRE]; const float* gf = (const float*)a.in[I_GFFN];
      bf16_t* WH = (bf16_t*)(ws + WS_WRH); bf16_t* WL = (bf16_t*)(ws + WS_WRL);
      for (int idx = gt; idx < 48 * 1024; idx += NT) { const int n = idx >> 10, k = idx & 1023;
          float v = 0.f; if (n < 4) v = wrg[k * 4 + n] * gf[k]; else if (n < 36) v = wre[k * 32 + (n - 4)] * gf[k];
          const unsigned hi = pk2(v, 0.f) & 0xffffu; const float lo = v - __uint_as_float(hi << 16);
          WH[idx] = (bf16_t)hi; WL[idx] = (bf16_t)(pk2(lo, 0.f) & 0xffffu); } }
    { const int* pos = (const int*)a.in[I_POS]; float* cs = (float*)(ws + WS_ROPE);
      for (int idx = gt; idx < NTOK * 8; idx += NT) { const int row = idx >> 3, j = idx & 7;
          const double inv = exp2(-(double)j * (18.931568569324174 / 8.0));
          const float invf = (float)inv; const float ang = (float)pos[row] * invf;
          const double ad = (double)ang; cs[row * 16 + j] = (float)cos(ad); cs[row * 16 + 8 + j] = (float)sin(ad); } }
}

typedef short v4i16_t __attribute__((ext_vector_type(4)));
DI s16x4 vtr(const LAS unsigned char* p) { return __builtin_bit_cast(s16x4, __builtin_amdgcn_ds_read_tr16_b64_v4i16((LAS v4i16_t*)p)); }

DI int kimg64(int slot, int c16) { return slot * 128 + ((c16 ^ ((slot >> 1) & 7)) << 4); }
DI int img256(int row, int ch) { return row * 256 + ((ch ^ (((row & 3) << 2) | ((row >> 2) & 3))) << 4); }
constexpr int A_VOFF = 49152, A_VS = 192;
constexpr int M_VOFF = 65536;

struct AUnit { int b, head, gi, hs, dl, L, j, Q0; size_t rowb; };
DI AUnit a_decode(int wu) {
    AUnit u; const int blk8 = wu & 7; const int bh = wu >> 3; u.head = bh % 12; u.b = bh / 12; u.gi = u.head >> 2; u.hs = u.head & 3;
    u.dl = (u.gi == 0) ? 1 : (u.gi == 1) ? 4 : 16; u.L = SEQ / u.dl;
    if (u.gi < 2) { const int npj = u.L >> 8; u.j = blk8 / npj; u.Q0 = (blk8 % npj) << 8; } else { u.j = 2 * blk8; u.Q0 = 0; }
    u.rowb = (size_t)u.b * SEQ; return u;
}
DI void a_wave_geom(const AUnit& u, int wave, int& qsub, int& kj_first, int& slot_first, int& jq) {
    jq = u.j;
    if (u.gi < 2) { qsub = u.Q0 + 32 * wave; kj_first = qsub - 64; slot_first = 32 * wave; }
    else { const int sub = wave >> 2; jq = u.j + sub; qsub = 32 * (wave & 3); kj_first = qsub - 64; slot_first = sub * 128 + kj_first; }
}
DI void a_issue(const AUnit& u, const bf16_t* Q, const bf16_t* K, const bf16_t* V, int tid, int lane, int wave, u32x4 (&kv)[6], u32x4 (&vv)[6], unsigned& okm, bf16x8 (&qf)[4]) {
    const int nsl = (u.gi < 2) ? 384 : 256; okm = 0u;
#pragma unroll
    for (int i = 0; i < 6; ++i) {
        const int p = tid + i * 512, slot = p >> 3, c16 = p & 7; size_t row; bool ok = slot < nsl;
        if (u.gi < 2) { const int kj = u.Q0 - 64 + slot; ok = ok && (kj >= 0 && kj < u.L); row = u.rowb + (size_t)kj * u.dl + u.j; }
        else { row = u.rowb + (size_t)(slot & 127) * 16 + u.j + (slot >> 7); }
        if (ok) { kv[i] = *(const u32x4*)(K + row * 768 + u.head * 64 + c16 * 8); vv[i] = *(const u32x4*)(V + row * 768 + u.head * 64 + c16 * 8); okm |= 1u << i; }
    }
    int qsub, kj_first, slot_first, jq; a_wave_geom(u, wave, qsub, kj_first, slot_first, jq);
    const size_t rowq = u.rowb + (size_t)(qsub + (lane & 31)) * u.dl + jq;
    const bf16_t* qrow = Q + rowq * 768 + u.head * 64;
#pragma unroll
    for (int s = 0; s < 4; ++s) qf[s] = *(const bf16x8*)(qrow + 16 * s + 8 * (lane >> 5));
}
DI void a_fill(LAS unsigned char* lds, int tid, const u32x4 (&kv)[6], const u32x4 (&vv)[6], unsigned okm) {
#pragma unroll
    for (int i = 0; i < 6; ++i) { const int p = tid + i * 512, slot = p >> 3, c16 = p & 7;
        if (okm & (1u << i)) { *(LAS u32x4*)(lds + kimg64(slot, c16)) = kv[i]; *(LAS u32x4*)(lds + A_VOFF + slot * A_VS + c16 * 16) = vv[i]; } }
}
DI void a_compute(const AUnit& u, const bf16x8 (&qf)[4], bf16_t* PO, float* LSE, LAS unsigned char* lds, int lane, int wave) {
    const int gi = u.gi, hs = u.hs, dl = u.dl, L = u.L; const size_t rowb = u.rowb;
    const int r32 = lane & 31, h = lane >> 5;
    int qsub, kj_first, slot_first, jq; a_wave_geom(u, wave, qsub, kj_first, slot_first, jq);
    const size_t rowq = rowb + (size_t)(qsub + r32) * dl + jq;
    f32x16 o[2];
#pragma unroll
    for (int dt = 0; dt < 2; ++dt)
#pragma unroll
        for (int r = 0; r < 16; ++r) o[dt][r] = 0.f;
    float m = -INFINITY, lp = 0.f;
    const int q4 = (lane & 15) >> 2, p4 = lane & 3, blk = (lane >> 4) & 1;
    const int troff = (4 * h + q4) * A_VS + blk * 32 + p4 * 8;
#pragma unroll
    for (int ci = 0; ci < 5; ++ci) {
        const int c = (ci == 0 ? 2 : ci == 1 ? 1 : ci == 2 ? 3 : ci == 3 ? 0 : 4);
        const int kj = kj_first + 32 * c;
        if (kj < 0 || kj >= L) continue;
        const int slot0 = slot_first + 32 * c, ks = slot0 + r32;
        const LAS unsigned char* kp = lds + ks * 128; const int kx = (ks >> 1) & 7;
        f32x16 S;
        const float ninit = (ci == 0) ? 0.f : -m;
#pragma unroll
        for (int r = 0; r < 16; ++r) S[r] = ninit;
#pragma unroll
        for (int s = 0; s < 4; ++s) { const bf16x8 kf = *(const LAS bf16x8*)(kp + (((2 * s + h) ^ kx) << 4)); S = MFMA32(kf, qf[s], S); }
        if (c == 0) {
#pragma unroll
            for (int r = 0; r < 16; ++r) if (crow(r, h) < r32) S[r] = -INFINITY;
        }
        if (c == 4) {
#pragma unroll
            for (int r = 0; r < 16; ++r) if (crow(r, h) > r32) S[r] = -INFINITY;
        }
        float mx = S[0];
#pragma unroll
        for (int r = 1; r < 16; ++r) mx = fmaxf(mx, S[r]);
        mx = fmaxf(mx, __shfl_xor(mx, 32));
        if (ci == 0 || __builtin_amdgcn_ballot_w64(mx > 8.f) != 0ull) {
            const float d = (ci == 0) ? mx : fmaxf(mx, 0.f), al = fexp2(-d);
            m = ((ci == 0) ? 0.f : m) + d; lp *= al;
#pragma unroll
            for (int r = 0; r < 16; ++r) S[r] -= d;
#pragma unroll
            for (int dt = 0; dt < 2; ++dt)
#pragma unroll
                for (int r = 0; r < 16; ++r) o[dt][r] *= al;
        }
        float rsum = 0.f;
#pragma unroll
        for (int r = 0; r < 16; ++r) { S[r] = fexp2(S[r]); rsum += S[r]; }
        lp += rsum;
        bf16x8 pb[2];
#pragma unroll
        for (int s2 = 0; s2 < 2; ++s2) { u32x4 w; w.x = pk2(S[8 * s2], S[8 * s2 + 1]); w.y = pk2(S[8 * s2 + 2], S[8 * s2 + 3]); w.z = pk2(S[8 * s2 + 4], S[8 * s2 + 5]); w.w = pk2(S[8 * s2 + 6], S[8 * s2 + 7]); pb[s2] = __builtin_bit_cast(bf16x8, w); }
        const LAS unsigned char* trp = lds + A_VOFF + slot0 * A_VS + troff;
#pragma unroll
        for (int dt = 0; dt < 2; ++dt)
#pragma unroll
            for (int s2 = 0; s2 < 2; ++s2) {
                const s16x4 lo = vtr(trp + (16 * s2) * A_VS + dt * 64), hi = vtr(trp + (16 * s2 + 8) * A_VS + dt * 64);
                const bf16x8 va = __builtin_shufflevector(lo, hi, 0, 1, 2, 3, 4, 5, 6, 7);
                o[dt] = MFMA32(va, pb[s2], o[dt]);
            }
    }
    const float l = lp + __shfl_xor(lp, 32), inv = 1.f / l;
    if (h == 0) LSE[((size_t)gi * NTOK + rowq) * 4 + hs] = m + __builtin_amdgcn_logf(l);
    __syncthreads();
    { LAS unsigned char* ot = lds + wave * 4096;
#pragma unroll
      for (int dt = 0; dt < 2; ++dt)
#pragma unroll
          for (int g4 = 0; g4 < 4; ++g4) { u32x2 w; w.x = pk2(o[dt][4 * g4] * inv, o[dt][4 * g4 + 1] * inv); w.y = pk2(o[dt][4 * g4 + 2] * inv, o[dt][4 * g4 + 3] * inv);
              *(LAS u32x2*)(ot + r32 * 128 + (32 * dt + 8 * g4 + 4 * h) * 2) = w; }
      asm volatile("s_waitcnt lgkmcnt(0)" ::: "memory");
#pragma unroll
      for (int i = 0; i < 4; ++i) { const int q = i * 8 + (lane >> 3), c16 = lane & 7;
          const u32x4 w = *(const LAS u32x4*)(ot + q * 128 + c16 * 16);
          const size_t rq = rowb + (size_t)(qsub + q) * dl + jq;
          *(u32x4*)(PO + ((size_t)gi * NTOK + rq) * 256 + hs * 64 + c16 * 8) = w; }
    }
    __syncthreads();
}


DI void attnM_wg(int wu, const bf16_t* QM, const bf16_t* KM, const bf16_t* VM, const float* gqm, const float* gkm, bf16_t* AM, LAS unsigned char* lds, int tid, int lane, int wave) {
    const int qblk = wu & 7, head = (wu >> 3) & 3, b = wu >> 5;
    { const bf16_t* kb = KM + (size_t)b * NMEM * 512 + head * 128; const bf16_t* vb = VM + (size_t)b * NMEM * 512 + head * 128;
      u32x4 kv[8], vv[8];
#pragma unroll
      for (int i = 0; i < 8; ++i) { const int p = tid + i * 512, row = p >> 4, ch = p & 15;
          kv[i] = *(const u32x4*)(kb + (size_t)row * 512 + ch * 8); vv[i] = *(const u32x4*)(vb + (size_t)row * 512 + ch * 8); }
      const int chl = tid & 15; const f32x4 g0 = *(const f32x4*)(gkm + chl * 8), g1 = *(const f32x4*)(gkm + chl * 8 + 4);
#pragma unroll
      for (int i = 0; i < 8; ++i) { const int p = tid + i * 512, row = p >> 4, ch = p & 15;
          float x[8]; x[0] = bf_lo(kv[i].x); x[1] = bf_hi(kv[i].x); x[2] = bf_lo(kv[i].y); x[3] = bf_hi(kv[i].y); x[4] = bf_lo(kv[i].z); x[5] = bf_hi(kv[i].z); x[6] = bf_lo(kv[i].w); x[7] = bf_hi(kv[i].w);
          float ss = (x[0] * x[0] + x[1] * x[1]) + (x[2] * x[2] + x[3] * x[3]) + (x[4] * x[4] + x[5] * x[5]) + (x[6] * x[6] + x[7] * x[7]);
          ss += __shfl_xor(ss, 1); ss += __shfl_xor(ss, 2); ss += __shfl_xor(ss, 4); ss += __shfl_xor(ss, 8);
          const float rs = __builtin_amdgcn_rsqf(ss * (1.f / 128.f) + EPS);
          u32x4 kn; kn.x = pk2(x[0] * rs * g0.x, x[1] * rs * g0.y); kn.y = pk2(x[2] * rs * g0.z, x[3] * rs * g0.w); kn.z = pk2(x[4] * rs * g1.x, x[5] * rs * g1.y); kn.w = pk2(x[6] * rs * g1.z, x[7] * rs * g1.w);
          const int off = img256(row, ch); *(LAS u32x4*)(lds + off) = kn; *(LAS u32x4*)(lds + M_VOFF + off) = vv[i]; } }
    __syncthreads();
    const int r32 = lane & 31, h = lane >> 5;
    const int q4 = (lane & 15) >> 2, p4 = lane & 3, blk = (lane >> 4) & 1;
    const int kxor = ((r32 & 3) << 2) | ((r32 >> 2) & 3);
    const int vlow0 = ((2 * blk + (p4 >> 1)) ^ (h & 3)) << 4, vlow1 = ((2 * blk + (p4 >> 1)) ^ ((h + 2) & 3)) << 4;
    {
        const size_t rowq = (size_t)b * SEQ + qblk * 256 + wave * 32 + r32;
        const bf16_t* qrow = QM + rowq * 512 + head * 128;
        bf16x8 qf[8];
#pragma unroll
        for (int s = 0; s < 8; ++s) qf[s] = *(const bf16x8*)(qrow + 16 * s + 8 * h);
        { float ss = 0.f;
#pragma unroll
          for (int s = 0; s < 8; ++s)
#pragma unroll
              for (int jx = 0; jx < 8; ++jx) { const float x = bf2f(qf[s][jx]); ss += x * x; }
          ss += __shfl_xor(ss, 32);
          const float rs = __builtin_amdgcn_rsqf(ss * (1.f / 128.f) + EPS) * QSCALE_M;
#pragma unroll
          for (int s = 0; s < 8; ++s) {
              const f32x4 g0 = *(const f32x4*)(gqm + 16 * s + 8 * h), g1 = *(const f32x4*)(gqm + 16 * s + 8 * h + 4);
              u32x4 w;
              w.x = pk2(bf2f(qf[s][0]) * rs * g0.x, bf2f(qf[s][1]) * rs * g0.y); w.y = pk2(bf2f(qf[s][2]) * rs * g0.z, bf2f(qf[s][3]) * rs * g0.w);
              w.z = pk2(bf2f(qf[s][4]) * rs * g1.x, bf2f(qf[s][5]) * rs * g1.y); w.w = pk2(bf2f(qf[s][6]) * rs * g1.z, bf2f(qf[s][7]) * rs * g1.w);
              qf[s] = __builtin_bit_cast(bf16x8, w); } }
        f32x16 o[4];
#pragma unroll
        for (int dt = 0; dt < 4; ++dt)
#pragma unroll
            for (int r = 0; r < 16; ++r) o[dt][r] = 0.f;
        float m = -INFINITY, lp = 0.f;
#pragma unroll 1
        for (int c = 0; c < 8; ++c) {
            const int slot0 = 32 * c;
            const LAS unsigned char* kp = lds + (slot0 + r32) * 256;
            f32x16 S;
            const float ninit = (c == 0) ? 0.f : -m;
#pragma unroll
            for (int r = 0; r < 16; ++r) S[r] = ninit;
#pragma unroll
            for (int s = 0; s < 8; ++s) { const bf16x8 kf = *(const LAS bf16x8*)(kp + (((2 * s + h) ^ kxor) << 4)); S = MFMA32(kf, qf[s], S); }
            float mx = S[0];
#pragma unroll
            for (int r = 1; r < 16; ++r) mx = fmaxf(mx, S[r]);
            mx = fmaxf(mx, __shfl_xor(mx, 32));
            if (c == 0 || __builtin_amdgcn_ballot_w64(mx > 8.f) != 0ull) {
                const float d = (c == 0) ? mx : fmaxf(mx, 0.f), al = fexp2(-d);
                m = ((c == 0) ? 0.f : m) + d; lp *= al;
#pragma unroll
                for (int r = 0; r < 16; ++r) S[r] -= d;
#pragma unroll
                for (int dt = 0; dt < 4; ++dt)
#pragma unroll
                    for (int r = 0; r < 16; ++r) o[dt][r] *= al;
            }
            float rsum = 0.f;
#pragma unroll
            for (int r = 0; r < 16; ++r) { S[r] = fexp2(S[r]); rsum += S[r]; }
            lp += rsum;
            bf16x8 pb[2];
#pragma unroll
            for (int s2 = 0; s2 < 2; ++s2) { u32x4 w; w.x = pk2(S[8 * s2], S[8 * s2 + 1]); w.y = pk2(S[8 * s2 + 2], S[8 * s2 + 3]); w.z = pk2(S[8 * s2 + 4], S[8 * s2 + 5]); w.w = pk2(S[8 * s2 + 6], S[8 * s2 + 7]); pb[s2] = __builtin_bit_cast(bf16x8, w); }
            const LAS unsigned char* vp = lds + M_VOFF + (slot0 + 4 * h + q4) * 256 + (p4 & 1) * 8;
#pragma unroll
            for (int dt = 0; dt < 4; ++dt)
#pragma unroll
                for (int s2 = 0; s2 < 2; ++s2) {
                    const s16x4 lo = vtr(vp + (16 * s2) * 256 + ((dt ^ q4) << 6) + vlow0), hi = vtr(vp + (16 * s2 + 8) * 256 + ((dt ^ q4) << 6) + vlow1);
                    const bf16x8 va = __builtin_shufflevector(lo, hi, 0, 1, 2, 3, 4, 5, 6, 7);
                    o[dt] = MFMA32(va, pb[s2], o[dt]);
                }
        }
        const float l = lp + __shfl_xor(lp, 32), inv = 1.f / l;
        __syncthreads();
        LAS unsigned char* ot = lds + wave * 8192;
#pragma unroll
        for (int dt = 0; dt < 4; ++dt)
#pragma unroll
            for (int g4 = 0; g4 < 4; ++g4) { u32x2 w; w.x = pk2(o[dt][4 * g4] * inv, o[dt][4 * g4 + 1] * inv); w.y = pk2(o[dt][4 * g4 + 2] * inv, o[dt][4 * g4 + 3] * inv);
                *(LAS u32x2*)(ot + r32 * 256 + (32 * dt + 8 * g4 + 4 * h) * 2) = w; }
        asm volatile("s_waitcnt lgkmcnt(0)" ::: "memory");
        const size_t rowq0 = (size_t)b * SEQ + qblk * 256 + wave * 32;
#pragma unroll
        for (int i = 0; i < 8; ++i) { const int q = i * 4 + (lane >> 4), c16 = lane & 15;
            const u32x4 w = *(const LAS u32x4*)(ot + q * 256 + c16 * 16);
            *(u32x4*)(AM + (rowq0 + q) * 1536 + 1024 + head * 128 + c16 * 8) = w; }
    }
    __syncthreads();
}

DI void p2_attnA(const Args& a, LAS unsigned char* lds, int tid, int lane, int wave) {
    unsigned char* ws = a.ws; const int G = gridDim.x; const int vcu = (G % 8 == 0) ? ((int)blockIdx.x % 8) * (G / 8) + (int)blockIdx.x / 8 : (int)blockIdx.x;
    const bf16_t* Q = (const bf16_t*)(ws + WS_Q); const bf16_t* K = (const bf16_t*)(ws + WS_K); const bf16_t* V = (const bf16_t*)(ws + WS_V);
    bf16_t* PO = (bf16_t*)(ws + WS_PO); float* LSE = (float*)(ws + WS_LSE);
    constexpr int NU = NB * 12 * 8;
    const int per = (NU + G - 1) / G, u0 = vcu * per, u1 = (u0 + per < NU) ? u0 + per : NU;
    if (u0 >= u1) return;
    u32x4 kv[6], vv[6]; unsigned okm; bf16x8 qn[4];
    AUnit cu = a_decode(u0);
    a_issue(cu, Q, K, V, tid, lane, wave, kv, vv, okm, qn);
    for (int u = u0; u < u1; ++u) {
        a_fill(lds, tid, kv, vv, okm);
        bf16x8 qf[4];
#pragma unroll
        for (int s = 0; s < 4; ++s) qf[s] = qn[s];
        __syncthreads();
        AUnit nu = cu;
        if (u + 1 < u1) { nu = a_decode(u + 1); a_issue(nu, Q, K, V, tid, lane, wave, kv, vv, okm, qn); }
        a_compute(cu, qf, PO, LSE, lds, lane, wave);
        cu = nu;
    }
}
DI void p2_attnM(const Args& a, LAS unsigned char* lds, int tid, int lane, int wave) {
    unsigned char* ws = a.ws; unsigned char* dob = (unsigned char*)a.out; const int G = gridDim.x; const int vcu = (G % 8 == 0) ? ((int)blockIdx.x % 8) * (G / 8) + (int)blockIdx.x / 8 : (int)blockIdx.x;
    bf16_t* AM = (bf16_t*)(ws + WS_AM);
    const bf16_t* QM = (const bf16_t*)(dob + DO_QM); const bf16_t* KM = (const bf16_t*)(dob + DO_KM); const bf16_t* VM = (const bf16_t*)(dob + DO_VM);
    for (int u = vcu; u < NB * 4 * 8; u += G) attnM_wg(u, QM, KM, VM, (const float*)a.in[I_GQM], (const float*)a.in[I_GKM], AM, lds, tid, lane, wave);
}
DI void p2_conv(const Args& a, int tid) {
    unsigned char* ws = a.ws; bf16_t* AM = (bf16_t*)(ws + WS_AM);
    const bf16_t* U = (const bf16_t*)(ws + WS_U); const bf16_t* CB = (const bf16_t*)(ws + WS_CB); const float* wc = (const float*)a.in[I_WCONV];
    const int gt = blockIdx.x * 512 + tid, NT = gridDim.x * 512;
    constexpr int TB = 8;
    for (int idx = gt; idx < (NTOK / TB) * 96; idx += NT) {
        const int tb = idx / 96, c8 = (idx % 96) * 8, row0 = tb * TB, s0 = row0 & (SEQ - 1);
        u32x4 uu[TB + 2], cb[TB];
        const u32x4 zero = {0u, 0u, 0u, 0u};
        uu[0] = (s0 > 0) ? *(const u32x4*)(U + (size_t)(row0 - 1) * 768 + c8) : zero;
#pragma unroll
        for (int t = 0; t < TB; ++t) { uu[t + 1] = *(const u32x4*)(U + (size_t)(row0 + t) * 768 + c8); cb[t] = *(const u32x4*)(CB + (size_t)(row0 + t) * 768 + c8); }
        uu[TB + 1] = (s0 + TB < SEQ) ? *(const u32x4*)(U + (size_t)(row0 + TB) * 768 + c8) : zero;
        float k0[8], k1[8], k2[8];
        { const f32x4 a0 = *(const f32x4*)(wc + c8), a1 = *(const f32x4*)(wc + c8 + 4), b0 = *(const f32x4*)(wc + 768 + c8), b1 = *(const f32x4*)(wc + 768 + c8 + 4),
                      d0 = *(const f32x4*)(wc + 1536 + c8), d1 = *(const f32x4*)(wc + 1536 + c8 + 4);
#pragma unroll
          for (int q = 0; q < 4; ++q) { k0[q] = a0[q]; k0[4 + q] = a1[q]; k1[q] = b0[q]; k1[4 + q] = b1[q]; k2[q] = d0[q]; k2[4 + q] = d1[q]; } }
#pragma unroll
        for (int t = 0; t < TB; ++t) {
            u32x4 o;
#pragma unroll
            for (int w = 0; w < 4; ++w) {
                const float y0 = k0[2 * w] * bf_lo(uu[t][w]) + k1[2 * w] * bf_lo(uu[t + 1][w]) + k2[2 * w] * bf_lo(uu[t + 2][w]);
                const float y1 = k0[2 * w + 1] * bf_hi(uu[t][w]) + k1[2 * w + 1] * bf_hi(uu[t + 1][w]) + k2[2 * w + 1] * bf_hi(uu[t + 2][w]);
                o[w] = pk2(bf_lo(cb[t][w]) * y0, bf_hi(cb[t][w]) * y1);
            }
            *(u32x4*)(AM + (size_t)(row0 + t) * 1536 + 256 + c8) = o;
        }
    }
}
#ifndef P2_REP
#define P2_REP 0
#endif
DI void phase2(const Args& a, LAS unsigned char* lds, int tid, int lane, int wave) {
#ifndef P2_PARTS
#define P2_PARTS 7
#endif
    if constexpr (P2_PARTS & 1) p2_attnA(a, lds, tid, lane, wave);
    if constexpr (P2_REP & 1) p2_attnA(a, lds, tid, lane, wave);
    __builtin_amdgcn_sched_barrier(0); asm volatile("" ::: "memory");
    if constexpr (P2_PARTS & 2) p2_attnM(a, lds, tid, lane, wave);
    if constexpr (P2_REP & 2) p2_attnM(a, lds, tid, lane, wave);
    if constexpr (P2_PARTS & 4) p2_conv(a, tid);
    if constexpr (P2_REP & 4) p2_conv(a, tid);
}

DI void attn_combine(const Args& a, int tid) {
    unsigned char* ws = a.ws;
    const bf16_t* PO = (const bf16_t*)(ws + WS_PO); const float* LSE = (const float*)(ws + WS_LSE); bf16_t* AM = (bf16_t*)(ws + WS_AM);
    const int gt = blockIdx.x * 512 + tid, NT = gridDim.x * 512;
    for (int idx = gt; idx < NTOK * 32; idx += NT) {
        const int row = idx >> 5, c8 = (idx & 31) * 8, hs = c8 >> 6;
        const float l0 = LSE[(size_t)row * 4 + hs], l1 = LSE[((size_t)NTOK + row) * 4 + hs], l2 = LSE[((size_t)2 * NTOK + row) * 4 + hs];
        const float mx = fmaxf(l0, fmaxf(l1, l2)); float w0 = fexp2(l0 - mx), w1 = fexp2(l1 - mx), w2 = fexp2(l2 - mx);
        const float inv = 1.f / (w0 + w1 + w2); w0 *= inv; w1 *= inv; w2 *= inv;
        const u32x4 a0 = *(const u32x4*)(PO + (size_t)row * 256 + c8), a1 = *(const u32x4*)(PO + ((size_t)NTOK + row) * 256 + c8), a2 = *(const u32x4*)(PO + ((size_t)2 * NTOK + row) * 256 + c8);
        u32x4 o;
#pragma unroll
        for (int w = 0; w < 4; ++w) o[w] = pk2(w0 * bf_lo(a0[w]) + w1 * bf_lo(a1[w]) + w2 * bf_lo(a2[w]), w0 * bf_hi(a0[w]) + w1 * bf_hi(a1[w]) + w2 * bf_hi(a2[w]));
        *(u32x4*)(AM + (size_t)row * 1536 + c8) = o;
    }
}

DI void phase6(const Args& a, LAS unsigned char* lds, int tid, int lane, int wave) {
    unsigned char* ws = a.ws;
    const bf16_t* XB = (const bf16_t*)(ws + WS_XB);
    const bf16_t* WH = (const bf16_t*)(ws + WS_WRH); const bf16_t* WL = (const bf16_t*)(ws + WS_WRL);
    const float* brg = (const float*)a.in[I_BRG]; const float* bre = (const float*)a.in[I_BRE];
    int* tok_e = (int*)(ws + WS_RT + RT_TOKE); int* tok_rank = (int*)(ws + WS_RT + RT_RANK); float* tok_w = (float*)(ws + WS_RT + RT_W);
    float* tok_rstd = (float*)(ws + WS_RT + RT_RSTD); int* ccnt = (int*)(ws + WS_RT + RT_CCNT);
    LAS int* asg = (LAS int*)(lds + 32768);
    LAS int* rnk = (LAS int*)(lds + 32768 + 1024);
    bool first = true;
    for (int chunk = blockIdx.x; chunk < NTOK / 128; chunk += gridDim.x) {
        {
            constexpr int WP = 272;
            constexpr int SLB = 48 * WP;
            LAS unsigned char* wbuf = lds + 40960;
            LAS float* lg = (LAS float*)(lds + wave * 4096);
            const int t0 = chunk * 128 + wave * 16, row = lane & 15, kq = lane >> 4;
            const bf16_t* xp = XB + (size_t)(t0 + row) * 1024 + 8 * kq;
            u32x4 wst[3];
#define RT_STAGE_LOAD(sl) do { _Pragma("unroll") for (int i = 0; i < 3; ++i) { const int p = tid + i * 512, arr = p / 768, q = p % 768, r = q >> 4, c = q & 15; \
                wst[i] = *(const u32x4*)((arr ? WL : WH) + (size_t)r * 1024 + (sl) * 128 + c * 8); } } while (0)
#define RT_STAGE_WRITE(buf) do { _Pragma("unroll") for (int i = 0; i < 3; ++i) { const int p = tid + i * 512, arr = p / 768, q = p % 768, r = q >> 4, c = q & 15; \
                *(LAS u32x4*)(wbuf + ((buf) * 2 + arr) * SLB + r * WP + c * 16) = wst[i]; } } while (0)
            RT_STAGE_LOAD(0); RT_STAGE_WRITE(0);
            __syncthreads();
            pg8::f32x4 acc[3]; acc[0] = acc[1] = acc[2] = (pg8::f32x4){0.f, 0.f, 0.f, 0.f};
            float ss = 0.f, amax = 0.f;
#pragma unroll 1
            for (int sl = 0; sl < 8; ++sl) {
                if (sl + 1 < 8) RT_STAGE_LOAD(sl + 1);
                u32x4 xv[4];
#pragma unroll
                for (int ks = 0; ks < 4; ++ks) xv[ks] = *(const u32x4*)(xp + sl * 128 + 32 * ks);
                const LAS unsigned char* wb = wbuf + (sl & 1) * 2 * SLB;
#pragma unroll
                for (int ks = 0; ks < 4; ++ks) {
                    const u32x4 hi = xv[ks];
#pragma unroll
                    for (int w = 0; w < 4; ++w) { const float e0 = bf_lo(hi[w]), e1 = bf_hi(hi[w]); ss += e0 * e0 + e1 * e1; amax = fmaxf(amax, fmaxf(fabsf(e0), fabsf(e1))); }
                    const bf16x8 ah = __builtin_bit_cast(bf16x8, hi);
#pragma unroll
                    for (int nt = 0; nt < 3; ++nt) {
                        const bf16x8 bh = *(const LAS bf16x8*)(wb + (16 * nt + row) * WP + (32 * ks + 8 * kq) * 2);
                        const bf16x8 bl = *(const LAS bf16x8*)(wb + SLB + (16 * nt + row) * WP + (32 * ks + 8 * kq) * 2);
                        acc[nt] = MFMA16(ah, bh, acc[nt]); acc[nt] = MFMA16(ah, bl, acc[nt]);
                    }
                }
                if (sl + 1 < 8) RT_STAGE_WRITE((sl + 1) & 1);
                __syncthreads();
            }
#undef RT_STAGE_LOAD
#undef RT_STAGE_WRITE
            ss += __shfl_xor(ss, 16); ss += __shfl_xor(ss, 32);
            amax = fmaxf(amax, __shfl_xor(amax, 16)); amax = fmaxf(amax, __shfl_xor(amax, 32));
            {
#pragma unroll 4
                for (int r = 0; r < 16; ++r) { const float am = __shfl(amax, r); const float inv = am > 0.f ? 127.f / am : 0.f;
                    const bf16_t* rp = XB + (size_t)(t0 + r) * 1024 + 16 * lane; const u32x4 x0 = *(const u32x4*)rp, x1 = *(const u32x4*)(rp + 8);
                    u32x4 o; o.x = q8x4(bf_lo(x0.x) * inv, bf_hi(x0.x) * inv, bf_lo(x0.y) * inv, bf_hi(x0.y) * inv); o.y = q8x4(bf_lo(x0.z) * inv, bf_hi(x0.z) * inv, bf_lo(x0.w) * inv, bf_hi(x0.w) * inv);
                    o.z = q8x4(bf_lo(x1.x) * inv, bf_hi(x1.x) * inv, bf_lo(x1.y) * inv, bf_hi(x1.y) * inv); o.w = q8x4(bf_lo(x1.z) * inv, bf_hi(x1.z) * inv, bf_lo(x1.w) * inv, bf_hi(x1.w) * inv);
                    *(u32x4*)(ws + WS_XB8 + (size_t)(t0 + r) * 1024 + 16 * lane) = o; }
            }
#pragma unroll
            for (int nt = 0; nt < 3; ++nt)
#pragma unroll
                for (int r = 0; r < 4; ++r) lg[(kq * 4 + r) * 48 + 16 * nt + row] = acc[nt][r];
            asm volatile("s_waitcnt lgkmcnt(0)" ::: "memory");
            if (lane < 16) {
                const int tok = t0 + lane; const float rstd = __builtin_amdgcn_rsqf(ss * (1.f / 1024.f) + EPS);
                const LAS float* lp = lg + lane * 48;
                float gv[4]; int g = 0;
#pragma unroll
                for (int n = 0; n < 4; ++n) gv[n] = lp[n] * rstd + brg[n];
                float gm = gv[0];
#pragma unroll
                for (int n = 1; n < 4; ++n) if (gv[n] > gm) { gm = gv[n]; g = n; }
                float gz = 0.f;
#pragma unroll
                for (int n = 0; n < 4; ++n) gz += fexp(gv[n] - gm);
                const float pg = 1.f / gz;
                float sv[8];
#pragma unroll
                for (int e = 0; e < 8; ++e) sv[e] = lp[4 + 8 * g + e] * rstd + bre[8 * g + e];
                int i0 = 0; float s0 = sv[0];
#pragma unroll
                for (int e = 1; e < 8; ++e) if (sv[e] > s0) { s0 = sv[e]; i0 = e; }
                int i1 = -1; float s1 = -INFINITY;
#pragma unroll
                for (int e = 0; e < 8; ++e) if (e != i0 && sv[e] > s1) { s1 = sv[e]; i1 = e; }
                const float r = fexp(s1 - s0), w0 = pg / (1.f + r), w1 = w0 * r;
                const int al2 = (wave * 16 + lane) * 2;
                asg[al2] = g * 8 + i0; asg[al2 + 1] = g * 8 + i1;
                tok_w[tok * 2] = w0; tok_w[tok * 2 + 1] = w1; tok_rstd[tok] = rstd * amax * (1.f / 127.f);
            }
        }
        first = false;
        __syncthreads();
        int my_e = 0, my_rank = 0;
        if (tid < 256) { my_e = asg[tid];
            for (int ee = 0; ee < 32; ++ee) { const unsigned long long mk = __ballot(my_e == ee);
                if (my_e == ee) my_rank = __popcll(mk & ((1ull << lane) - 1ull));
                if (lane == 0) rnk[wave * 32 + ee] = __popcll(mk); } }
        __syncthreads();
        if (tid < 256) { int base = 0;
            for (int w = 0; w < wave; ++w) base += rnk[w * 32 + my_e];
            const int tok = chunk * 128 + (tid >> 1); tok_e[tok * 2 + (tid & 1)] = my_e; tok_rank[tok * 2 + (tid & 1)] = base + my_rank; }
        if (tid < 32) ccnt[chunk * 32 + tid] = rnk[tid] + rnk[32 + tid] + rnk[64 + tid] + rnk[96 + tid];
        __syncthreads();
    }
}

DI void moe_weight_convert(const Args& a, int cw, int NCW, int lane) {
    unsigned char* ws = a.ws;
    unsigned char* WGU = ws + WS_WGU; bf16_t* WD = (bf16_t*)(ws + WS_WD); float* SB = (float*)(ws + WS_SB);
    const float* wg = (const float*)a.in[I_WGATE]; const float* wu = (const float*)a.in[I_WUP]; const float* wd = (const float*)a.in[I_WDOWN]; const float* gf = (const float*)a.in[I_GFFN];
    constexpr int I_GU = 32 * 128, I_D = 32 * 8 * 32;
    for (int it = cw; it < I_GU + I_D; it += NCW) {
        if (it < I_GU) { const int e = it >> 7, nb8 = it & 127;
            const int t = nb8 >> 5, c = (nb8 & 31) * 8; const bool up = c >= 128; const int ff = 128 * t + (up ? c - 128 : c);
            quant_gu_item((up ? wu : wg) + (size_t)e * 1024 * 512, 512, ff, WGU + (size_t)e * 1024 * 1024, nb8 * 8, gf, SB + (size_t)e * 1024 + nb8 * 8, lane);
        } else { const int r2 = it - I_GU, e = r2 >> 8, r = r2 & 255, kb = r >> 5, nb = r & 31;
            transpose_item(wd + (size_t)e * 512 * 1024, 1024, kb * 64, nb * 32, WD + (size_t)e * 1024 * 512, 512, nb * 32, kb * 64, nullptr, nullptr, lane); }
    }
}

DI void phase7(const Args& a, LAS unsigned char* lds, int tid, int lane, int wave) {
    unsigned char* ws = a.ws;
    const int* tok_e = (const int*)(ws + WS_RT + RT_TOKE); const int* tok_rank = (const int*)(ws + WS_RT + RT_RANK); const float* tok_w = (const float*)(ws + WS_RT + RT_W);
    const float* tok_rstd = (const float*)(ws + WS_RT + RT_RSTD); const int* ccnt = (const int*)(ws + WS_RT + RT_CCNT); int* meta = (int*)(ws + WS_RT + RT_META);
    u32x2* sr_dw = (u32x2*)(ws + WS_SROW);
    int* rowtok = (int*)(ws + WS_SROW + 640 * 1024); float* sr_rstd = (float*)(ws + WS_SROW + 960 * 1024);
    LAS int* red = (LAS int*)lds;
    LAS int* tot = red + 1024;
    LAS int* bef = tot + 32;
    LAS int* pst = bef + 32;
    for (int chunk = blockIdx.x; chunk < NTOK / 128; chunk += gridDim.x) {
        { const int e = tid & 31, cgp = tid >> 5; int pt = 0, pb = 0;
          for (int c = cgp * 16; c < cgp * 16 + 16; ++c) { const int v = ccnt[c * 32 + e]; pt += v; if (c < chunk) pb += v; }
          red[cgp * 32 + e] = pt; red[512 + cgp * 32 + e] = pb; }
        __syncthreads();
        if (tid < 32) { int t = 0, b = 0; for (int q = 0; q < 16; ++q) { t += red[q * 32 + tid]; b += red[512 + q * 32 + tid]; } tot[tid] = t; bef[tid] = b; }
        __syncthreads();
        if (tid == 0) { int p = 0; for (int e = 0; e < 32; ++e) { pst[e] = p; p += (tot[e] + 255) & ~255; } pst[32] = p; }
        __syncthreads();
        if (lane < 16) {
            const int tokl = chunk * 128 + wave * 16 + lane;
            const int e0 = tok_e[tokl * 2], e1 = tok_e[tokl * 2 + 1], r0 = tok_rank[tokl * 2], r1 = tok_rank[tokl * 2 + 1];
            const float w0 = tok_w[tokl * 2], w1 = tok_w[tokl * 2 + 1], rs = tok_rstd[tokl];
            const int d0 = pst[e0] + bef[e0] + r0, d1 = pst[e1] + bef[e1] + r1;
            u32x2 r0v; r0v.x = (unsigned)(tokl * 2); r0v.y = __float_as_uint(w0); sr_dw[d0] = r0v; u32x2 r1v; r1v.x = (unsigned)(tokl * 2 + 1); r1v.y = __float_as_uint(w1); sr_dw[d1] = r1v;
            rowtok[d0] = tokl; rowtok[d1] = tokl; sr_rstd[d0] = rs; sr_rstd[d1] = rs;
        }
        if (chunk < 32) { const int e = chunk, p0 = pst[e], pe = pst[e + 1];
            for (int r = p0 + tot[e] + tid; r < pe; r += 512) { u32x2 z; z.x = 0xffffffffu; z.y = 0u; sr_dw[r] = z; rowtok[r] = 0; sr_rstd[r] = 0.f; } }
        if (chunk == 0) { const int nt = pst[32] >> 8; if (tid == 0) meta[0] = nt;
            for (int t = tid; t < nt; t += 512) { int e = 0; for (int q = 1; q < 32; ++q) if ((pst[q] >> 8) <= t) e = q; meta[1 + t] = e; } }
        __syncthreads();
    }
}

DI int load_tile_table(const Args& a, LAS unsigned char* lds, int tid) {
    const int* meta = (const int*)(a.ws + WS_RT + RT_META); LAS int* tbl = (LAS int*)(lds + MISC_OFF);
    const int nt = meta[0];
    for (int i = tid; i < nt; i += 512) tbl[i] = meta[1 + i];
    __syncthreads();
    return nt;
}

DI void phase10(const Args& a, int lane, int wave) {
    const bf16_t* Y = (const bf16_t*)(a.ws + WS_Y); const bf16_t* XB = (const bf16_t*)(a.ws + WS_XB); float* O = a.out;
    const int gw = blockIdx.x * 8 + wave, NGW = gridDim.x * 8;
    for (int tok = gw; tok < NTOK; tok += NGW) {
        u32x4 xv[2], y0[2], y1[2];
#pragma unroll
        for (int j = 0; j < 2; ++j) { const size_t c = (size_t)j * 512 + lane * 8;
            xv[j] = *(const u32x4*)(XB + (size_t)tok * 1024 + c); y0[j] = *(const u32x4*)(Y + (size_t)(tok * 2) * 1024 + c); y1[j] = *(const u32x4*)(Y + (size_t)(tok * 2 + 1) * 1024 + c); }
#pragma unroll
        for (int j = 0; j < 2; ++j) { const size_t c = (size_t)j * 512 + lane * 8;
            f32x4 o0, o1;
            o0.x = bf_lo(xv[j].x) + bf_lo(y0[j].x) + bf_lo(y1[j].x); o0.y = bf_hi(xv[j].x) + bf_hi(y0[j].x) + bf_hi(y1[j].x);
            o0.z = bf_lo(xv[j].y) + bf_lo(y0[j].y) + bf_lo(y1[j].y); o0.w = bf_hi(xv[j].y) + bf_hi(y0[j].y) + bf_hi(y1[j].y);
            o1.x = bf_lo(xv[j].z) + bf_lo(y0[j].z) + bf_lo(y1[j].z); o1.y = bf_hi(xv[j].z) + bf_hi(y0[j].z) + bf_hi(y1[j].z);
            o1.z = bf_lo(xv[j].w) + bf_lo(y0[j].w) + bf_lo(y1[j].w); o1.w = bf_hi(xv[j].w) + bf_hi(y0[j].w) + bf_hi(y1[j].w);
            __builtin_nontemporal_store(o0, (f32x4*)(O + (size_t)tok * 1024 + c)); __builtin_nontemporal_store(o1, (f32x4*)(O + (size_t)tok * 1024 + c + 4)); }
    }
}

#define VM_WAIT() asm volatile("s_waitcnt vmcnt(0)" ::: "memory")
#define XB_TMO      128
#define XB_XCNT(j)  (256  + 64 * (j))
#define XB_XSUB(j)  (1280 + 64 * (j))
#define XB_XGEN(j)  (2304 + 64 * (j))
#define XB_TOP      3328
#define XB_TOPGEN   3392
#define XCD_BAR_WORDS 3456
#define XB_SPIN_CAP (1u << 18)

__device__ __forceinline__ unsigned xb_ld(unsigned* p)              { return __hip_atomic_load(p, __ATOMIC_RELAXED, __HIP_MEMORY_SCOPE_AGENT); }
__device__ __forceinline__ unsigned xb_add(unsigned* p, unsigned v) { return __hip_atomic_fetch_add(p, v, __ATOMIC_RELAXED, __HIP_MEMORY_SCOPE_AGENT); }
__device__ __forceinline__ unsigned xb_xcc_id() { return (unsigned)__builtin_amdgcn_s_getreg((3 << 11) | 20) & 0xFu; }
#define XB_SPIN(cond, bar) do { unsigned _sp = 0; while (cond) { __builtin_amdgcn_s_sleep(1); \
    if ((++_sp & 255u) == 0u) { if (xb_ld(&(bar)[XB_TMO])) break; if (_sp > XB_SPIN_CAP) { atomicAdd(&(bar)[XB_TMO], 1u); break; } } } } while (0)

struct XcdBarrier {
    unsigned* bar; unsigned x;
    volatile LAS unsigned* st;
};

__device__ __forceinline__ XcdBarrier xcd_barrier_post(unsigned* bar, volatile LAS unsigned* st) {
    XcdBarrier b; b.bar = bar; b.x = xb_xcc_id(); b.st = st;
    if (threadIdx.x == 0) (void)xb_add(&bar[XB_XCNT(b.x)], 1u);
    return b;
}
__device__ __forceinline__ void xcd_barrier_complete(unsigned* bar, unsigned x, unsigned& nloc, unsigned& nx) {
    const unsigned G = gridDim.x * gridDim.y * gridDim.z;
    unsigned sum, cnt, mine, sp = 0u;
    for (;;) {
        sum = 0u; cnt = 0u; mine = 0u;
#pragma unroll
        for (unsigned j = 0; j < 16; ++j) { const unsigned c = xb_ld(&bar[XB_XCNT(j)]); sum += c; cnt += (c > 0u) ? 1u : 0u; mine = (j == x) ? c : mine; }
        if (sum == G) break;
        __builtin_amdgcn_s_sleep(1);
        if ((++sp & 255u) == 0u) { if (xb_ld(&bar[XB_TMO])) break; if (sp > XB_SPIN_CAP) { atomicAdd(&bar[XB_TMO], 1u); break; } }
    }
    nloc = mine > 0u ? mine : 1u; nx = cnt > 0u ? cnt : 1u;
}

__device__ __forceinline__ void xcd_barrier(const XcdBarrier& b) {
    asm volatile("s_waitcnt vmcnt(0)" ::: "memory");
    __syncthreads();
    if (threadIdx.x == 0) {
        unsigned* bar = b.bar;
        __builtin_amdgcn_s_waitcnt(0);
        unsigned nloc = b.st[0], nx = b.st[1];
        if (nloc == 0u) { xcd_barrier_complete(bar, b.x, nloc, nx); b.st[0] = nloc; b.st[1] = nx; }
        const unsigned old = xb_add(&bar[XB_XSUB(b.x)], 1u);
        const unsigned gen = old / nloc;
        if (old + 1u == (gen + 1u) * nloc) {
            __builtin_amdgcn_fence(__ATOMIC_RELEASE, "agent");
            asm volatile("s_waitcnt vmcnt(0)" ::: "memory");
            const unsigned og = xb_add(&bar[XB_TOP], 1u);
            const unsigned tg = og / nx;
            if (og + 1u == (tg + 1u) * nx) xb_add(&bar[XB_TOPGEN], 1u);
            else XB_SPIN(xb_ld(&bar[XB_TOPGEN]) == tg, bar);
            __builtin_amdgcn_fence(__ATOMIC_ACQUIRE, "agent");
            xb_add(&bar[XB_XGEN(b.x)], 1u);
            asm volatile("s_waitcnt vmcnt(0)" ::: "memory");
        } else {
            XB_SPIN(xb_ld(&bar[XB_XGEN(b.x)]) == gen, bar);
            __builtin_amdgcn_fence(__ATOMIC_ACQUIRE, "agent");
            asm volatile("s_waitcnt vmcnt(0)" ::: "memory");
        }
    }
    __syncthreads();
}

constexpr int N_PHASES = 11;
template <int K> DI void run_phase(const Args& a, LAS unsigned char* lds) {
    int tid = threadIdx.x; asm volatile("" : "+v"(tid));
    const int lane = tid & 63, wave = __builtin_amdgcn_readfirstlane(tid >> 6);
    unsigned char* ws = a.ws; unsigned char* dob = (unsigned char*)a.out; const int G = gridDim.x;
    if constexpr (K == 0) { phase0(a, lds, tid, lane, wave); }
    if constexpr (K == 1) {
        pg8::Gemm g{(const pg8::bf16_t*)(dob + DO_H), (const pg8::bf16_t*)(ws + WS_WIN), NTOK + NMROW, 9216, 1024};
        InOrder S; S.so.init(NTOK, 5120, G, (int)blockIdx.x); S.nmain = (NTOK / 256) * 20;
        EpiIn E{ws, (bf16_t*)(dob + DO_QM), (bf16_t*)(dob + DO_KM), (const float*)a.in[I_GQA], (const float*)a.in[I_GKA], (const float*)(ws + WS_ROPE)};
        pg8::gemm_phase<EpiIn, InOrder, true, true>(lds, g, S, E);
        {
            const int total = S.nmain + 64, rounds = (total + G - 1) / G, busy = total - (rounds - 1) * G;
            if ((int)blockIdx.x >= busy) moe_weight_convert(a, ((int)blockIdx.x - busy) * 8 + wave, (G - busy) * 8, lane);
            else if (busy == G) moe_weight_convert(a, (int)blockIdx.x * 8 + wave, G * 8, lane);
        }
    }
    if constexpr (K == 2) { phase2(a, lds, tid, lane, wave); }
    if constexpr (K == 3) {
        pg8::Gemm g{(const pg8::bf16_t*)(ws + WS_H8), (const pg8::bf16_t*)(ws + WS_WG8), NTOK, 3072, 512};
        pg8::StaticOrder S; S.init(NTOK, 3072, G, (int)blockIdx.x);
        EpiGate E{(unsigned char*)(ws + WS_G), 3072, (const float*)(ws + WS_SH), (const float*)(ws + WS_SG)};
        pg8::gemm_phase<EpiGate, pg8::StaticOrder, true, true, true>(lds, g, S, E);
        attn_combine(a, tid);
    }
    if constexpr (K == 4) {
        pg8::Gemm g{(const pg8::bf16_t*)(ws + WS_AM), (const pg8::bf16_t*)(ws + WS_WMRG), NTOK, 1024, 1536};
        pg8::StaticOrder S; S.init(NTOK, 1024, G, (int)blockIdx.x);
        EpiMerge E{(const unsigned char*)(ws + WS_G), (bf16_t*)(ws + WS_MRG), 4, 16};
        pg8::gemm_phase<EpiMerge, pg8::StaticOrder, true, true>(lds, g, S, E);
    }
    if constexpr (K == 5) {
        pg8::Gemm g{(const pg8::bf16_t*)(ws + WS_MRG), (const pg8::bf16_t*)(ws + WS_WOUT), NTOK, 1024, 1024};
        pg8::StaticOrder S; S.init(NTOK, 1024, G, (int)blockIdx.x);
        EpiOut E{(const float*)a.in[I_X], a.out, (bf16_t*)(ws + WS_XB)};
        pg8::gemm_phase<EpiOut, pg8::StaticOrder, true, true>(lds, g, S, E);
    }
    if constexpr (K == 6) { phase6(a, lds, tid, lane, wave); }
    if constexpr (K == 7) { phase7(a, lds, tid, lane, wave); }
    if constexpr (K == 8) {
        const int nt = load_tile_table(a, lds, tid);
        LAS int* rowtab = (LAS int*)(lds + MISC_OFF + 1536);
        MoeOrder<true> S{(const LAS int*)(lds + MISC_OFF), nt, G, (int)blockIdx.x, rowtab};
        { const int* rowtok = (const int*)(ws + WS_SROW + 640 * 1024); Unit uu;
          for (int ui = 0; ui < 6; ++ui) { if (!S.next(ui, uu)) break; if (tid < 256) rowtab[ui * 256 + tid] = rowtok[uu.pm * 256 + tid]; } }
        __syncthreads();
        pg8::Gemm g{(const pg8::bf16_t*)(ws + WS_XB8), (const pg8::bf16_t*)(ws + WS_WGU), nt * 256, 1024, 512};
        EpiUp E{(const float*)(ws + WS_SROW + 960 * 1024), (const float*)(ws + WS_SB), (bf16_t*)(ws + WS_ACT)};
        pg8::gemm_phase<EpiUp, MoeOrder<true>, true, true, true>(lds, g, S, E);
    }
    if constexpr (K == 9) {
        const int nt = load_tile_table(a, lds, tid);
        pg8::Gemm g{(const pg8::bf16_t*)(ws + WS_ACT), (const pg8::bf16_t*)(ws + WS_WD), nt * 256, 1024, 512};
        MoeOrder<false> S{(const LAS int*)(lds + MISC_OFF), nt, G, (int)blockIdx.x, nullptr};
        EpiDown E{(const u32x2*)(ws + WS_SROW), (bf16_t*)(ws + WS_Y)};
        pg8::gemm_phase<EpiDown, MoeOrder<false>, true, true>(lds, g, S, E);
    }
    if constexpr (K == 10) { phase10(a, lane, wave); }
}

#ifndef PH_MASK
#define PH_MASK 0x7ff
#endif
#ifndef USE_CG_SEAM0
#define USE_CG_SEAM0 0
#endif
#ifndef REP_MASK
#define REP_MASK 0x000
#endif
__global__ void __launch_bounds__(512, 2) mk_fwd(Args a) {
    extern __shared__ __attribute__((aligned(16))) unsigned char lds_raw[];
    LAS unsigned char* lds = (LAS unsigned char*)lds_raw;
    const int tid = threadIdx.x;
    const int lo = a.ph_lo, hi = a.ph_hi;
    cg::grid_group grid = cg::this_grid();
    volatile LAS unsigned* bst = (volatile LAS unsigned*)(lds + MISC_OFF + 8192);
    if (tid < 2) bst[tid] = 0u;
    __syncthreads();
    XcdBarrier bar = xcd_barrier_post((unsigned*)(a.ws + WS_CTL) + 1024, bst);
#define IN(k) ((((PH_MASK) >> (k)) & 1) && lo <= (k) && (k) < hi)
#define RUN(k) do { if (IN(k)) { run_phase<k>(a, lds); if constexpr (((REP_MASK) >> (k)) & 1) { __syncthreads(); run_phase<k>(a, lds); } } \
                    if (IN(k) && IN((k) + 1)) { if (USE_CG_SEAM0 && (k) == 0) grid.sync(); else xcd_barrier(bar); } } while (0)
    RUN(0); RUN(1); RUN(2); RUN(3); RUN(4); RUN(5); RUN(6);
    RUN(7); RUN(8); RUN(9); RUN(10);
#undef IN
#undef RUN
}

#ifndef MK_MULTI
#define MK_MULTI 0
#endif
extern "C" void kernel_launch(void* const* d_in, const int* in_sizes, int n_in, void* d_out, int out_size, void* d_ws, size_t ws_size, hipStream_t stream) {
    static int grid = 0;
    if (grid == 0) {
        if (n_in != 24 || out_size != NTOK * DM || ws_size < WS_NEED) { fprintf(stderr, "kernel_launch: unexpected shapes (n_in %d, out %d, ws %zu)\n", n_in, out_size, ws_size); grid = -1; return; }
        int dev = 0, cus = 0, per_cu = 0;
        (void)hipGetDevice(&dev); (void)hipDeviceGetAttribute(&cus, hipDeviceAttributeMultiprocessorCount, dev);
        (void)hipFuncSetAttribute((const void*)mk_fwd, hipFuncAttributeMaxDynamicSharedMemorySize, LDS_BYTES);
        (void)hipOccupancyMaxActiveBlocksPerMultiprocessor(&per_cu, (const void*)mk_fwd, 512, LDS_BYTES);
        (void)hipGetLastError();
        if (per_cu < 1) { fprintf(stderr, "kernel_launch: occupancy query says %d blocks per CU: this kernel cannot be made resident, nothing launched\n", per_cu); grid = -1; return; }
        grid = cus;
    }
    if (grid < 0) return;
    Args a{};
    for (int i = 0; i < 24; ++i) a.in[i] = d_in[i];
    a.out = (float*)d_out; a.ws = (unsigned char*)d_ws;
#if MK_MULTI
    for (int p = 0; p < N_PHASES; ++p) { a.ph_lo = p; a.ph_hi = p + 1; hipLaunchKernelGGL(mk_fwd, dim3(grid), dim3(512), LDS_BYTES, stream, a); }
#else
    a.ph_lo = 0; a.ph_hi = N_PHASES;
    if (hipMemsetAsync((char*)d_ws + WS_CTL, 0, CTL_BYTES, stream) != hipSuccess) { fprintf(stderr, "kernel_launch: memset failed\n"); return; }
    void* args[] = {&a};
    hipError_t e = hipLaunchCooperativeKernel((const void*)mk_fwd, dim3(grid), dim3(512), args, LDS_BYTES, stream);
    if (e != hipSuccess) fprintf(stderr, "cooperative launch failed: %s (grid %d)\n", hipGetErrorString(e), grid);
#endif
}
```

```cpp
#include <hip/hip_runtime.h>
#include <hip/hip_cooperative_groups.h>
#include <cstdio>
#include <cstdint>
namespace cg = cooperative_groups;
namespace pg8 {
#define PG8_LAS __attribute__((address_space(3)))
typedef unsigned short bf16_t;
typedef short bf16x8 __attribute__((ext_vector_type(8)));
typedef float f32x4 __attribute__((ext_vector_type(4)));
typedef unsigned u32x4 __attribute__((ext_vector_type(4)));
constexpr int BM = 256, BK = 64, HALF = 128, HTB = HALF * BK * 2  , STAGE_BYTES = 8 * HTB, NXCD = 8, WGM = 8;

__host__ __device__ __forceinline__ int lds_byte(int r, int c) { const int st = (r >> 4) * 2 + (c >> 5), rr = r & 15, cc = c & 31, ob = rr * 64 + cc * 2; return st * 1024 + (ob ^ (((ob >> 9) & 1) << 5)); }
__host__ __device__ __forceinline__ void stage_rc(int b, int& R, int& C) { const int st = b / 1024, sb = b % 1024, swz = sb ^ (((sb >> 9) & 1) << 5); R = (st >> 1) * 16 + swz / 64; C = (st & 1) * 32 + (swz % 64) / 2; }
__host__ __device__ __forceinline__ int perm32(int rho) { const int n = rho >> 4, i = rho & 15; return 8 * (i >> 2) + 4 * n + (i & 3); }

struct Unit { int pm, pn, aux; };
struct Gemm { const bf16_t* A; const bf16_t* Bt; int M, N, K; };

struct StaticOrder {
    static constexpr bool GATHER = false; __device__ __forceinline__ int row(int, int) const { return 0; }
    int nM, nN, nwg, G, c;
    __host__ __device__ void init(int M, int N, int G_, int c_) { nM = M / BM; nN = N / BM; nwg = nM * nN; G = G_; c = c_; }
    __host__ __device__ bool next(int i, Unit& u) const {
        const long L = (long)i * G + c; if (L >= nwg) return false;
        int wgid = (int)L; { const int q = nwg / NXCD, r = nwg % NXCD, xcd = wgid % NXCD, off = wgid / NXCD; wgid = (xcd < r ? xcd * (q + 1) : r * (q + 1) + (xcd - r) * q) + off; }
        const int nig = WGM * nN, gid = wgid / nig, fm = gid * WGM, gsz = (nM - fm) < WGM ? (nM - fm) : WGM;
        u.pm = fm + ((wgid % nig) % gsz); u.pn = (wgid % nig) / gsz; u.aux = u.pn; return true;
    }
    __device__ __forceinline__ void a_ready(const Unit&) const {}
    __device__ __forceinline__ void done(const Unit&) const {}
};

__device__ __forceinline__ unsigned cvt_pk_bf16(float lo, float hi) { unsigned r; asm volatile("v_cvt_pk_bf16_f32 %0, %1, %2" : "=v"(r) : "v"(lo), "v"(hi)); return r; }
template <class Epi, class Sched, bool ALIGN_EPI = false, bool SP2 = false, bool I8 = false>
__device__ __forceinline__ void gemm_phase(PG8_LAS unsigned char* lds, const Gemm g, const Sched& S, const Epi& E) {
    const int tid = threadIdx.x, wid = __builtin_amdgcn_readfirstlane(tid >> 6), lane = tid & 63, wr = wid >> 2, wc = wid & 3, fr = lane & 15, fq = lane >> 4;
    const int K = g.K, nt = K / BK;
    unsigned voffA[2], voffB[2];
    constexpr bool GATHER = Sched::GATHER;
    static_assert(!GATHER || SP2, "gather is implemented for the SP2 loop");
    unsigned gA[2][2], gN[2][2];
#pragma unroll
    for (int i = 0; i < 2; ++i) { int R, C; stage_rc(tid * 16 + i * 8192, R, C); const int Rb = Epi::PERM ? ((R & ~31) + perm32(R & 31)) : R;
        voffA[i] = (unsigned)(R * K + C) * 2u; voffB[i] = (unsigned)(Rb * K + C) * 2u; }
#define PG8_ROWS(dst, ui_) do { _Pragma("unroll") for (int h_ = 0; h_ < 2; ++h_) _Pragma("unroll") for (int i_ = 0; i_ < 2; ++i_) { int R_, C_; stage_rc(tid * 16 + i_ * 8192, R_, C_); \
        dst[h_][i_] = (unsigned)S.row(ui_, h_ * HALF + R_) * (unsigned)(K * 2) + (unsigned)(C_ * 2); } } while (0)
    const size_t kstep = (size_t)(BK * 2);
    const size_t hstep = (size_t)HALF * K * 2;
    const size_t hstepA = GATHER ? (size_t)0 : hstep;
    const size_t tstep = 2 * hstep;
    const unsigned ldsw = (unsigned)wid * 1024u;
    const int aoff = lds_byte(wr * 64 + fr, fq * 8), boff = lds_byte(wc * 32 + fr, fq * 8);
#define PG8_SA(b, h) (((b) * 2 + (h)) * HTB)
#define PG8_SB(b, h) ((4 + (b) * 2 + (h)) * HTB)
#define PG8_STAGE(bufoff, gbase, voff) do { _Pragma("unroll") for (int _i = 0; _i < 2; ++_i) \
        __builtin_amdgcn_global_load_lds((const unsigned*)((const char*)(gbase) + (voff)[_i]), (PG8_LAS unsigned*)(lds + (bufoff) + ldsw + _i * 8192), 16, 0, 0); } while (0)
#define PG8_LDA(dst, b, h) do { _Pragma("unroll") for (int m = 0; m < 4; ++m) _Pragma("unroll") for (int k = 0; k < 2; ++k) dst[m][k] = *(const PG8_LAS bf16x8*)(lds + PG8_SA(b, h) + aoff + m * 2048 + k * 1024); } while (0)
#define PG8_LDB(dst, b, h) do { _Pragma("unroll") for (int n = 0; n < 2; ++n) _Pragma("unroll") for (int k = 0; k < 2; ++k) dst[n][k] = *(const PG8_LAS bf16x8*)(lds + PG8_SB(b, h) + boff + n * 2048 + k * 1024); } while (0)
typedef int pg8_i32x4 __attribute__((ext_vector_type(4)));
#define PG8_MMA(ai, bj, At, Bt) do { __builtin_amdgcn_s_setprio(1); _Pragma("unroll") for (int m = 0; m < 4; ++m) _Pragma("unroll") for (int n = 0; n < 2; ++n) _Pragma("unroll") for (int k = 0; k < 2; ++k) { \
        if constexpr (I8) acc[ai][bj][m][n] = __builtin_bit_cast(f32x4, __builtin_amdgcn_mfma_i32_16x16x64_i8(__builtin_bit_cast(pg8_i32x4, Bt[n][k]), __builtin_bit_cast(pg8_i32x4, At[m][k]), __builtin_bit_cast(pg8_i32x4, acc[ai][bj][m][n]), 0, 0, 0)); \
        else acc[ai][bj][m][n] = __builtin_amdgcn_mfma_f32_16x16x32_bf16(Bt[n][k], At[m][k], acc[ai][bj][m][n], 0, 0, 0); } \
        __builtin_amdgcn_s_setprio(0); } while (0)
#define PG8_WAIT_V(n) asm volatile("s_waitcnt vmcnt(" #n ")" ::: "memory")
#define PG8_WAIT_L(n) asm volatile("s_waitcnt lgkmcnt(" #n ")" ::: "memory")
#define PG8_BAR __builtin_amdgcn_s_barrier()
#define PG8_SCHED __builtin_amdgcn_sched_barrier(0)
    Unit cur, nxt; int ui = 0;
    if (!S.next(0, cur)) return;
    f32x4 acc[2][2][4][2];
#pragma unroll
    for (int a = 0; a < 2; ++a)
#pragma unroll
        for (int b = 0; b < 2; ++b)
#pragma unroll
            for (int m = 0; m < 4; ++m)
#pragma unroll
                for (int n = 0; n < 2; ++n) acc[a][b][m][n] = (f32x4){0.f, 0.f, 0.f, 0.f};
    bf16x8 At[4][2], B0[2][2], B1[2][2];
    const char* cA = (const char*)g.A + (GATHER ? (size_t)0 : (size_t)cur.pm * tstep); const char* cB = (const char*)g.Bt + (size_t)cur.pn * tstep;
    if constexpr (GATHER) { PG8_ROWS(gA, 0); PG8_ROWS(gN, 0); }
#define PG8_OA(h) (GATHER ? gA[h] : voffA)
    S.a_ready(cur);
    if constexpr (SP2) {
        PG8_STAGE(PG8_SB(0, 0), cB, voffB); PG8_STAGE(PG8_SB(0, 1), cB + hstep, voffB); PG8_STAGE(PG8_SA(0, 0), cA, PG8_OA(0)); PG8_STAGE(PG8_SA(0, 1), cA + hstepA, PG8_OA(1));
        if (wr == 1) PG8_BAR;
        PG8_WAIT_V(2); PG8_BAR;
        PG8_STAGE(PG8_SB(1, 0), cB + kstep, voffB); PG8_STAGE(PG8_SA(1, 0), cA + kstep, PG8_OA(0)); PG8_STAGE(PG8_SB(1, 1), cB + hstep + kstep, voffB);
        PG8_WAIT_V(6); PG8_BAR;
    } else {
        PG8_STAGE(PG8_SB(0, 0), cB, voffB); PG8_STAGE(PG8_SA(0, 0), cA, voffA); PG8_STAGE(PG8_SB(0, 1), cB + hstep, voffB); PG8_STAGE(PG8_SA(0, 1), cA + hstep, voffA);
        if (wr == 1) PG8_BAR;
        PG8_WAIT_V(4); PG8_BAR;
        PG8_STAGE(PG8_SB(1, 0), cB + kstep, voffB); PG8_STAGE(PG8_SA(1, 0), cA + kstep, voffA); PG8_STAGE(PG8_SB(1, 1), cB + hstep + kstep, voffB);
        PG8_WAIT_V(6); PG8_BAR;
    }
    for (;;) {
        const bool has_next = S.next(ui + 1, nxt);
        const char* nA = (has_next && !GATHER) ? (const char*)g.A + (size_t)nxt.pm * tstep : cA; const char* nB = has_next ? (const char*)g.Bt + (size_t)nxt.pn * tstep : cB;
        if constexpr (GATHER) { if (has_next) PG8_ROWS(gN, ui + 1); }
#pragma unroll 1
        for (int t = 0; t < nt; t += 2) {
            const bool last = (t == nt - 2);
            const char* a1 = cA + (size_t)(t + 1) * kstep;
            const char* a2 = last ? nA : cA + (size_t)(t + 2) * kstep; const char* b2 = last ? nB : cB + (size_t)(t + 2) * kstep;
            const char* a3 = a2 + kstep; const char* b3 = b2 + kstep;
            if (last && has_next) S.a_ready(nxt);
            if constexpr (Epi::HAS_MID) { if (t == E.mid0 || t == E.mid1) E.mid(acc, cur, t, wr, wc, fr, fq); }
            if constexpr (SP2) {
            unsigned on0[2], on1[2];
            on0[0] = GATHER ? (last ? gN[0][0] : gA[0][0]) : voffA[0]; on0[1] = GATHER ? (last ? gN[0][1] : gA[0][1]) : voffA[1];
            on1[0] = GATHER ? (last ? gN[1][0] : gA[1][0]) : voffA[0]; on1[1] = GATHER ? (last ? gN[1][1] : gA[1][1]) : voffA[1];
            PG8_LDB(B0, 0, 0); PG8_LDB(B1, 0, 1); PG8_SCHED; PG8_LDA(At, 0, 0); PG8_STAGE(PG8_SA(1, 1), a1 + hstepA, PG8_OA(1));
            PG8_WAIT_V(8); PG8_WAIT_L(0); PG8_BAR; PG8_MMA(0, 0, At, B0); PG8_MMA(0, 1, At, B1); PG8_BAR; PG8_SCHED;
            PG8_LDA(At, 0, 1); PG8_STAGE(PG8_SB(0, 0), b2, voffB); PG8_STAGE(PG8_SB(0, 1), b2 + hstep, voffB); PG8_STAGE(PG8_SA(0, 0), a2, on0);
            PG8_WAIT_V(8); PG8_WAIT_L(0); PG8_BAR; PG8_MMA(1, 0, At, B0); PG8_MMA(1, 1, At, B1); PG8_BAR; PG8_SCHED;
            PG8_LDB(B0, 1, 0); PG8_LDB(B1, 1, 1); PG8_SCHED; PG8_LDA(At, 1, 0); PG8_STAGE(PG8_SA(0, 1), a2 + hstepA, on1);
            PG8_WAIT_V(8); PG8_WAIT_L(0); PG8_BAR; PG8_MMA(0, 0, At, B0); PG8_MMA(0, 1, At, B1); PG8_BAR; PG8_SCHED;
            PG8_LDA(At, 1, 1); PG8_STAGE(PG8_SB(1, 0), b3, voffB); PG8_STAGE(PG8_SB(1, 1), b3 + hstep, voffB); PG8_STAGE(PG8_SA(1, 0), a3, on0);
            PG8_WAIT_V(8); PG8_WAIT_L(0); PG8_BAR; PG8_MMA(1, 0, At, B0); PG8_MMA(1, 1, At, B1); PG8_BAR; PG8_SCHED;
            } else {
            PG8_LDB(B0, 0, 0); PG8_SCHED; PG8_LDA(At, 0, 0); PG8_STAGE(PG8_SA(1, 1), a1 + hstep, voffA);
            PG8_WAIT_L(8); PG8_BAR; PG8_WAIT_L(0); PG8_MMA(0, 0, At, B0); PG8_BAR; PG8_SCHED;
            PG8_LDB(B1, 0, 1); PG8_STAGE(PG8_SB(0, 0), b2, voffB);
            PG8_BAR; PG8_WAIT_L(0); PG8_MMA(0, 1, At, B1); PG8_BAR;
            PG8_LDA(At, 0, 1); PG8_STAGE(PG8_SA(0, 0), a2, voffA);
            PG8_BAR; PG8_WAIT_L(0); PG8_MMA(1, 0, At, B0); PG8_BAR; PG8_SCHED;
            PG8_STAGE(PG8_SB(0, 1), b2 + hstep, voffB);
            PG8_WAIT_V(6); PG8_BAR; PG8_MMA(1, 1, At, B1); PG8_BAR;
            PG8_LDB(B0, 1, 0); PG8_SCHED; PG8_LDA(At, 1, 0); PG8_STAGE(PG8_SA(0, 1), a2 + hstep, voffA);
            PG8_WAIT_L(8); PG8_BAR; PG8_WAIT_L(0); PG8_MMA(0, 0, At, B0); PG8_BAR; PG8_SCHED;
            PG8_LDB(B1, 1, 1); PG8_STAGE(PG8_SB(1, 0), b3, voffB);
            PG8_BAR; PG8_WAIT_L(0); PG8_MMA(0, 1, At, B1); PG8_BAR;
            PG8_LDA(At, 1, 1); PG8_STAGE(PG8_SA(1, 0), a3, voffA);
            PG8_BAR; PG8_WAIT_L(0); PG8_MMA(1, 0, At, B0); PG8_BAR; PG8_SCHED;
            PG8_STAGE(PG8_SB(1, 1), b3 + hstep, voffB);
            PG8_WAIT_V(6); PG8_BAR; PG8_MMA(1, 1, At, B1); PG8_BAR;
            }
        }
        if constexpr (ALIGN_EPI) { if (wr == 0) PG8_BAR; }
        if constexpr (!Epi::AFTER_DRAIN) { E(acc, cur, wr, wc, fr, fq); S.done(cur); }
        if (!has_next) break;
#pragma unroll
        for (int a = 0; a < 2; ++a)
#pragma unroll
            for (int b = 0; b < 2; ++b)
#pragma unroll
                for (int m = 0; m < 4; ++m)
#pragma unroll
                    for (int n = 0; n < 2; ++n) acc[a][b][m][n] = (f32x4){0.f, 0.f, 0.f, 0.f};
        cur = nxt; cA = nA; cB = nB; ++ui;
        if constexpr (GATHER) { _Pragma("unroll") for (int h_ = 0; h_ < 2; ++h_) _Pragma("unroll") for (int i_ = 0; i_ < 2; ++i_) gA[h_][i_] = gN[h_][i_]; }
        if constexpr (ALIGN_EPI) { if (wr == 1) PG8_BAR; }
    }
    PG8_WAIT_V(0);
    if constexpr (!ALIGN_EPI) { if (wr == 0) PG8_BAR; }
    PG8_BAR;
    if constexpr (Epi::AFTER_DRAIN) { E.fused(acc, cur, wr, wc, fr, fq, lds, wid, lane); S.done(cur); }
#undef PG8_SA
#undef PG8_OA
#undef PG8_ROWS
#undef PG8_SB
#undef PG8_STAGE
#undef PG8_LDA
#undef PG8_LDB
#undef PG8_MMA
#undef PG8_WAIT_V
#undef PG8_WAIT_L
#undef PG8_BAR
#undef PG8_SCHED
}
}

#define DI __device__ __forceinline__
#define LAS __attribute__((address_space(3)))
typedef unsigned short bf16_t;
typedef float f32x4 __attribute__((ext_vector_type(4)));
typedef float f32x2 __attribute__((ext_vector_type(2)));
typedef float f32x16 __attribute__((ext_vector_type(16)));
typedef unsigned u32x4 __attribute__((ext_vector_type(4)));
typedef unsigned u32x2 __attribute__((ext_vector_type(2)));
typedef short bf16x8 __attribute__((ext_vector_type(8)));
typedef short s16x4 __attribute__((ext_vector_type(4)));
typedef __bf16 bf16x2_t __attribute__((ext_vector_type(2)));
using pg8::Unit;

constexpr int NB = 16, SEQ = 2048, DM = 1024, NTOK = NB * SEQ, NMEM = 256, NMROW = NB * NMEM;
constexpr float EPS = 1e-6f, LOG2E = 1.4426950408889634f;
constexpr float QSCALE_A = 0.125f * LOG2E, QSCALE_M = 0.08838834764831845f * LOG2E;
constexpr int MAXROWS = 73728, MAXTILES = MAXROWS / 256;

constexpr size_t MiB = 1u << 20;
constexpr size_t WS_CTL = 0, CTL_BYTES = 64 * 1024;
constexpr size_t WS_WIN = 1 * MiB, WS_WMKV = 17 * MiB, WS_WMRG = 19 * MiB, WS_WOUT = 22 * MiB;
constexpr size_t WS_ROPE = 24 * MiB, WS_WRH = 26 * MiB, WS_WRL = WS_WRH + 128 * 1024;
constexpr size_t WS_RT = 27 * MiB;
constexpr size_t RT_TOKE = 0, RT_RANK = 256 * 1024, RT_W = 512 * 1024, RT_RSTD = 768 * 1024, RT_CCNT = 896 * 1024, RT_META = 960 * 1024;
constexpr size_t WS_WGU = 28 * MiB, WS_WD = 92 * MiB;
constexpr size_t WS_Q = 124 * MiB, WS_K = 172 * MiB, WS_V = 220 * MiB, WS_U = 268 * MiB, WS_CB = 316 * MiB;
constexpr size_t WS_AM = 364 * MiB, WS_PO = 460 * MiB, WS_LSE = 508 * MiB, WS_SROW = 510 * MiB;
constexpr size_t WS_G = 124 * MiB;
constexpr size_t WS_MRG = 220 * MiB, WS_XB = 284 * MiB;
constexpr size_t SR_RSTD = 0, SR_DEST = 320 * 1024, SR_W = 640 * 1024;
constexpr size_t WS_XB8 = 124 * MiB, WS_ACT = 348 * MiB, WS_Y = 124 * MiB;
constexpr size_t WS_SH = WS_WRH + 256 * 1024, WS_SW = WS_WRH + 640 * 1024;
constexpr size_t WS_SB = WS_WRH + 512 * 1024;
constexpr size_t WS_NEED = 512 * MiB;
constexpr size_t DO_A8 = 0, DO_QM = 72 * MiB, DO_KM = 104 * MiB, DO_VM = 108 * MiB;
constexpr int RING_BYTES = 131072, MISC_OFF = 131072, LDS_BYTES = 147456;

DI unsigned pk2(float lo, float hi) { f32x2 v = {lo, hi}; bf16x2_t b = __builtin_convertvector(v, bf16x2_t); return __builtin_bit_cast(unsigned, b); }
DI float bf_lo(unsigned u) { return __uint_as_float(u << 16); }
DI float bf_hi(unsigned u) { return __uint_as_float(u & 0xffff0000u); }
DI float bf2f(short s) { return __uint_as_float(((unsigned)(unsigned short)s) << 16); }
DI float fexp2(float x) { return __builtin_amdgcn_exp2f(x); }
DI float fexp(float x) { return __builtin_amdgcn_exp2f(x * LOG2E); }
DI float frcp(float x) { return __builtin_amdgcn_rcpf(x); }
DI u32x4 pack8(const f32x4& a, const f32x4& b) { u32x4 w; w.x = pk2(a.x, a.y); w.y = pk2(a.z, a.w); w.z = pk2(b.x, b.y); w.w = pk2(b.z, b.w); return w; }
DI void st16(void* p, const u32x4& v) { __builtin_nontemporal_store(v, (u32x4*)p); }
DI void st16f(void* p, const f32x4& v) { __builtin_nontemporal_store(v, (f32x4*)p); }
DI void st8(void* p, const u32x2& v) { __builtin_nontemporal_store(v, (u32x2*)p); }
DI void st16d(void* p, const u32x4& v) { *(u32x4*)p = v; }
DI void st8d(void* p, const u32x2& v) { *(u32x2*)p = v; }
DI float h2f_lo(unsigned w) { return (float)__builtin_bit_cast(_Float16, (unsigned short)(w & 0xffffu)); }
DI float h2f_hi(unsigned w) { return (float)__builtin_bit_cast(_Float16, (unsigned short)(w >> 16)); }
DI int crow(int reg, int h) { return (reg & 3) + 8 * (reg >> 2) + 4 * h; }
DI float wave_sum(float v) {
#pragma unroll
    for (int o = 1; o < 64; o <<= 1) v += __shfl_xor(v, o);
    return v;
}
#define MFMA32(a, b, c) __builtin_amdgcn_mfma_f32_32x32x16_bf16((a), (b), (c), 0, 0, 0)
#define MFMA16(a, b, c) __builtin_amdgcn_mfma_f32_16x16x32_bf16((a), (b), (c), 0, 0, 0)

struct EpiIn {
    static constexpr bool PERM = true, AFTER_DRAIN = false, HAS_MID = false;
    unsigned char* wsb; bf16_t* QM; bf16_t* KMVM; const float *gq, *gk; const _Float16* cs; const float *sh, *sw;
    DI void operator()(const pg8::f32x4 (&acc)[2][2][4][2], const Unit& u, int wr, int wc, int fr, int fq) const {
        const int t = u.pn, row0 = u.pm * 256 + wr * 64 + fr;
        f32x4 sc[2][2];
        { const float* sp = sw + u.pn * 256 + wc * 32 + 8 * fq;
#pragma unroll
          for (int bj = 0; bj < 2; ++bj)
#pragma unroll
              for (int n = 0; n < 2; ++n) sc[bj][n] = *(const f32x4*)(sp + 128 * bj + 4 * n); }
#define EIN_DQ(v, ai, m, rs) do { _Pragma("unroll") for (int bj_ = 0; bj_ < 2; ++bj_) _Pragma("unroll") for (int n_ = 0; n_ < 2; ++n_) _Pragma("unroll") for (int c_ = 0; c_ < 4; ++c_) \
            v[bj_][n_][c_] = (float)__float_as_int(acc[ai][bj_][m][n_][c_]) * ((rs) * sc[bj_][n_][c_]); } while (0)
        if (t >= 32) {
            bf16_t* dst = KMVM + (t >= 34 ? (size_t)NMROW * 512 : 0);
            const int col = (t & 1) * 256 + wc * 32 + 8 * fq;
#pragma unroll
            for (int ai = 0; ai < 2; ++ai)
#pragma unroll
                for (int m = 0; m < 4; ++m) {
                    const int row = row0 + ai * 128 + m * 16; f32x4 v[2][2]; EIN_DQ(v, ai, m, sh[row]);
                    bf16_t* rp = dst + (size_t)(row - NTOK) * 512 + col;
#pragma unroll
                    for (int bj = 0; bj < 2; ++bj) st16(rp + 128 * bj, pack8(v[bj][0], v[bj][1]));
                }
        } else if (t < 6) {
            const bool isq = t < 3; bf16_t* dst = (bf16_t*)(wsb + (isq ? WS_Q : WS_K)); const float* g = isq ? gq : gk; const float osc = isq ? QSCALE_A : 1.f;
            const int head = 4 * (isq ? t : t - 3) + wc;
            f32x4 gv[2][2];
#pragma unroll
            for (int bj = 0; bj < 2; ++bj)
#pragma unroll
                for (int n = 0; n < 2; ++n) gv[bj][n] = *(const f32x4*)(g + 32 * bj + 8 * fq + 4 * n) * osc;
#pragma unroll
            for (int ai = 0; ai < 2; ++ai) {
#pragma unroll
              for (int mp = 0; mp < 2; ++mp) {
                u32x4 csv[2][2];
#pragma unroll
                for (int m2 = 0; m2 < 2; ++m2) { const u32x4* cr = (const u32x4*)(cs + (size_t)(row0 + ai * 128 + (2 * mp + m2) * 16) * 16);
                    csv[m2][0] = cr[0]; csv[m2][1] = cr[1]; }
#pragma unroll
                for (int m = 2 * mp; m < 2 * mp + 2; ++m) {
                    const int row = row0 + ai * 128 + m * 16;
                    f32x4 v[2][2]; EIN_DQ(v, ai, m, sh[row]);
                    float ss = 0.f;
#pragma unroll
                    for (int bj = 0; bj < 2; ++bj)
#pragma unroll
                        for (int n = 0; n < 2; ++n) { const f32x4 x = v[bj][n]; ss += (x.x * x.x + x.y * x.y) + (x.z * x.z + x.w * x.w); }
                    ss += __shfl_xor(ss, 16); ss += __shfl_xor(ss, 32);
                    const float rstd = __builtin_amdgcn_rsqf(ss * (1.f / 64.f) + EPS);
#pragma unroll
                    for (int bj = 0; bj < 2; ++bj)
#pragma unroll
                        for (int n = 0; n < 2; ++n) v[bj][n] = v[bj][n] * rstd * gv[bj][n];
                    f32x4 p0, p1;
#pragma unroll
                    for (int c = 0; c < 4; ++c) { p0[c] = __shfl_xor(v[0][0][c], 16); p1[c] = __shfl_xor(v[0][1][c], 16); }
                    if (fq < 2) {
                        const u32x4 cw = csv[m - 2 * mp][0], sw4 = csv[m - 2 * mp][1];
                        const f32x4 c0 = {h2f_lo(cw.x), h2f_hi(cw.x), h2f_lo(cw.y), h2f_hi(cw.y)}, c1 = {h2f_lo(cw.z), h2f_hi(cw.z), h2f_lo(cw.w), h2f_hi(cw.w)};
                        const f32x4 s0 = {h2f_lo(sw4.x), h2f_hi(sw4.x), h2f_lo(sw4.y), h2f_hi(sw4.y)}, s1 = {h2f_lo(sw4.z), h2f_hi(sw4.z), h2f_lo(sw4.w), h2f_hi(sw4.w)};
                        if (fq == 0) { v[0][0] = v[0][0] * c0 - p0 * s0; v[0][1] = v[0][1] * c1 - p1 * s1; }
                        else         { v[0][0] = v[0][0] * c0 + p0 * s0; v[0][1] = v[0][1] * c1 + p1 * s1; }
                    }
                    bf16_t* rp = dst + (size_t)row * 768 + head * 64 + 8 * fq;
#pragma unroll
                    for (int bj = 0; bj < 2; ++bj) st16(rp + 32 * bj, pack8(v[bj][0], v[bj][1]));
                }
                asm volatile("" ::: "memory");
              }
            }
        } else if (t >= 9 && t < 15) {
            bf16_t* U = (bf16_t*)(wsb + WS_U);
            const int c0 = (t - 9) * 128 + wc * 32 + 8 * fq;
#pragma unroll
            for (int ai = 0; ai < 2; ++ai)
#pragma unroll
                for (int m = 0; m < 4; ++m) {
                    const int row = row0 + ai * 128 + m * 16; f32x4 v[2][2]; EIN_DQ(v, ai, m, sh[row]);
                    st16(U + (size_t)row * 768 + c0, pack8(v[0][0] * v[1][0], v[0][1] * v[1][1]));
                }
        } else {
            bf16_t* dst; int ld, col;
            if (t >= 18) { dst = QM; ld = 512; col = (t - 18) * 256; }
            else { dst = (bf16_t*)(wsb + (t < 9 ? WS_V : WS_CB)); ld = 768; col = (t < 9 ? t - 6 : t - 15) * 256; }
            col += wc * 32 + 8 * fq;
#pragma unroll
            for (int ai = 0; ai < 2; ++ai)
#pragma unroll
                for (int m = 0; m < 4; ++m) {
                    const int row = row0 + ai * 128 + m * 16; f32x4 v[2][2]; EIN_DQ(v, ai, m, sh[row]);
                    bf16_t* rp = dst + (size_t)row * ld + col;
#pragma unroll
                    for (int bj = 0; bj < 2; ++bj) st16(rp + 128 * bj, pack8(v[bj][0], v[bj][1]));
                }
        }
#undef EIN_DQ
    }
};

DI float sigm(float x) { return frcp(1.f + fexp(-fminf(fmaxf(x, -60.f), 60.f))); }
DI f32x4 sigm4(const f32x4& v) { f32x4 r; r.x = sigm(v.x); r.y = sigm(v.y); r.z = sigm(v.z); r.w = sigm(v.w); return r; }
DI unsigned gq1(float x) { return (unsigned)fminf(fmaxf(__builtin_rintf(sigm(x) * 255.f), 1.f), 255.f); }
DI unsigned gq4(const f32x4& v) { return gq1(v.x) | (gq1(v.y) << 8) | (gq1(v.z) << 16) | (gq1(v.w) << 24); }
DI float ub(unsigned w, int k) { return (float)((w >> (8 * k)) & 0xffu); }
struct EpiGate {
    static constexpr bool PERM = true, AFTER_DRAIN = false, HAS_MID = false;
    unsigned char* O; int ld; const float* sh; const float* sg;
    DI void operator()(const pg8::f32x4 (&acc)[2][2][4][2], const Unit& u, int wr, int wc, int fr, int fq) const {
        const int row0 = u.pm * 256 + wr * 64 + fr, col = u.pn * 256 + wc * 64 + 16 * fq;
        const float* sp = sg + u.pn * 256 + wc * 32 + 8 * fq;
        f32x4 sc[2][2];
#pragma unroll
        for (int bj = 0; bj < 2; ++bj)
#pragma unroll
            for (int n = 0; n < 2; ++n) sc[bj][n] = *(const f32x4*)(sp + 128 * bj + 4 * n);
#pragma unroll
        for (int ai = 0; ai < 2; ++ai)
#pragma unroll
            for (int m = 0; m < 4; ++m) {
                const int row = row0 + ai * 128 + m * 16; const float rs = sh[row];
                f32x4 lg[2][2];
#pragma unroll
                for (int bj = 0; bj < 2; ++bj)
#pragma unroll
                    for (int n = 0; n < 2; ++n)
#pragma unroll
                        for (int c = 0; c < 4; ++c) lg[bj][n][c] = (float)__float_as_int(acc[ai][bj][m][n][c]) * rs * sc[bj][n][c];
                u32x4 w; w.x = gq4(lg[0][0]); w.y = gq4(lg[0][1]); w.z = gq4(lg[1][0]); w.w = gq4(lg[1][1]);
                st16d(O + (size_t)row * ld + col, w);
            }
    }
};
struct EpiMerge {
    static constexpr bool PERM = true, AFTER_DRAIN = false, HAS_MID = true;
    const unsigned char* G; bf16_t* O; int mid0, mid1;
    DI void mid(pg8::f32x4 (&acc)[2][2][4][2], const Unit& u, int t, int wr, int wc, int fr, int fq) const {
        const int ga = (t == mid0) ? 0 : 1;
        int row0 = u.pm * 256 + wr * 64 + fr; const int col = u.pn * 256 + wc * 64 + 16 * fq;
        asm volatile("" : "+v"(row0));
        u32x4 la[2][4], lb[2][4];
#pragma unroll
        for (int ai = 0; ai < 2; ++ai)
#pragma unroll
            for (int m = 0; m < 4; ++m) { const unsigned char* gp = G + (size_t)(row0 + ai * 128 + m * 16) * 3072 + ga * 1024 + col; la[ai][m] = *(const u32x4*)gp; lb[ai][m] = *(const u32x4*)(gp + 1024); }
#pragma unroll
        for (int ai = 0; ai < 2; ++ai)
#pragma unroll
            for (int m = 0; m < 4; ++m)
#pragma unroll
                for (int bj = 0; bj < 2; ++bj)
#pragma unroll
                    for (int n = 0; n < 2; ++n)
#pragma unroll
                        for (int c = 0; c < 4; ++c) acc[ai][bj][m][n][c] *= ub(la[ai][m][2 * bj + n], c) * frcp(ub(lb[ai][m][2 * bj + n], c));
        asm volatile("" ::: "memory");
    }
    DI void operator()(const pg8::f32x4 (&acc)[2][2][4][2], const Unit& u, int wr, int wc, int fr, int fq) const {
        const int row0 = u.pm * 256 + wr * 64 + fr, col = u.pn * 256 + wc * 64 + 16 * fq;
        u32x4 lq[2][4];
#pragma unroll
        for (int ai = 0; ai < 2; ++ai)
#pragma unroll
            for (int m = 0; m < 4; ++m) lq[ai][m] = *(const u32x4*)(G + (size_t)(row0 + ai * 128 + m * 16) * 3072 + 2048 + col);
#pragma unroll
        for (int ai = 0; ai < 2; ++ai)
#pragma unroll
            for (int m = 0; m < 4; ++m) {
                const size_t row = (size_t)(row0 + ai * 128 + m * 16);
#pragma unroll
                for (int bj = 0; bj < 2; ++bj) {
                    const float k = 1.f / 255.f; const unsigned q0 = lq[ai][m][2 * bj], q1 = lq[ai][m][2 * bj + 1];
                    const f32x4 g0 = {ub(q0, 0) * k, ub(q0, 1) * k, ub(q0, 2) * k, ub(q0, 3) * k}, g1 = {ub(q1, 0) * k, ub(q1, 1) * k, ub(q1, 2) * k, ub(q1, 3) * k};
                    st16d(O + row * 1024 + col + 8 * bj, pack8(acc[ai][bj][m][0] * g0, acc[ai][bj][m][1] * g1));
                }
            }
    }
};

struct EpiOut {
    static constexpr bool PERM = true, AFTER_DRAIN = false, HAS_MID = false;
    const float* X; float* O; bf16_t* XB;
    DI void operator()(const pg8::f32x4 (&acc)[2][2][4][2], const Unit& u, int wr, int wc, int fr, int fq) const {
        const int row0 = u.pm * 256 + wr * 64 + fr, col = u.pn * 256 + wc * 32 + 8 * fq;
#pragma unroll
        for (int ai = 0; ai < 2; ++ai)
#pragma unroll
            for (int m = 0; m < 4; ++m) {
                const size_t off = (size_t)(row0 + ai * 128 + m * 16) * 1024 + col;
#pragma unroll
                for (int bj = 0; bj < 2; ++bj) {
                    const f32x4 o0 = *(const f32x4*)(X + off + 128 * bj) + acc[ai][bj][m][0], o1 = *(const f32x4*)(X + off + 128 * bj + 4) + acc[ai][bj][m][1];
                    st16d(XB + off + 128 * bj, pack8(o0, o1));
                }
            }
    }
};

struct EpiUp {
    static constexpr bool PERM = true, AFTER_DRAIN = false, HAS_MID = false;
    const float* sa; const float* sb; bf16_t* ACT;
    DI void operator()(const pg8::f32x4 (&acc)[2][2][4][2], const Unit& u, int wr, int wc, int fr, int fq) const {
        const int row0 = u.pm * 256 + wr * 64 + fr, col = u.aux * 128 + wc * 32 + 8 * fq;
        const float* sbp = sb + (size_t)(u.pn >> 2) * 1024 + u.aux * 256 + wc * 32 + 8 * fq;
        const f32x4 sg0 = *(const f32x4*)(sbp), sg1 = *(const f32x4*)(sbp + 4), su0 = *(const f32x4*)(sbp + 128), su1 = *(const f32x4*)(sbp + 132);
#pragma unroll
        for (int ai = 0; ai < 2; ++ai)
#pragma unroll
            for (int m = 0; m < 4; ++m) {
                const int row = row0 + ai * 128 + m * 16; const float rs = sa[row];
                f32x4 o[2];
#pragma unroll
                for (int n = 0; n < 2; ++n)
#pragma unroll
                    for (int c = 0; c < 4; ++c) {
                        const float a = (float)__float_as_int(acc[ai][0][m][n][c]) * rs * (n ? sg1[c] : sg0[c]), b = (float)__float_as_int(acc[ai][1][m][n][c]) * rs * (n ? su1[c] : su0[c]);
                        o[n][c] = a * b * frcp(1.f + fexp(-a)); }
                st16d(ACT + (size_t)row * 512 + col, pack8(o[0], o[1]));
            }
    }
};

struct EpiDown {
    static constexpr bool PERM = true, AFTER_DRAIN = false, HAS_MID = false;
    const u32x2* dw; bf16_t* Y;
    DI void operator()(const pg8::f32x4 (&acc)[2][2][4][2], const Unit& u, int wr, int wc, int fr, int fq) const {
        const int row0 = u.pm * 256 + wr * 64 + fr, col = u.aux * 256 + wc * 32 + 8 * fq;
#pragma unroll
        for (int ai = 0; ai < 2; ++ai)
#pragma unroll
            for (int m = 0; m < 4; ++m) {
                const int row = row0 + ai * 128 + m * 16; const u32x2 rec = dw[row]; const int d = (int)rec.x;
                if (d >= 0) { const float ww = __uint_as_float(rec.y); bf16_t* rp = Y + (size_t)d * 1024 + col;
#pragma unroll
                    for (int bj = 0; bj < 2; ++bj) st16d(rp + 128 * bj, pack8(acc[ai][bj][m][0] * ww, acc[ai][bj][m][1] * ww)); }
            }
    }
};

struct InOrder {
    static constexpr bool GATHER = false; DI int row(int, int) const { return 0; }
    pg8::StaticOrder so; int nmain;
    DI bool next(int i, Unit& u) const {
        const long L = (long)i * so.G + so.c;
        if (L < nmain) return so.next(i, u);
        const int idx = (int)(L - nmain); if (idx >= 64) return false;
        u.pm = NTOK / 256 + (idx >> 2); u.pn = 32 + (idx & 3); u.aux = u.pn; return true;
    }
    DI void a_ready(const Unit&) const {}
    DI void done(const Unit&) const {}
};
template <bool GATHER_> struct MoeOrder {
    static constexpr bool GATHER = GATHER_;
    const LAS int* tile_exp; int ntiles, G, c; const LAS int* rowtab;
    DI int row(int ui, int r) const { return rowtab[ui * 256 + r]; }
    DI bool next(int i, Unit& u) const {
        const int nwg = ntiles * 4; const long L = (long)i * G + c; if (L >= nwg) return false;
        int wgid = (int)L; { const int q = nwg / 8, r = nwg % 8, xcd = wgid % 8, off = wgid / 8; wgid = (xcd < r ? xcd * (q + 1) : r * (q + 1) + (xcd - r) * q) + off; }
        u.pm = wgid >> 2; u.aux = wgid & 3; u.pn = tile_exp[u.pm] * 4 + u.aux; return true;
    }
    DI void a_ready(const Unit&) const {}
    DI void done(const Unit&) const {}
};

struct Args { const void* in[24]; float* out; unsigned char* ws; int ph_lo, ph_hi; };
enum { I_X = 0, I_MEM, I_POS, I_GMIX, I_GMEM, I_WIN, I_GQA, I_GKA, I_WCONV, I_WMKV, I_GQM, I_GKM, I_WPA, I_WPC, I_WPM, I_WOUT, I_GFFN, I_WRG, I_BRG, I_WRE, I_BRE, I_WGATE, I_WUP, I_WDOWN };

DI void transpose_item(const float* src, int ldsrc, int k0, int col0, bf16_t* dst, int lddst, int drow0, int dk0, const float* kgain, LAS float* scr, int lane, bool gmode = false) {
    (void)scr;
    const int kg = lane >> 3, nq = lane & 7;
    const float* sp = src + (size_t)(k0 + 8 * kg) * ldsrc + col0 + (gmode ? 16 * (nq >> 1) + 4 * (nq & 1) : 4 * nq);
    f32x4 v[8];
#pragma unroll
    for (int j = 0; j < 8; ++j) v[j] = *(const f32x4*)(sp + (size_t)j * ldsrc);
    if (kgain) { const f32x4 g0 = *(const f32x4*)(kgain + k0 + 8 * kg), g1 = *(const f32x4*)(kgain + k0 + 8 * kg + 4);
        v[0] *= g0.x; v[1] *= g0.y; v[2] *= g0.z; v[3] *= g0.w; v[4] *= g1.x; v[5] *= g1.y; v[6] *= g1.z; v[7] *= g1.w; }
    bf16_t* dp = dst + (size_t)(drow0 + 4 * nq) * lddst + dk0 + 8 * kg;
#pragma unroll
    for (int q = 0; q < 4; ++q) { u32x4 o; o.x = pk2(v[0][q], v[1][q]); o.y = pk2(v[2][q], v[3][q]); o.z = pk2(v[4][q], v[5][q]); o.w = pk2(v[6][q], v[7][q]);
        *(u32x4*)(dp + (size_t)q * lddst) = o; }
}
DI unsigned q8x4(float a, float b, float c, float d) {
    const int ia = (int)__builtin_rintf(a), ib = (int)__builtin_rintf(b), ic = (int)__builtin_rintf(c), id = (int)__builtin_rintf(d);
    return ((unsigned)ia & 0xffu) | (((unsigned)ib & 0xffu) << 8) | (((unsigned)ic & 0xffu) << 16) | ((unsigned)id << 24);
}
DI void quant_gu_item(const float* src  , int lds_, int col0, unsigned char* dst, int drow0, const float* kgain  , float* sb  , int lane) {
    const float* sp = src + (size_t)(16 * lane) * lds_ + col0;
    f32x4 v[16][2];
#pragma unroll
    for (int j = 0; j < 16; ++j) { v[j][0] = *(const f32x4*)(sp + (size_t)j * lds_); v[j][1] = *(const f32x4*)(sp + (size_t)j * lds_ + 4); }
    float g[16];
#pragma unroll
    for (int j4 = 0; j4 < 4; ++j4) { f32x4 gg = {1.f, 1.f, 1.f, 1.f}; if (kgain) gg = *(const f32x4*)(kgain + 16 * lane + 4 * j4); g[4 * j4] = gg.x; g[4 * j4 + 1] = gg.y; g[4 * j4 + 2] = gg.z; g[4 * j4 + 3] = gg.w; }
    float cm[8];
#pragma unroll
    for (int c = 0; c < 8; ++c) cm[c] = 0.f;
#pragma unroll
    for (int j = 0; j < 16; ++j) { v[j][0] *= g[j]; v[j][1] *= g[j];
#pragma unroll
        for (int c = 0; c < 4; ++c) { cm[c] = fmaxf(cm[c], fabsf(v[j][0][c])); cm[4 + c] = fmaxf(cm[4 + c], fabsf(v[j][1][c])); } }
#pragma unroll
    for (int c = 0; c < 8; ++c) {
#pragma unroll
        for (int o = 1; o < 64; o <<= 1) cm[c] = fmaxf(cm[c], __shfl_xor(cm[c], o)); }
    if (lane < 8) { float mine = cm[0];
#pragma unroll
        for (int c = 1; c < 8; ++c) mine = (lane == c) ? cm[c] : mine;
        sb[lane] = mine * (1.f / 127.f); }
#pragma unroll
    for (int c = 0; c < 8; ++c) { const float sc = cm[c] > 0.f ? 127.f / cm[c] : 0.f; u32x4 o;
#pragma unroll
        for (int w = 0; w < 4; ++w) o[w] = q8x4(v[4 * w][c >> 2][c & 3] * sc, v[4 * w + 1][c >> 2][c & 3] * sc, v[4 * w + 2][c >> 2][c & 3] * sc, v[4 * w + 3][c >> 2][c & 3] * sc);
        *(u32x4*)(dst + (size_t)(drow0 + c) * 1024 + 16 * lane) = o; }
}
DI int gperm_col0(int c) { return 64 * ((c >> 5) & 3) + 8 * (c >> 7); }
DI int in_orig_col(int n0) {
    const int t = n0 >> 8, c = n0 & 255;
    if (t < 3)  return (4 * t + ((c >> 5) & 3)) * 64 + 32 * (c >> 7) + (c & 31);
    if (t < 6)  return 768 + (4 * (t - 3) + ((c >> 5) & 3)) * 64 + 32 * (c >> 7) + (c & 31);
    if (t < 9)  return 1536 + (t - 6) * 256 + c;
    if (t < 15) return (c < 128) ? 2304 + 128 * (t - 9) + c : 3840 + 128 * (t - 9) + c - 128;
    if (t < 18) return 3072 + (t - 15) * 256 + c;
    if (t < 20) return 4608 + (t - 18) * 256 + c;
    return 5120 + (t - 20) * 256 + gperm_col0(c);
}
DI int orig_col8(int n0) {
    const int t = n0 >> 8, c = n0 & 255;
    if (t < 3)  return (4 * t + ((c >> 5) & 3)) * 64 + 32 * (c >> 7) + (c & 31);
    if (t < 6)  return 768 + (4 * (t - 3) + ((c >> 5) & 3)) * 64 + 32 * (c >> 7) + (c & 31);
    if (t < 9)  return 1536 + (t - 6) * 256 + c;
    if (t < 15) return (c < 128) ? 2304 + 128 * (t - 9) + c : 3840 + 128 * (t - 9) + c - 128;
    if (t < 18) return 3072 + (t - 15) * 256 + c;
    if (t < 20) return 4608 + (t - 18) * 256 + c;
    return 5120 + (t - 20) * 256 + 64 * ((c >> 5) & 3) + 16 * ((c >> 3) & 3) + 8 * (c >> 7);
}
DI void rms_rows_to_i8(const float* x, const float* g, int nrows, unsigned char* A8, float* SH, int gw, int NGW, int lane) {
    const f32x4* gr = (const f32x4*)g + lane; f32x4 gg[4];
#pragma unroll
    for (int j = 0; j < 4; ++j) gg[j] = gr[64 * j];
    for (int m0 = 4 * gw; m0 < nrows; m0 += 4 * NGW) {
        f32x4 v[4][4];
#pragma unroll
        for (int r = 0; r < 4; ++r)
#pragma unroll
            for (int j = 0; j < 4; ++j) v[r][j] = ((const f32x4*)(x + (size_t)(m0 + r) * 1024) + lane)[64 * j];
#pragma unroll
        for (int r = 0; r < 4; ++r) {
            float s = 0.f;
#pragma unroll
            for (int j = 0; j < 4; ++j) s += (v[r][j].x * v[r][j].x + v[r][j].y * v[r][j].y) + (v[r][j].z * v[r][j].z + v[r][j].w * v[r][j].w);
            const float rstd = __builtin_amdgcn_rsqf(wave_sum(s) * (1.f / 1024.f) + EPS);
            float am = 0.f;
#pragma unroll
            for (int j = 0; j < 4; ++j) { v[r][j] = v[r][j] * rstd * gg[j];
                am = fmaxf(am, fmaxf(fmaxf(fabsf(v[r][j].x), fabsf(v[r][j].y)), fmaxf(fabsf(v[r][j].z), fabsf(v[r][j].w)))); }
#pragma unroll
            for (int o = 1; o < 64; o <<= 1) am = fmaxf(am, __shfl_xor(am, o));
            const float inv = am > 0.f ? 127.f / am : 0.f;
            unsigned* q8 = (unsigned*)(A8 + (size_t)(m0 + r) * 1024) + lane;
#pragma unroll
            for (int j = 0; j < 4; ++j) q8[64 * j] = q8x4(v[r][j].x * inv, v[r][j].y * inv, v[r][j].z * inv, v[r][j].w * inv);
            if (lane == 0) SH[m0 + r] = am * (1.f / 127.f);
        }
    }
}
DI void rms_row_to_bf16(const float* xrow, const float* g, bf16_t* orow, int lane) {
    const f32x4* xr = (const f32x4*)xrow + lane; const f32x4* gr = (const f32x4*)g + lane;
    f32x4 v[4]; float s = 0.f;
#pragma unroll
    for (int j = 0; j < 4; ++j) { v[j] = xr[64 * j]; s += (v[j].x * v[j].x + v[j].y * v[j].y) + (v[j].z * v[j].z + v[j].w * v[j].w); }
    const float rstd = __builtin_amdgcn_rsqf(wave_sum(s) * (1.f / 1024.f) + EPS);
    u32x2* o8 = (u32x2*)orow + lane;
#pragma unroll
    for (int j = 0; j < 4; ++j) { const f32x4 gg = gr[64 * j]; u32x2 w; w.x = pk2(v[j].x * rstd * gg.x, v[j].y * rstd * gg.y); w.y = pk2(v[j].z * rstd * gg.z, v[j].w * rstd * gg.w); o8[64 * j] = w; }
}

DI void phase0(const Args& a, LAS unsigned char* lds, int tid, int lane, int wave) {
    const int gw = blockIdx.x * 8 + wave, NGW = gridDim.x * 8;
    LAS float* scr = (LAS float*)(lds + wave * 16384);
    unsigned char* ws = a.ws; unsigned char* dob = (unsigned char*)a.out;
    bf16_t* Wt_mrg = (bf16_t*)(ws + WS_WMRG); bf16_t* Wt_out = (bf16_t*)(ws + WS_WOUT);
    constexpr int I_W8 = 1024 + 128, I_PA = 4 * 32, I_PC = 12 * 32, I_PM = 8 * 32, I_OUT = 16 * 32;
    constexpr int NITEMS = I_W8 + I_PA + I_PC + I_PM + I_OUT;
    for (int it = gw; it < NITEMS; it += NGW) {
        int r = it;
        if (r < I_W8) { const int n0 = r * 8;
            if (n0 < 8192) quant_gu_item((const float*)a.in[I_WIN], 8192, orig_col8(n0), ws + WS_WIN, n0, nullptr, (float*)(ws + WS_SW) + n0, lane);
            else quant_gu_item((const float*)a.in[I_WMKV], 1024, n0 - 8192, ws + WS_WIN, n0, nullptr, (float*)(ws + WS_SW) + n0, lane);
            continue; } r -= I_W8;
        if (r < I_PA) { const int kb = r >> 5, nb = r & 31; transpose_item((const float*)a.in[I_WPA], 1024, kb * 64, (nb >> 3) * 256 + gperm_col0((nb & 7) * 32), Wt_mrg, 1536, nb * 32, kb * 64, nullptr, scr, lane, true); continue; } r -= I_PA;
        if (r < I_PC) { const int kb = r >> 5, nb = r & 31; transpose_item((const float*)a.in[I_WPC], 1024, kb * 64, (nb >> 3) * 256 + gperm_col0((nb & 7) * 32), Wt_mrg, 1536, nb * 32, 256 + kb * 64, nullptr, scr, lane, true); continue; } r -= I_PC;
        if (r < I_PM) { const int kb = r >> 5, nb = r & 31; transpose_item((const float*)a.in[I_WPM], 1024, kb * 64, (nb >> 3) * 256 + gperm_col0((nb & 7) * 32), Wt_mrg, 1536, nb * 32, 1024 + kb * 64, nullptr, scr, lane, true); continue; } r -= I_PM;
        { const int kb = r >> 5, nb = r & 31; transpose_item((const float*)a.in[I_WOUT], 1024, kb * 64, nb * 32, Wt_out, 1024, nb * 32, kb * 64, nullptr, scr, lane); }
    }
    rms_rows_to_i8((const float*)a.in[I_X], (const float*)a.in[I_GMIX], NTOK, dob + DO_A8, (float*)(ws + WS_SH), gw, NGW, lane);
    rms_rows_to_i8((const float*)a.in[I_MEM], (const float*)a.in[I_GMEM], NMROW, dob + DO_A8 + (size_t)NTOK * 1024, (float*)(ws + WS_SH) + NTOK, gw, NGW, lane);
    const int gt = blockIdx.x * 512 + tid, NT = gridDim.x * 512;
    { const float* wrg = (const float*)a.in[I_WRG]; const float* wre = (const float*)a.in[I_WRE]; const float* gf = (const float*)a.in[I_GFFN];
      bf16_t* WH = (bf16_t*)(ws + WS_WRH); bf16_t* WL = (bf16_t*)(ws + WS_WRL);
      for (int idx = gt; idx < 48 * 1024; idx += NT) { const int n = idx >> 10, k = idx & 1023;
          float v = 0.f; if (n < 4) v = wrg[k * 4 + n] * gf[k]; else if (n < 36) v = wre[k * 32 + (n - 4)] * gf[k];
          const unsigned hi = pk2(v, 0.f) & 0xffffu; const float lo = v - __uint_as_float(hi << 16);
          WH[idx] = (bf16_t)hi; WL[idx] = (bf16_t)(pk2(lo, 0.f) & 0xffffu); } }
    { const int* pos = (const int*)a.in[I_POS]; _Float16* cs = (_Float16*)(ws + WS_ROPE);
      for (int idx = gt; idx < NTOK * 8; idx += NT) { const int row = idx >> 3, j = idx & 7;
          const double inv = exp2(-(double)j * (18.931568569324174 / 8.0));
          const float invf = (float)inv; const float ang = (float)pos[row] * invf;
          const double ad = (double)ang; cs[row * 16 + j] = (_Float16)(float)cos(ad); cs[row * 16 + 8 + j] = (_Float16)(float)sin(ad); } }
}

typedef short v4i16_t __attribute__((ext_vector_type(4)));
DI s16x4 vtr(const LAS unsigned char* p) { return __builtin_bit_cast(s16x4, __builtin_amdgcn_ds_read_tr16_b64_v4i16((LAS v4i16_t*)p)); }

DI int kimg64(int slot, int c16) { return slot * 128 + ((c16 ^ ((slot >> 1) & 7)) << 4); }
DI int img256(int row, int ch) { return row * 256 + ((ch ^ (((row & 3) << 2) | ((row >> 2) & 3))) << 4); }
constexpr int A_VOFF = 49152, A_VS = 192;
constexpr int M_VOFF = 65536;

struct AUnit { int b, head, gi, hs, dl, L, j, Q0; size_t rowb; };
DI AUnit a_decode(int wu) {
    AUnit u; const int blk8 = wu & 7; const int bh = wu >> 3; u.head = bh % 12; u.b = bh / 12; u.gi = u.head >> 2; u.hs = u.head & 3;
    u.dl = (u.gi == 0) ? 1 : (u.gi == 1) ? 4 : 16; u.L = SEQ / u.dl;
    if (u.gi < 2) { const int npj = u.L >> 8; u.j = blk8 / npj; u.Q0 = (blk8 % npj) << 8; } else { u.j = 2 * blk8; u.Q0 = 0; }
    u.rowb = (size_t)u.b * SEQ; return u;
}
DI void a_wave_geom(const AUnit& u, int wave, int& qsub, int& kj_first, int& slot_first, int& jq) {
    jq = u.j;
    if (u.gi < 2) { qsub = u.Q0 + 32 * wave; kj_first = qsub - 64; slot_first = 32 * wave; }
    else { const int sub = wave >> 2; jq = u.j + sub; qsub = 32 * (wave & 3); kj_first = qsub - 64; slot_first = sub * 128 + kj_first; }
}
DI void a_issue(const AUnit& u, const bf16_t* Q, const bf16_t* K, const bf16_t* V, int tid, int lane, int wave, u32x4 (&kv)[6], u32x4 (&vv)[6], unsigned& okm, bf16x8 (&qf)[4]) {
    const int nsl = (u.gi < 2) ? 384 : 256; okm = 0u;
#pragma unroll
    for (int i = 0; i < 6; ++i) {
        const int p = tid + i * 512, slot = p >> 3, c16 = p & 7; size_t row; bool ok = slot < nsl;
        if (u.gi < 2) { const int kj = u.Q0 - 64 + slot; ok = ok && (kj >= 0 && kj < u.L); row = u.rowb + (size_t)kj * u.dl + u.j; }
        else { row = u.rowb + (size_t)(slot & 127) * 16 + u.j + (slot >> 7); }
        if (ok) { kv[i] = *(const u32x4*)(K + row * 768 + u.head * 64 + c16 * 8); vv[i] = *(const u32x4*)(V + row * 768 + u.head * 64 + c16 * 8); okm |= 1u << i; }
    }
    int qsub, kj_first, slot_first, jq; a_wave_geom(u, wave, qsub, kj_first, slot_first, jq);
    const size_t rowq = u.rowb + (size_t)(qsub + (lane & 31)) * u.dl + jq;
    const bf16_t* qrow = Q + rowq * 768 + u.head * 64;
#pragma unroll
    for (int s = 0; s < 4; ++s) qf[s] = *(const bf16x8*)(qrow + 16 * s + 8 * (lane >> 5));
}
DI void a_fill(LAS unsigned char* lds, int tid, const u32x4 (&kv)[6], const u32x4 (&vv)[6], unsigned okm) {
#pragma unroll
    for (int i = 0; i < 6; ++i) { const int p = tid + i * 512, slot = p >> 3, c16 = p & 7;
        if (okm & (1u << i)) { *(LAS u32x4*)(lds + kimg64(slot, c16)) = kv[i]; *(LAS u32x4*)(lds + A_VOFF + slot * A_VS + c16 * 16) = vv[i]; } }
}
DI void a_compute(const AUnit& u, const bf16x8 (&qf)[4], bf16_t* PO, float* LSE, LAS unsigned char* lds, int lane, int wave) {
    const int gi = u.gi, hs = u.hs, dl = u.dl, L = u.L; const size_t rowb = u.rowb;
    const int r32 = lane & 31, h = lane >> 5;
    int qsub, kj_first, slot_first, jq; a_wave_geom(u, wave, qsub, kj_first, slot_first, jq);
    const size_t rowq = rowb + (size_t)(qsub + r32) * dl + jq;
    f32x16 o[2];
#pragma unroll
    for (int dt = 0; dt < 2; ++dt)
#pragma unroll
        for (int r = 0; r < 16; ++r) o[dt][r] = 0.f;
    float m = -INFINITY, lp = 0.f;
    const int q4 = (lane & 15) >> 2, p4 = lane & 3, blk = (lane >> 4) & 1;
    const int troff = (4 * h + q4) * A_VS + blk * 32 + p4 * 8;
#pragma unroll
    for (int ci = 0; ci < 5; ++ci) {
        const int c = (ci == 0 ? 2 : ci == 1 ? 1 : ci == 2 ? 3 : ci == 3 ? 0 : 4);
        const int kj = kj_first + 32 * c;
        if (kj < 0 || kj >= L) continue;
        const int slot0 = slot_first + 32 * c, ks = slot0 + r32;
        const LAS unsigned char* kp = lds + ks * 128; const int kx = (ks >> 1) & 7;
        f32x16 S;
        const float ninit = (ci == 0) ? 0.f : -m;
#pragma unroll
        for (int r = 0; r < 16; ++r) S[r] = ninit;
#pragma unroll
        for (int s = 0; s < 4; ++s) { const bf16x8 kf = *(const LAS bf16x8*)(kp + (((2 * s + h) ^ kx) << 4)); S = MFMA32(kf, qf[s], S); }
        if (c == 0) {
#pragma unroll
            for (int r = 0; r < 16; ++r) if (crow(r, h) < r32) S[r] = -INFINITY;
        }
        if (c == 4) {
#pragma unroll
            for (int r = 0; r < 16; ++r) if (crow(r, h) > r32) S[r] = -INFINITY;
        }
        float mx = S[0];
#pragma unroll
        for (int r = 1; r < 16; ++r) mx = fmaxf(mx, S[r]);
        mx = fmaxf(mx, __shfl_xor(mx, 32));
        if (ci == 0 || __builtin_amdgcn_ballot_w64(mx > 8.f) != 0ull) {
            const float d = (ci == 0) ? mx : fmaxf(mx, 0.f), al = fexp2(-d);
            m = ((ci == 0) ? 0.f : m) + d; lp *= al;
#pragma unroll
            for (int r = 0; r < 16; ++r) S[r] -= d;
#pragma unroll
            for (int dt = 0; dt < 2; ++dt)
#pragma unroll
                for (int r = 0; r < 16; ++r) o[dt][r] *= al;
        }
        float rsum = 0.f;
#pragma unroll
        for (int r = 0; r < 16; ++r) { S[r] = fexp2(S[r]); rsum += S[r]; }
        lp += rsum;
        bf16x8 pb[2];
#pragma unroll
        for (int s2 = 0; s2 < 2; ++s2) { u32x4 w; w.x = pk2(S[8 * s2], S[8 * s2 + 1]); w.y = pk2(S[8 * s2 + 2], S[8 * s2 + 3]); w.z = pk2(S[8 * s2 + 4], S[8 * s2 + 5]); w.w = pk2(S[8 * s2 + 6], S[8 * s2 + 7]); pb[s2] = __builtin_bit_cast(bf16x8, w); }
        const LAS unsigned char* trp = lds + A_VOFF + slot0 * A_VS + troff;
#pragma unroll
        for (int dt = 0; dt < 2; ++dt)
#pragma unroll
            for (int s2 = 0; s2 < 2; ++s2) {
                const s16x4 lo = vtr(trp + (16 * s2) * A_VS + dt * 64), hi = vtr(trp + (16 * s2 + 8) * A_VS + dt * 64);
                const bf16x8 va = __builtin_shufflevector(lo, hi, 0, 1, 2, 3, 4, 5, 6, 7);
                o[dt] = MFMA32(va, pb[s2], o[dt]);
            }
    }
    const float l = lp + __shfl_xor(lp, 32), inv = 1.f / l;
    if (h == 0) LSE[((size_t)gi * NTOK + rowq) * 4 + hs] = m + __builtin_amdgcn_logf(l);
    __syncthreads();
    { LAS unsigned char* ot = lds + wave * 4096;
#pragma unroll
      for (int dt = 0; dt < 2; ++dt)
#pragma unroll
          for (int g4 = 0; g4 < 4; ++g4) { u32x2 w; w.x = pk2(o[dt][4 * g4] * inv, o[dt][4 * g4 + 1] * inv); w.y = pk2(o[dt][4 * g4 + 2] * inv, o[dt][4 * g4 + 3] * inv);
              *(LAS u32x2*)(ot + r32 * 128 + (32 * dt + 8 * g4 + 4 * h) * 2) = w; }
      asm volatile("s_waitcnt lgkmcnt(0)" ::: "memory");
#pragma unroll
      for (int i = 0; i < 4; ++i) { const int q = i * 8 + (lane >> 3), c16 = lane & 7;
          const u32x4 w = *(const LAS u32x4*)(ot + q * 128 + c16 * 16);
          const size_t rq = rowb + (size_t)(qsub + q) * dl + jq;
          *(u32x4*)(PO + ((size_t)gi * NTOK + rq) * 256 + hs * 64 + c16 * 8) = w; }
    }
    __syncthreads();
}


DI void attnM_wg(int wu, const bf16_t* QM, const bf16_t* KM, const bf16_t* VM, const float* gqm, const float* gkm, bf16_t* AM, LAS unsigned char* lds, int tid, int lane, int wave) {
    const int qblk = wu & 7, head = (wu >> 3) & 3, b = wu >> 5;
    { const bf16_t* kb = KM + (size_t)b * NMEM * 512 + head * 128; const bf16_t* vb = VM + (size_t)b * NMEM * 512 + head * 128;
      u32x4 kv[8], vv[8];
#pragma unroll
      for (int i = 0; i < 8; ++i) { const int p = tid + i * 512, row = p >> 4, ch = p & 15;
          kv[i] = *(const u32x4*)(kb + (size_t)row * 512 + ch * 8); vv[i] = *(const u32x4*)(vb + (size_t)row * 512 + ch * 8); }
      const int chl = tid & 15; const f32x4 g0 = *(const f32x4*)(gkm + chl * 8), g1 = *(const f32x4*)(gkm + chl * 8 + 4);
#pragma unroll
      for (int i = 0; i < 8; ++i) { const int p = tid + i * 512, row = p >> 4, ch = p & 15;
          float x[8]; x[0] = bf_lo(kv[i].x); x[1] = bf_hi(kv[i].x); x[2] = bf_lo(kv[i].y); x[3] = bf_hi(kv[i].y); x[4] = bf_lo(kv[i].z); x[5] = bf_hi(kv[i].z); x[6] = bf_lo(kv[i].w); x[7] = bf_hi(kv[i].w);
          float ss = (x[0] * x[0] + x[1] * x[1]) + (x[2] * x[2] + x[3] * x[3]) + (x[4] * x[4] + x[5] * x[5]) + (x[6] * x[6] + x[7] * x[7]);
          ss += __shfl_xor(ss, 1); ss += __shfl_xor(ss, 2); ss += __shfl_xor(ss, 4); ss += __shfl_xor(ss, 8);
          const float rs = __builtin_amdgcn_rsqf(ss * (1.f / 128.f) + EPS);
          u32x4 kn; kn.x = pk2(x[0] * rs * g0.x, x[1] * rs * g0.y); kn.y = pk2(x[2] * rs * g0.z, x[3] * rs * g0.w); kn.z = pk2(x[4] * rs * g1.x, x[5] * rs * g1.y); kn.w = pk2(x[6] * rs * g1.z, x[7] * rs * g1.w);
          const int off = img256(row, ch); *(LAS u32x4*)(lds + off) = kn; *(LAS u32x4*)(lds + M_VOFF + off) = vv[i]; } }
    __syncthreads();
    const int r32 = lane & 31, h = lane >> 5;
    const int q4 = (lane & 15) >> 2, p4 = lane & 3, blk = (lane >> 4) & 1;
    const int kxor = ((r32 & 3) << 2) | ((r32 >> 2) & 3);
    const int vlow0 = ((2 * blk + (p4 >> 1)) ^ (h & 3)) << 4, vlow1 = ((2 * blk + (p4 >> 1)) ^ ((h + 2) & 3)) << 4;
    {
        const size_t rowq = (size_t)b * SEQ + qblk * 256 + wave * 32 + r32;
        const bf16_t* qrow = QM + rowq * 512 + head * 128;
        bf16x8 qf[8];
#pragma unroll
        for (int s = 0; s < 8; ++s) qf[s] = *(const bf16x8*)(qrow + 16 * s + 8 * h);
        { float ss = 0.f;
#pragma unroll
          for (int s = 0; s < 8; ++s)
#pragma unroll
              for (int jx = 0; jx < 8; ++jx) { const float x = bf2f(qf[s][jx]); ss += x * x; }
          ss += __shfl_xor(ss, 32);
          const float rs = __builtin_amdgcn_rsqf(ss * (1.f / 128.f) + EPS) * QSCALE_M;
#pragma unroll
          for (int s = 0; s < 8; ++s) {
              const f32x4 g0 = *(const f32x4*)(gqm + 16 * s + 8 * h), g1 = *(const f32x4*)(gqm + 16 * s + 8 * h + 4);
              u32x4 w;
              w.x = pk2(bf2f(qf[s][0]) * rs * g0.x, bf2f(qf[s][1]) * rs * g0.y); w.y = pk2(bf2f(qf[s][2]) * rs * g0.z, bf2f(qf[s][3]) * rs * g0.w);
              w.z = pk2(bf2f(qf[s][4]) * rs * g1.x, bf2f(qf[s][5]) * rs * g1.y); w.w = pk2(bf2f(qf[s][6]) * rs * g1.z, bf2f(qf[s][7]) * rs * g1.w);
              qf[s] = __builtin_bit_cast(bf16x8, w); } }
        f32x16 o[4];
#pragma unroll
        for (int dt = 0; dt < 4; ++dt)
#pragma unroll
            for (int r = 0; r < 16; ++r) o[dt][r] = 0.f;
        float m = -INFINITY, lp = 0.f;
#pragma unroll 1
        for (int c = 0; c < 8; ++c) {
            const int slot0 = 32 * c;
            const LAS unsigned char* kp = lds + (slot0 + r32) * 256;
            f32x16 S;
            const float ninit = (c == 0) ? 0.f : -m;
#pragma unroll
            for (int r = 0; r < 16; ++r) S[r] = ninit;
#pragma unroll
            for (int s = 0; s < 8; ++s) { const bf16x8 kf = *(const LAS bf16x8*)(kp + (((2 * s + h) ^ kxor) << 4)); S = MFMA32(kf, qf[s], S); }
            float mx = S[0];
#pragma unroll
            for (int r = 1; r < 16; ++r) mx = fmaxf(mx, S[r]);
            mx = fmaxf(mx, __shfl_xor(mx, 32));
            if (c == 0 || __builtin_amdgcn_ballot_w64(mx > 8.f) != 0ull) {
                const float d = (c == 0) ? mx : fmaxf(mx, 0.f), al = fexp2(-d);
                m = ((c == 0) ? 0.f : m) + d; lp *= al;
#pragma unroll
                for (int r = 0; r < 16; ++r) S[r] -= d;
#pragma unroll
                for (int dt = 0; dt < 4; ++dt)
#pragma unroll
                    for (int r = 0; r < 16; ++r) o[dt][r] *= al;
            }
            float rsum = 0.f;
#pragma unroll
            for (int r = 0; r < 16; ++r) { S[r] = fexp2(S[r]); rsum += S[r]; }
            lp += rsum;
            bf16x8 pb[2];
#pragma unroll
            for (int s2 = 0; s2 < 2; ++s2) { u32x4 w; w.x = pk2(S[8 * s2], S[8 * s2 + 1]); w.y = pk2(S[8 * s2 + 2], S[8 * s2 + 3]); w.z = pk2(S[8 * s2 + 4], S[8 * s2 + 5]); w.w = pk2(S[8 * s2 + 6], S[8 * s2 + 7]); pb[s2] = __builtin_bit_cast(bf16x8, w); }
            const LAS unsigned char* vp = lds + M_VOFF + (slot0 + 4 * h + q4) * 256 + (p4 & 1) * 8;
#pragma unroll
            for (int dt = 0; dt < 4; ++dt)
#pragma unroll
                for (int s2 = 0; s2 < 2; ++s2) {
                    const s16x4 lo = vtr(vp + (16 * s2) * 256 + ((dt ^ q4) << 6) + vlow0), hi = vtr(vp + (16 * s2 + 8) * 256 + ((dt ^ q4) << 6) + vlow1);
                    const bf16x8 va = __builtin_shufflevector(lo, hi, 0, 1, 2, 3, 4, 5, 6, 7);
                    o[dt] = MFMA32(va, pb[s2], o[dt]);
                }
        }
        const float l = lp + __shfl_xor(lp, 32), inv = 1.f / l;
        __syncthreads();
        LAS unsigned char* ot = lds + wave * 8192;
#pragma unroll
        for (int dt = 0; dt < 4; ++dt)
#pragma unroll
            for (int g4 = 0; g4 < 4; ++g4) { u32x2 w; w.x = pk2(o[dt][4 * g4] * inv, o[dt][4 * g4 + 1] * inv); w.y = pk2(o[dt][4 * g4 + 2] * inv, o[dt][4 * g4 + 3] * inv);
                *(LAS u32x2*)(ot + r32 * 256 + (32 * dt + 8 * g4 + 4 * h) * 2) = w; }
        asm volatile("s_waitcnt lgkmcnt(0)" ::: "memory");
        const size_t rowq0 = (size_t)b * SEQ + qblk * 256 + wave * 32;
#pragma unroll
        for (int i = 0; i < 8; ++i) { const int q = i * 4 + (lane >> 4), c16 = lane & 15;
            const u32x4 w = *(const LAS u32x4*)(ot + q * 256 + c16 * 16);
            *(u32x4*)(AM + (rowq0 + q) * 1536 + 1024 + head * 128 + c16 * 8) = w; }
    }
    __syncthreads();
}

DI void p2_attnA(const Args& a, LAS unsigned char* lds, int tid, int lane, int wave) {
    unsigned char* ws = a.ws; const int G = gridDim.x; const int vcu = (G % 8 == 0) ? ((int)blockIdx.x % 8) * (G / 8) + (int)blockIdx.x / 8 : (int)blockIdx.x;
    const bf16_t* Q = (const bf16_t*)(ws + WS_Q); const bf16_t* K = (const bf16_t*)(ws + WS_K); const bf16_t* V = (const bf16_t*)(ws + WS_V);
    bf16_t* PO = (bf16_t*)(ws + WS_PO); float* LSE = (float*)(ws + WS_LSE);
    constexpr int NU = NB * 12 * 8;
    const int per = (NU + G - 1) / G, u0 = vcu * per, u1 = (u0 + per < NU) ? u0 + per : NU;
    if (u0 >= u1) return;
    u32x4 kv[6], vv[6]; unsigned okm; bf16x8 qn[4];
    AUnit cu = a_decode(u0);
    a_issue(cu, Q, K, V, tid, lane, wave, kv, vv, okm, qn);
    for (int u = u0; u < u1; ++u) {
        a_fill(lds, tid, kv, vv, okm);
        bf16x8 qf[4];
#pragma unroll
        for (int s = 0; s < 4; ++s) qf[s] = qn[s];
        __syncthreads();
        AUnit nu = cu;
        if (u + 1 < u1) { nu = a_decode(u + 1); a_issue(nu, Q, K, V, tid, lane, wave, kv, vv, okm, qn); }
        a_compute(cu, qf, PO, LSE, lds, lane, wave);
        cu = nu;
    }
}
DI void p2_attnM(const Args& a, LAS unsigned char* lds, int tid, int lane, int wave) {
    unsigned char* ws = a.ws; unsigned char* dob = (unsigned char*)a.out; const int G = gridDim.x; const int vcu = (G % 8 == 0) ? ((int)blockIdx.x % 8) * (G / 8) + (int)blockIdx.x / 8 : (int)blockIdx.x;
    bf16_t* AM = (bf16_t*)(ws + WS_AM);
    const bf16_t* QM = (const bf16_t*)(dob + DO_QM); const bf16_t* KM = (const bf16_t*)(dob + DO_KM); const bf16_t* VM = (const bf16_t*)(dob + DO_VM);
    for (int u = vcu; u < NB * 4 * 8; u += G) attnM_wg(u, QM, KM, VM, (const float*)a.in[I_GQM], (const float*)a.in[I_GKM], AM, lds, tid, lane, wave);
}
DI void p2_conv(const Args& a, int tid) {
    unsigned char* ws = a.ws; bf16_t* AM = (bf16_t*)(ws + WS_AM);
    const bf16_t* U = (const bf16_t*)(ws + WS_U); const bf16_t* CB = (const bf16_t*)(ws + WS_CB); const float* wc = (const float*)a.in[I_WCONV];
    const int gt = blockIdx.x * 512 + tid, NT = gridDim.x * 512;
    constexpr int TB = 8;
    for (int idx = gt; idx < (NTOK / TB) * 96; idx += NT) {
        const int tb = idx / 96, c8 = (idx % 96) * 8, row0 = tb * TB, s0 = row0 & (SEQ - 1);
        u32x4 uu[TB + 2], cb[TB];
        const u32x4 zero = {0u, 0u, 0u, 0u};
        uu[0] = (s0 > 0) ? *(const u32x4*)(U + (size_t)(row0 - 1) * 768 + c8) : zero;
#pragma unroll
        for (int t = 0; t < TB; ++t) { uu[t + 1] = *(const u32x4*)(U + (size_t)(row0 + t) * 768 + c8); cb[t] = *(const u32x4*)(CB + (size_t)(row0 + t) * 768 + c8); }
        uu[TB + 1] = (s0 + TB < SEQ) ? *(const u32x4*)(U + (size_t)(row0 + TB) * 768 + c8) : zero;
        float k0[8], k1[8], k2[8];
        { const f32x4 a0 = *(const f32x4*)(wc + c8), a1 = *(const f32x4*)(wc + c8 + 4), b0 = *(const f32x4*)(wc + 768 + c8), b1 = *(const f32x4*)(wc + 768 + c8 + 4),
                      d0 = *(const f32x4*)(wc + 1536 + c8), d1 = *(const f32x4*)(wc + 1536 + c8 + 4);
#pragma unroll
          for (int q = 0; q < 4; ++q) { k0[q] = a0[q]; k0[4 + q] = a1[q]; k1[q] = b0[q]; k1[4 + q] = b1[q]; k2[q] = d0[q]; k2[4 + q] = d1[q]; } }
#pragma unroll
        for (int t = 0; t < TB; ++t) {
            u32x4 o;
#pragma unroll
            for (int w = 0; w < 4; ++w) {
                const float y0 = k0[2 * w] * bf_lo(uu[t][w]) + k1[2 * w] * bf_lo(uu[t + 1][w]) + k2[2 * w] * bf_lo(uu[t + 2][w]);
                const float y1 = k0[2 * w + 1] * bf_hi(uu[t][w]) + k1[2 * w + 1] * bf_hi(uu[t + 1][w]) + k2[2 * w + 1] * bf_hi(uu[t + 2][w]);
                o[w] = pk2(bf_lo(cb[t][w]) * y0, bf_hi(cb[t][w]) * y1);
            }
            *(u32x4*)(AM + (size_t)(row0 + t) * 1536 + 256 + c8) = o;
        }
    }
}
#ifndef P2_REP
#define P2_REP 0
#endif
DI void phase2(const Args& a, LAS unsigned char* lds, int tid, int lane, int wave) {
#ifndef P2_PARTS
#define P2_PARTS 7
#endif
    if constexpr (P2_PARTS & 1) p2_attnA(a, lds, tid, lane, wave);
    if constexpr (P2_REP & 1) p2_attnA(a, lds, tid, lane, wave);
    __builtin_amdgcn_sched_barrier(0); asm volatile("" ::: "memory");
    if constexpr (P2_PARTS & 2) p2_attnM(a, lds, tid, lane, wave);
    if constexpr (P2_REP & 2) p2_attnM(a, lds, tid, lane, wave);
    if constexpr (P2_PARTS & 4) p2_conv(a, tid);
    if constexpr (P2_REP & 4) p2_conv(a, tid);
}

DI void attn_combine(const Args& a, int tid) {
    unsigned char* ws = a.ws;
    const bf16_t* PO = (const bf16_t*)(ws + WS_PO); const float* LSE = (const float*)(ws + WS_LSE); bf16_t* AM = (bf16_t*)(ws + WS_AM);
    const int gt = blockIdx.x * 512 + tid, NT = gridDim.x * 512;
    for (int idx = gt; idx < NTOK * 32; idx += NT) {
        const int row = idx >> 5, c8 = (idx & 31) * 8, hs = c8 >> 6;
        const float l0 = LSE[(size_t)row * 4 + hs], l1 = LSE[((size_t)NTOK + row) * 4 + hs], l2 = LSE[((size_t)2 * NTOK + row) * 4 + hs];
        const float mx = fmaxf(l0, fmaxf(l1, l2)); float w0 = fexp2(l0 - mx), w1 = fexp2(l1 - mx), w2 = fexp2(l2 - mx);
        const float inv = 1.f / (w0 + w1 + w2); w0 *= inv; w1 *= inv; w2 *= inv;
        const u32x4 a0 = *(const u32x4*)(PO + (size_t)row * 256 + c8), a1 = *(const u32x4*)(PO + ((size_t)NTOK + row) * 256 + c8), a2 = *(const u32x4*)(PO + ((size_t)2 * NTOK + row) * 256 + c8);
        u32x4 o;
#pragma unroll
        for (int w = 0; w < 4; ++w) o[w] = pk2(w0 * bf_lo(a0[w]) + w1 * bf_lo(a1[w]) + w2 * bf_lo(a2[w]), w0 * bf_hi(a0[w]) + w1 * bf_hi(a1[w]) + w2 * bf_hi(a2[w]));
        *(u32x4*)(AM + (size_t)row * 1536 + c8) = o;
    }
}

DI void phase6(const Args& a, LAS unsigned char* lds, int tid, int lane, int wave) {
    unsigned char* ws = a.ws;
    const bf16_t* XB = (const bf16_t*)(ws + WS_XB);
    const bf16_t* WH = (const bf16_t*)(ws + WS_WRH); const bf16_t* WL = (const bf16_t*)(ws + WS_WRL);
    const float* brg = (const float*)a.in[I_BRG]; const float* bre = (const float*)a.in[I_BRE];
    int* tok_e = (int*)(ws + WS_RT + RT_TOKE); int* tok_rank = (int*)(ws + WS_RT + RT_RANK); float* tok_w = (float*)(ws + WS_RT + RT_W);
    float* tok_rstd = (float*)(ws + WS_RT + RT_RSTD); int* ccnt = (int*)(ws + WS_RT + RT_CCNT);
    LAS int* asg = (LAS int*)(lds + 32768);
    LAS int* rnk = (LAS int*)(lds + 32768 + 1024);
    bool first = true;
    for (int chunk = blockIdx.x; chunk < NTOK / 128; chunk += gridDim.x) {
        {
            constexpr int WP = 272;
            constexpr int SLB = 48 * WP;
            LAS unsigned char* wbuf = lds + 40960;
            LAS float* lg = (LAS float*)(lds + wave * 4096);
            const int t0 = chunk * 128 + wave * 16, row = lane & 15, kq = lane >> 4;
            const bf16_t* xp = XB + (size_t)(t0 + row) * 1024 + 8 * kq;
            u32x4 wst[3];
#define RT_STAGE_LOAD(sl) do { _Pragma("unroll") for (int i = 0; i < 3; ++i) { const int p = tid + i * 512, arr = p / 768, q = p % 768, r = q >> 4, c = q & 15; \
                wst[i] = *(const u32x4*)((arr ? WL : WH) + (size_t)r * 1024 + (sl) * 128 + c * 8); } } while (0)
#define RT_STAGE_WRITE(buf) do { _Pragma("unroll") for (int i = 0; i < 3; ++i) { const int p = tid + i * 512, arr = p / 768, q = p % 768, r = q >> 4, c = q & 15; \
                *(LAS u32x4*)(wbuf + ((buf) * 2 + arr) * SLB + r * WP + c * 16) = wst[i]; } } while (0)
            RT_STAGE_LOAD(0); RT_STAGE_WRITE(0);
            __syncthreads();
            pg8::f32x4 acc[3]; acc[0] = acc[1] = acc[2] = (pg8::f32x4){0.f, 0.f, 0.f, 0.f};
            float ss = 0.f, amax = 0.f;
#pragma unroll 1
            for (int sl = 0; sl < 8; ++sl) {
                if (sl + 1 < 8) RT_STAGE_LOAD(sl + 1);
                u32x4 xv[4];
#pragma unroll
                for (int ks = 0; ks < 4; ++ks) xv[ks] = *(const u32x4*)(xp + sl * 128 + 32 * ks);
                const LAS unsigned char* wb = wbuf + (sl & 1) * 2 * SLB;
#pragma unroll
                for (int ks = 0; ks < 4; ++ks) {
                    const u32x4 hi = xv[ks];
#pragma unroll
                    for (int w = 0; w < 4; ++w) { const float e0 = bf_lo(hi[w]), e1 = bf_hi(hi[w]); ss += e0 * e0 + e1 * e1; amax = fmaxf(amax, fmaxf(fabsf(e0), fabsf(e1))); }
                    const bf16x8 ah = __builtin_bit_cast(bf16x8, hi);
#pragma unroll
                    for (int nt = 0; nt < 3; ++nt) {
                        const bf16x8 bh = *(const LAS bf16x8*)(wb + (16 * nt + row) * WP + (32 * ks + 8 * kq) * 2);
                        const bf16x8 bl = *(const LAS bf16x8*)(wb + SLB + (16 * nt + row) * WP + (32 * ks + 8 * kq) * 2);
                        acc[nt] = MFMA16(ah, bh, acc[nt]); acc[nt] = MFMA16(ah, bl, acc[nt]);
                    }
                }
                if (sl + 1 < 8) RT_STAGE_WRITE((sl + 1) & 1);
                __syncthreads();
            }
#undef RT_STAGE_LOAD
#undef RT_STAGE_WRITE
            ss += __shfl_xor(ss, 16); ss += __shfl_xor(ss, 32);
            amax = fmaxf(amax, __shfl_xor(amax, 16)); amax = fmaxf(amax, __shfl_xor(amax, 32));
            {
#pragma unroll 4
                for (int r = 0; r < 16; ++r) { const float am = __shfl(amax, r); const float inv = am > 0.f ? 127.f / am : 0.f;
                    const bf16_t* rp = XB + (size_t)(t0 + r) * 1024 + 16 * lane; const u32x4 x0 = *(const u32x4*)rp, x1 = *(const u32x4*)(rp + 8);
                    u32x4 o; o.x = q8x4(bf_lo(x0.x) * inv, bf_hi(x0.x) * inv, bf_lo(x0.y) * inv, bf_hi(x0.y) * inv); o.y = q8x4(bf_lo(x0.z) * inv, bf_hi(x0.z) * inv, bf_lo(x0.w) * inv, bf_hi(x0.w) * inv);
                    o.z = q8x4(bf_lo(x1.x) * inv, bf_hi(x1.x) * inv, bf_lo(x1.y) * inv, bf_hi(x1.y) * inv); o.w = q8x4(bf_lo(x1.z) * inv, bf_hi(x1.z) * inv, bf_lo(x1.w) * inv, bf_hi(x1.w) * inv);
                    *(u32x4*)(ws + WS_XB8 + (size_t)(t0 + r) * 1024 + 16 * lane) = o; }
            }
#pragma unroll
            for (int nt = 0; nt < 3; ++nt)
#pragma unroll
                for (int r = 0; r < 4; ++r) lg[(kq * 4 + r) * 48 + 16 * nt + row] = acc[nt][r];
            asm volatile("s_waitcnt lgkmcnt(0)" ::: "memory");
            if (lane < 16) {
                const int tok = t0 + lane; const float rstd = __builtin_amdgcn_rsqf(ss * (1.f / 1024.f) + EPS);
                const LAS float* lp = lg + lane * 48;
                float gv[4]; int g = 0;
#pragma unroll
                for (int n = 0; n < 4; ++n) gv[n] = lp[n] * rstd + brg[n];
                float gm = gv[0];
#pragma unroll
                for (int n = 1; n < 4; ++n) if (gv[n] > gm) { gm = gv[n]; g = n; }
                float gz = 0.f;
#pragma unroll
                for (int n = 0; n < 4; ++n) gz += fexp(gv[n] - gm);
                const float pg = 1.f / gz;
                float sv[8];
#pragma unroll
                for (int e = 0; e < 8; ++e) sv[e] = lp[4 + 8 * g + e] * rstd + bre[8 * g + e];
                int i0 = 0; float s0 = sv[0];
#pragma unroll
                for (int e = 1; e < 8; ++e) if (sv[e] > s0) { s0 = sv[e]; i0 = e; }
                int i1 = -1; float s1 = -INFINITY;
#pragma unroll
                for (int e = 0; e < 8; ++e) if (e != i0 && sv[e] > s1) { s1 = sv[e]; i1 = e; }
                const float r = fexp(s1 - s0), w0 = pg / (1.f + r), w1 = w0 * r;
                const int al2 = (wave * 16 + lane) * 2;
                asg[al2] = g * 8 + i0; asg[al2 + 1] = g * 8 + i1;
                tok_w[tok * 2] = w0; tok_w[tok * 2 + 1] = w1; tok_rstd[tok] = rstd * amax * (1.f / 127.f);
            }
        }
        first = false;
        __syncthreads();
        int my_e = 0, my_rank = 0;
        if (tid < 256) { my_e = asg[tid];
            for (int ee = 0; ee < 32; ++ee) { const unsigned long long mk = __ballot(my_e == ee);
                if (my_e == ee) my_rank = __popcll(mk & ((1ull << lane) - 1ull));
                if (lane == 0) rnk[wave * 32 + ee] = __popcll(mk); } }
        __syncthreads();
        if (tid < 256) { int base = 0;
            for (int w = 0; w < wave; ++w) base += rnk[w * 32 + my_e];
            const int tok = chunk * 128 + (tid >> 1); tok_e[tok * 2 + (tid & 1)] = my_e; tok_rank[tok * 2 + (tid & 1)] = base + my_rank; }
        if (tid < 32) ccnt[chunk * 32 + tid] = rnk[tid] + rnk[32 + tid] + rnk[64 + tid] + rnk[96 + tid];
        __syncthreads();
    }
}

DI void moe_weight_convert(const Args& a, int cw, int NCW, int lane) {
    unsigned char* ws = a.ws;
    unsigned char* WGU = ws + WS_WGU; bf16_t* WD = (bf16_t*)(ws + WS_WD); float* SB = (float*)(ws + WS_SB);
    const float* wg = (const float*)a.in[I_WGATE]; const float* wu = (const float*)a.in[I_WUP]; const float* wd = (const float*)a.in[I_WDOWN]; const float* gf = (const float*)a.in[I_GFFN];
    constexpr int I_GU = 32 * 128, I_D = 32 * 8 * 32;
    for (int it = cw; it < I_GU + I_D; it += NCW) {
        if (it < I_GU) { const int e = it >> 7, nb8 = it & 127;
            const int t = nb8 >> 5, c = (nb8 & 31) * 8; const bool up = c >= 128; const int ff = 128 * t + (up ? c - 128 : c);
            quant_gu_item((up ? wu : wg) + (size_t)e * 1024 * 512, 512, ff, WGU + (size_t)e * 1024 * 1024, nb8 * 8, gf, SB + (size_t)e * 1024 + nb8 * 8, lane);
        } else { const int r2 = it - I_GU, e = r2 >> 8, r = r2 & 255, kb = r >> 5, nb = r & 31;
            transpose_item(wd + (size_t)e * 512 * 1024, 1024, kb * 64, nb * 32, WD + (size_t)e * 1024 * 512, 512, nb * 32, kb * 64, nullptr, nullptr, lane); }
    }
}

DI void phase7(const Args& a, LAS unsigned char* lds, int tid, int lane, int wave) {
    unsigned char* ws = a.ws;
    const int* tok_e = (const int*)(ws + WS_RT + RT_TOKE); const int* tok_rank = (const int*)(ws + WS_RT + RT_RANK); const float* tok_w = (const float*)(ws + WS_RT + RT_W);
    const float* tok_rstd = (const float*)(ws + WS_RT + RT_RSTD); const int* ccnt = (const int*)(ws + WS_RT + RT_CCNT); int* meta = (int*)(ws + WS_RT + RT_META);
    u32x2* sr_dw = (u32x2*)(ws + WS_SROW);
    int* rowtok = (int*)(ws + WS_SROW + 640 * 1024); float* sr_rstd = (float*)(ws + WS_SROW + 960 * 1024);
    LAS int* red = (LAS int*)lds;
    LAS int* tot = red + 1024;
    LAS int* bef = tot + 32;
    LAS int* pst = bef + 32;
    for (int chunk = blockIdx.x; chunk < NTOK / 128; chunk += gridDim.x) {
        { const int e = tid & 31, cgp = tid >> 5; int pt = 0, pb = 0;
          for (int c = cgp * 16; c < cgp * 16 + 16; ++c) { const int v = ccnt[c * 32 + e]; pt += v; if (c < chunk) pb += v; }
          red[cgp * 32 + e] = pt; red[512 + cgp * 32 + e] = pb; }
        __syncthreads();
        if (tid < 32) { int t = 0, b = 0; for (int q = 0; q < 16; ++q) { t += red[q * 32 + tid]; b += red[512 + q * 32 + tid]; } tot[tid] = t; bef[tid] = b; }
        __syncthreads();
        if (tid == 0) { int p = 0; for (int e = 0; e < 32; ++e) { pst[e] = p; p += (tot[e] + 255) & ~255; } pst[32] = p; }
        __syncthreads();
        if (lane < 16) {
            const int tokl = chunk * 128 + wave * 16 + lane;
            const int e0 = tok_e[tokl * 2], e1 = tok_e[tokl * 2 + 1], r0 = tok_rank[tokl * 2], r1 = tok_rank[tokl * 2 + 1];
            const float w0 = tok_w[tokl * 2], w1 = tok_w[tokl * 2 + 1], rs = tok_rstd[tokl];
            const int d0 = pst[e0] + bef[e0] + r0, d1 = pst[e1] + bef[e1] + r1;
            u32x2 r0v; r0v.x = (unsigned)(tokl * 2); r0v.y = __float_as_uint(w0); sr_dw[d0] = r0v; u32x2 r1v; r1v.x = (unsigned)(tokl * 2 + 1); r1v.y = __float_as_uint(w1); sr_dw[d1] = r1v;
            rowtok[d0] = tokl; rowtok[d1] = tokl; sr_rstd[d0] = rs; sr_rstd[d1] = rs;
        }
        if (chunk < 32) { const int e = chunk, p0 = pst[e], pe = pst[e + 1];
            for (int r = p0 + tot[e] + tid; r < pe; r += 512) { u32x2 z; z.x = 0xffffffffu; z.y = 0u; sr_dw[r] = z; rowtok[r] = 0; sr_rstd[r] = 0.f; } }
        if (chunk == 0) { const int nt = pst[32] >> 8; if (tid == 0) meta[0] = nt;
            for (int t = tid; t < nt; t += 512) { int e = 0; for (int q = 1; q < 32; ++q) if ((pst[q] >> 8) <= t) e = q; meta[1 + t] = e; } }
        __syncthreads();
    }
}

DI int load_tile_table(const Args& a, LAS unsigned char* lds, int tid) {
    const int* meta = (const int*)(a.ws + WS_RT + RT_META); LAS int* tbl = (LAS int*)(lds + MISC_OFF);
    const int nt = meta[0];
    for (int i = tid; i < nt; i += 512) tbl[i] = meta[1 + i];
    __syncthreads();
    return nt;
}

DI void phase10(const Args& a, int lane, int wave) {
    const bf16_t* Y = (const bf16_t*)(a.ws + WS_Y); const bf16_t* XB = (const bf16_t*)(a.ws + WS_XB); float* O = a.out;
    const int gw = blockIdx.x * 8 + wave, NGW = gridDim.x * 8;
    for (int tok = gw; tok < NTOK; tok += NGW) {
        u32x4 xv[2], y0[2], y1[2];
#pragma unroll
        for (int j = 0; j < 2; ++j) { const size_t c = (size_t)j * 512 + lane * 8;
            xv[j] = *(const u32x4*)(XB + (size_t)tok * 1024 + c); y0[j] = *(const u32x4*)(Y + (size_t)(tok * 2) * 1024 + c); y1[j] = *(const u32x4*)(Y + (size_t)(tok * 2 + 1) * 1024 + c); }
#pragma unroll
        for (int j = 0; j < 2; ++j) { const size_t c = (size_t)j * 512 + lane * 8;
            f32x4 o0, o1;
            o0.x = bf_lo(xv[j].x) + bf_lo(y0[j].x) + bf_lo(y1[j].x); o0.y = bf_hi(xv[j].x) + bf_hi(y0[j].x) + bf_hi(y1[j].x);
            o0.z = bf_lo(xv[j].y) + bf_lo(y0[j].y) + bf_lo(y1[j].y); o0.w = bf_hi(xv[j].y) + bf_hi(y0[j].y) + bf_hi(y1[j].y);
            o1.x = bf_lo(xv[j].z) + bf_lo(y0[j].z) + bf_lo(y1[j].z); o1.y = bf_hi(xv[j].z) + bf_hi(y0[j].z) + bf_hi(y1[j].z);
            o1.z = bf_lo(xv[j].w) + bf_lo(y0[j].w) + bf_lo(y1[j].w); o1.w = bf_hi(xv[j].w) + bf_hi(y0[j].w) + bf_hi(y1[j].w);
            __builtin_nontemporal_store(o0, (f32x4*)(O + (size_t)tok * 1024 + c)); __builtin_nontemporal_store(o1, (f32x4*)(O + (size_t)tok * 1024 + c + 4)); }
    }
}

#define VM_WAIT() asm volatile("s_waitcnt vmcnt(0)" ::: "memory")
#define XB_TMO      128
#define XB_XCNT(j)  (256  + 64 * (j))
#define XB_XSUB(j)  (1280 + 64 * (j))
#define XB_XGEN(j)  (2304 + 64 * (j))
#define XB_TOP      3328
#define XB_TOPGEN   3392
#define XCD_BAR_WORDS 3456
#define XB_SPIN_CAP (1u << 18)

__device__ __forceinline__ unsigned xb_ld(unsigned* p)              { return __hip_atomic_load(p, __ATOMIC_RELAXED, __HIP_MEMORY_SCOPE_AGENT); }
__device__ __forceinline__ unsigned xb_add(unsigned* p, unsigned v) { return __hip_atomic_fetch_add(p, v, __ATOMIC_RELAXED, __HIP_MEMORY_SCOPE_AGENT); }
__device__ __forceinline__ unsigned xb_xcc_id() { return (unsigned)__builtin_amdgcn_s_getreg((3 << 11) | 20) & 0xFu; }
#define XB_SPIN(cond, bar) do { unsigned _sp = 0; while (cond) { __builtin_amdgcn_s_sleep(1); \
    if ((++_sp & 255u) == 0u) { if (xb_ld(&(bar)[XB_TMO])) break; if (_sp > XB_SPIN_CAP) { atomicAdd(&(bar)[XB_TMO], 1u); break; } } } } while (0)

struct XcdBarrier {
    unsigned* bar; unsigned x;
    volatile LAS unsigned* st;
};

__device__ __forceinline__ XcdBarrier xcd_barrier_post(unsigned* bar, volatile LAS unsigned* st) {
    XcdBarrier b; b.bar = bar; b.x = xb_xcc_id(); b.st = st;
    if (threadIdx.x == 0) (void)xb_add(&bar[XB_XCNT(b.x)], 1u);
    return b;
}
__device__ __forceinline__ void xcd_barrier_complete(unsigned* bar, unsigned x, unsigned& nloc, unsigned& nx) {
    const unsigned G = gridDim.x * gridDim.y * gridDim.z;
    unsigned sum, cnt, mine, sp = 0u;
    for (;;) {
        sum = 0u; cnt = 0u; mine = 0u;
#pragma unroll
        for (unsigned j = 0; j < 16; ++j) { const unsigned c = xb_ld(&bar[XB_XCNT(j)]); sum += c; cnt += (c > 0u) ? 1u : 0u; mine = (j == x) ? c : mine; }
        if (sum == G) break;
        __builtin_amdgcn_s_sleep(1);
        if ((++sp & 255u) == 0u) { if (xb_ld(&bar[XB_TMO])) break; if (sp > XB_SPIN_CAP) { atomicAdd(&bar[XB_TMO], 1u); break; } }
    }
    nloc = mine > 0u ? mine : 1u; nx = cnt > 0u ? cnt : 1u;
}

__device__ __forceinline__ void xcd_barrier(const XcdBarrier& b) {
    asm volatile("s_waitcnt vmcnt(0)" ::: "memory");
    __syncthreads();
    if (threadIdx.x == 0) {
        unsigned* bar = b.bar;
        __builtin_amdgcn_s_waitcnt(0);
        unsigned nloc = b.st[0], nx = b.st[1];
        if (nloc == 0u) { xcd_barrier_complete(bar, b.x, nloc, nx); b.st[0] = nloc; b.st[1] = nx; }
        const unsigned old = xb_add(&bar[XB_XSUB(b.x)], 1u);
        const unsigned gen = old / nloc;
        if (old + 1u == (gen + 1u) * nloc) {
            __builtin_amdgcn_fence(__ATOMIC_RELEASE, "agent");
            asm volatile("s_waitcnt vmcnt(0)" ::: "memory");
            const unsigned og = xb_add(&bar[XB_TOP], 1u);
            const unsigned tg = og / nx;
            if (og + 1u == (tg + 1u) * nx) xb_add(&bar[XB_TOPGEN], 1u);
            else XB_SPIN(xb_ld(&bar[XB_TOPGEN]) == tg, bar);
            __builtin_amdgcn_fence(__ATOMIC_ACQUIRE, "agent");
            xb_add(&bar[XB_XGEN(b.x)], 1u);
            asm volatile("s_waitcnt vmcnt(0)" ::: "memory");
        } else {
            XB_SPIN(xb_ld(&bar[XB_XGEN(b.x)]) == gen, bar);
            __builtin_amdgcn_fence(__ATOMIC_ACQUIRE, "agent");
            asm volatile("s_waitcnt vmcnt(0)" ::: "memory");
        }
    }
    __syncthreads();
}

constexpr int N_PHASES = 11;
template <int K> DI void run_phase(const Args& a, LAS unsigned char* lds) {
    int tid = threadIdx.x; asm volatile("" : "+v"(tid));
    const int lane = tid & 63, wave = __builtin_amdgcn_readfirstlane(tid >> 6);
    unsigned char* ws = a.ws; unsigned char* dob = (unsigned char*)a.out; const int G = gridDim.x;
    if constexpr (K == 0) { phase0(a, lds, tid, lane, wave); }
    if constexpr (K == 1) {
        pg8::Gemm g{(const pg8::bf16_t*)(dob + DO_A8), (const pg8::bf16_t*)(ws + WS_WIN), NTOK + NMROW, 9216, 512};
        InOrder S; S.so.init(NTOK, 5120, G, (int)blockIdx.x); S.nmain = (NTOK / 256) * 20;
        EpiIn E{ws, (bf16_t*)(dob + DO_QM), (bf16_t*)(dob + DO_KM), (const float*)a.in[I_GQA], (const float*)a.in[I_GKA], (const _Float16*)(ws + WS_ROPE), (const float*)(ws + WS_SH), (const float*)(ws + WS_SW)};
        pg8::gemm_phase<EpiIn, InOrder, true, true, true>(lds, g, S, E);
        {
            const int total = S.nmain + 64, rounds = (total + G - 1) / G, busy = total - (rounds - 1) * G;
            if ((int)blockIdx.x >= busy) moe_weight_convert(a, ((int)blockIdx.x - busy) * 8 + wave, (G - busy) * 8, lane);
            else if (busy == G) moe_weight_convert(a, (int)blockIdx.x * 8 + wave, G * 8, lane);
        }
    }
    if constexpr (K == 2) { phase2(a, lds, tid, lane, wave); }
    if constexpr (K == 3) {
        pg8::Gemm g{(const pg8::bf16_t*)(dob + DO_A8), (const pg8::bf16_t*)(ws + WS_WIN + (size_t)5120 * 1024), NTOK, 3072, 512};
        pg8::StaticOrder S; S.init(NTOK, 3072, G, (int)blockIdx.x);
        EpiGate E{(unsigned char*)(ws + WS_G), 3072, (const float*)(ws + WS_SH), (const float*)(ws + WS_SW) + 5120};
        pg8::gemm_phase<EpiGate, pg8::StaticOrder, true, true, true>(lds, g, S, E);
        attn_combine(a, tid);
    }
    if constexpr (K == 4) {
        pg8::Gemm g{(const pg8::bf16_t*)(ws + WS_AM), (const pg8::bf16_t*)(ws + WS_WMRG), NTOK, 1024, 1536};
        pg8::StaticOrder S; S.init(NTOK, 1024, G, (int)blockIdx.x);
        EpiMerge E{(const unsigned char*)(ws + WS_G), (bf16_t*)(ws + WS_MRG), 4, 16};
        pg8::gemm_phase<EpiMerge, pg8::StaticOrder, true, true>(lds, g, S, E);
    }
    if constexpr (K == 5) {
        pg8::Gemm g{(const pg8::bf16_t*)(ws + WS_MRG), (const pg8::bf16_t*)(ws + WS_WOUT), NTOK, 1024, 1024};
        pg8::StaticOrder S; S.init(NTOK, 1024, G, (int)blockIdx.x);
        EpiOut E{(const float*)a.in[I_X], a.out, (bf16_t*)(ws + WS_XB)};
        pg8::gemm_phase<EpiOut, pg8::StaticOrder, true, true>(lds, g, S, E);
    }
    if constexpr (K == 6) { phase6(a, lds, tid, lane, wave); }
    if constexpr (K == 7) { phase7(a, lds, tid, lane, wave); }
    if constexpr (K == 8) {
        const int nt = load_tile_table(a, lds, tid);
        LAS int* rowtab = (LAS int*)(lds + MISC_OFF + 1536);
        MoeOrder<true> S{(const LAS int*)(lds + MISC_OFF), nt, G, (int)blockIdx.x, rowtab};
        { const int* rowtok = (const int*)(ws + WS_SROW + 640 * 1024); Unit uu;
          for (int ui = 0; ui < 6; ++ui) { if (!S.next(ui, uu)) break; if (tid < 256) rowtab[ui * 256 + tid] = rowtok[uu.pm * 256 + tid]; } }
        __syncthreads();
        pg8::Gemm g{(const pg8::bf16_t*)(ws + WS_XB8), (const pg8::bf16_t*)(ws + WS_WGU), nt * 256, 1024, 512};
        EpiUp E{(const float*)(ws + WS_SROW + 960 * 1024), (const float*)(ws + WS_SB), (bf16_t*)(ws + WS_ACT)};
        pg8::gemm_phase<EpiUp, MoeOrder<true>, true, true, true>(lds, g, S, E);
    }
    if constexpr (K == 9) {
        const int nt = load_tile_table(a, lds, tid);
        pg8::Gemm g{(const pg8::bf16_t*)(ws + WS_ACT), (const pg8::bf16_t*)(ws + WS_WD), nt * 256, 1024, 512};
        MoeOrder<false> S{(const LAS int*)(lds + MISC_OFF), nt, G, (int)blockIdx.x, nullptr};
        EpiDown E{(const u32x2*)(ws + WS_SROW), (bf16_t*)(ws + WS_Y)};
        pg8::gemm_phase<EpiDown, MoeOrder<false>, true, true>(lds, g, S, E);
    }
    if constexpr (K == 10) { phase10(a, lane, wave); }
}

#ifndef PH_MASK
#define PH_MASK 0x7ff
#endif
#ifndef USE_CG_SEAM0
#define USE_CG_SEAM0 0
#endif
#ifndef REP_MASK
#define REP_MASK 0x000
#endif
__global__ void __launch_bounds__(512, 2) mk_fwd(Args a) {
    extern __shared__ __attribute__((aligned(16))) unsigned char lds_raw[];
    LAS unsigned char* lds = (LAS unsigned char*)lds_raw;
    const int tid = threadIdx.x;
    const int lo = a.ph_lo, hi = a.ph_hi;
    cg::grid_group grid = cg::this_grid();
    volatile LAS unsigned* bst = (volatile LAS unsigned*)(lds + MISC_OFF + 8192);
    if (tid < 2) bst[tid] = 0u;
    __syncthreads();
    XcdBarrier bar = xcd_barrier_post((unsigned*)(a.ws + WS_CTL) + 1024, bst);
#define IN(k) ((((PH_MASK) >> (k)) & 1) && lo <= (k) && (k) < hi)
#define RUN(k) do { if (IN(k)) { run_phase<k>(a, lds); if constexpr (((REP_MASK) >> (k)) & 1) { __syncthreads(); run_phase<k>(a, lds); } } \
                    if (IN(k) && IN((k) + 1)) { if (USE_CG_SEAM0 && (k) == 0) grid.sync(); else xcd_barrier(bar); } } while (0)
    RUN(0); RUN(1); RUN(2); RUN(3); RUN(4); RUN(5); RUN(6);
    RUN(7); RUN(8); RUN(9); RUN(10);
#undef IN
#undef RUN
}

#ifndef MK_MULTI
#define MK_MULTI 0
#endif
extern "C" void kernel_launch(void* const* d_in, const int* in_sizes, int n_in, void* d_out, int out_size, void* d_ws, size_t ws_size, hipStream_t stream) {
    static int grid = 0;
    if (grid == 0) {
        if (n_in != 24 || out_size != NTOK * DM || ws_size < WS_NEED) { fprintf(stderr, "kernel_launch: unexpected shapes (n_in %d, out %d, ws %zu)\n", n_in, out_size, ws_size); grid = -1; return; }
        int dev = 0, cus = 0, per_cu = 0;
        (void)hipGetDevice(&dev); (void)hipDeviceGetAttribute(&cus, hipDeviceAttributeMultiprocessorCount, dev);
        (void)hipFuncSetAttribute((const void*)mk_fwd, hipFuncAttributeMaxDynamicSharedMemorySize, LDS_BYTES);
        (void)hipOccupancyMaxActiveBlocksPerMultiprocessor(&per_cu, (const void*)mk_fwd, 512, LDS_BYTES);
        (void)hipGetLastError();
        if (per_cu < 1) { fprintf(stderr, "kernel_launch: occupancy query says %d blocks per CU: this kernel cannot be made resident, nothing launched\n", per_cu); grid = -1; return; }
        grid = cus;
    }
    if (grid < 0) return;
    Args a{};
    for (int i = 0; i < 24; ++i) a.in[i] = d_in[i];
    a.out = (float*)d_out; a.ws = (unsigned char*)d_ws;
#if MK_MULTI
    for (int p = 0; p < N_PHASES; ++p) { a.ph_lo = p; a.ph_hi = p + 1; hipLaunchKernelGGL(mk_fwd, dim3(grid), dim3(512), LDS_BYTES, stream, a); }
#else
    a.ph_lo = 0; a.ph_hi = N_PHASES;
    if (hipMemsetAsync((char*)d_ws + WS_CTL, 0, CTL_BYTES, stream) != hipSuccess) { fprintf(stderr, "kernel_launch: memset failed\n"); return; }
    void* args[] = {&a};
    hipError_t e = hipLaunchCooperativeKernel((const void*)mk_fwd, dim3(grid), dim3(512), args, LDS_BYTES, stream);
    if (e != hipSuccess) fprintf(stderr, "cooperative launch failed: %s (grid %d)\n", hipGetErrorString(e), grid);
#endif
}
```

```cpp
#include <hip/hip_runtime.h>
#include <hip/hip_cooperative_groups.h>
#include <cstdio>
#include <cstdint>
namespace cg = cooperative_groups;
#define GATE_NT 1
namespace pg8 {
#define PG8_LAS __attribute__((address_space(3)))
typedef unsigned short bf16_t;
typedef short bf16x8 __attribute__((ext_vector_type(8)));
typedef float f32x4 __attribute__((ext_vector_type(4)));
typedef unsigned u32x4 __attribute__((ext_vector_type(4)));
constexpr int BM = 256, BK = 64, HALF = 128, HTB = HALF * BK * 2  , STAGE_BYTES = 8 * HTB, NXCD = 8, WGM = 8;

__host__ __device__ __forceinline__ int lds_byte(int r, int c) { const int st = (r >> 4) * 2 + (c >> 5), rr = r & 15, cc = c & 31, ob = rr * 64 + cc * 2; return st * 1024 + (ob ^ (((ob >> 9) & 1) << 5)); }
__host__ __device__ __forceinline__ void stage_rc(int b, int& R, int& C) { const int st = b / 1024, sb = b % 1024, swz = sb ^ (((sb >> 9) & 1) << 5); R = (st >> 1) * 16 + swz / 64; C = (st & 1) * 32 + (swz % 64) / 2; }
__host__ __device__ __forceinline__ int perm32(int rho) { const int n = rho >> 4, i = rho & 15; return 8 * (i >> 2) + 4 * n + (i & 3); }

struct Unit { int pm, pn, aux, sb, nv; };
struct Gemm { const bf16_t* A; const bf16_t* Bt; int M, N, K; };

struct StaticOrder {
    static constexpr bool GATHER = false; __device__ __forceinline__ int row(int, int) const { return 0; }
    int nM, nN, nwg, G, c;
    __host__ __device__ void init(int M, int N, int G_, int c_) { nM = M / BM; nN = N / BM; nwg = nM * nN; G = G_; c = c_; }
    __host__ __device__ bool next(int i, Unit& u) const {
        const long L = (long)i * G + c; if (L >= nwg) return false;
        int wgid = (int)L; { const int q = nwg / NXCD, r = nwg % NXCD, xcd = wgid % NXCD, off = wgid / NXCD; wgid = (xcd < r ? xcd * (q + 1) : r * (q + 1) + (xcd - r) * q) + off; }
        const int nig = WGM * nN, gid = wgid / nig, fm = gid * WGM, gsz = (nM - fm) < WGM ? (nM - fm) : WGM;
        u.pm = fm + ((wgid % nig) % gsz); u.pn = (wgid % nig) / gsz; u.aux = u.pn; return true;
    }
    __device__ __forceinline__ void a_ready(const Unit&) const {}
    __device__ __forceinline__ void done(const Unit&) const {}
};

__device__ __forceinline__ unsigned cvt_pk_bf16(float lo, float hi) { unsigned r; asm volatile("v_cvt_pk_bf16_f32 %0, %1, %2" : "=v"(r) : "v"(lo), "v"(hi)); return r; }
template <class Epi, class Sched, bool ALIGN_EPI = false, bool SP2 = false, bool I8 = false>
__device__ __forceinline__ void gemm_phase(PG8_LAS unsigned char* lds, const Gemm g, const Sched& S, const Epi& E) {
    const int tid = threadIdx.x, wid = __builtin_amdgcn_readfirstlane(tid >> 6), lane = tid & 63, wr = wid >> 2, wc = wid & 3, fr = lane & 15, fq = lane >> 4;
    const int K = g.K, nt = K / BK;
    unsigned voffA[2], voffB[2];
    constexpr bool GATHER = Sched::GATHER;
    static_assert(!GATHER || SP2, "gather is implemented for the SP2 loop");
    unsigned gA[2][2], gN[2][2];
#pragma unroll
    for (int i = 0; i < 2; ++i) { int R, C; stage_rc(tid * 16 + i * 8192, R, C); const int Rb = Epi::PERM ? ((R & ~31) + perm32(R & 31)) : R;
        voffA[i] = (unsigned)(R * K + C) * 2u; voffB[i] = (unsigned)(Rb * K + C) * 2u; }
#define PG8_ROWS(dst, ui_) do { _Pragma("unroll") for (int h_ = 0; h_ < 2; ++h_) _Pragma("unroll") for (int i_ = 0; i_ < 2; ++i_) { int R_, C_; stage_rc(tid * 16 + i_ * 8192, R_, C_); \
        dst[h_][i_] = (unsigned)S.row(ui_, h_ * HALF + R_) * (unsigned)(K * 2) + (unsigned)(C_ * 2); } } while (0)
    const size_t kstep = (size_t)(BK * 2);
    const size_t hstep = (size_t)HALF * K * 2;
    const size_t hstepA = GATHER ? (size_t)0 : hstep;
    const size_t tstep = 2 * hstep;
    const unsigned ldsw = (unsigned)wid * 1024u;
    const int aoff = lds_byte(wr * 64 + fr, fq * 8), boff = lds_byte(wc * 32 + fr, fq * 8);
#define PG8_SA(b, h) (((b) * 2 + (h)) * HTB)
#define PG8_SB(b, h) ((4 + (b) * 2 + (h)) * HTB)
#define PG8_STAGE(bufoff, gbase, voff) do { _Pragma("unroll") for (int _i = 0; _i < 2; ++_i) \
        __builtin_amdgcn_global_load_lds((const unsigned*)((const char*)(gbase) + (voff)[_i]), (PG8_LAS unsigned*)(lds + (bufoff) + ldsw + _i * 8192), 16, 0, 0); } while (0)
#define PG8_LDA(dst, b, h) do { _Pragma("unroll") for (int m = 0; m < 4; ++m) _Pragma("unroll") for (int k = 0; k < 2; ++k) dst[m][k] = *(const PG8_LAS bf16x8*)(lds + PG8_SA(b, h) + aoff + m * 2048 + k * 1024); } while (0)
#define PG8_LDB(dst, b, h) do { _Pragma("unroll") for (int n = 0; n < 2; ++n) _Pragma("unroll") for (int k = 0; k < 2; ++k) dst[n][k] = *(const PG8_LAS bf16x8*)(lds + PG8_SB(b, h) + boff + n * 2048 + k * 1024); } while (0)
typedef int pg8_i32x4 __attribute__((ext_vector_type(4)));
#define PG8_MMA(ai, bj, At, Bt) do { __builtin_amdgcn_s_setprio(1); _Pragma("unroll") for (int m = 0; m < 4; ++m) _Pragma("unroll") for (int n = 0; n < 2; ++n) _Pragma("unroll") for (int k = 0; k < 2; ++k) { \
        if constexpr (I8) acc[ai][bj][m][n] = __builtin_bit_cast(f32x4, __builtin_amdgcn_mfma_i32_16x16x64_i8(__builtin_bit_cast(pg8_i32x4, Bt[n][k]), __builtin_bit_cast(pg8_i32x4, At[m][k]), __builtin_bit_cast(pg8_i32x4, acc[ai][bj][m][n]), 0, 0, 0)); \
        else acc[ai][bj][m][n] = __builtin_amdgcn_mfma_f32_16x16x32_bf16(Bt[n][k], At[m][k], acc[ai][bj][m][n], 0, 0, 0); } \
        __builtin_amdgcn_s_setprio(0); } while (0)
#define PG8_WAIT_V(n) asm volatile("s_waitcnt vmcnt(" #n ")" ::: "memory")
#define PG8_WAIT_L(n) asm volatile("s_waitcnt lgkmcnt(" #n ")" ::: "memory")
#define PG8_BAR __builtin_amdgcn_s_barrier()
#define PG8_SCHED __builtin_amdgcn_sched_barrier(0)
#ifdef TPROBE_SEG
    unsigned long long tseg_ = 0;
#endif
    Unit cur, nxt; int ui = 0;
    if (!S.next(0, cur)) return;
    f32x4 acc[2][2][4][2];
#pragma unroll
    for (int a = 0; a < 2; ++a)
#pragma unroll
        for (int b = 0; b < 2; ++b)
#pragma unroll
            for (int m = 0; m < 4; ++m)
#pragma unroll
                for (int n = 0; n < 2; ++n) acc[a][b][m][n] = (f32x4){0.f, 0.f, 0.f, 0.f};
    bf16x8 At[4][2], B0[2][2], B1[2][2];
    const char* cA = (const char*)g.A + (GATHER ? (size_t)0 : (size_t)cur.pm * tstep); const char* cB = (const char*)g.Bt + (size_t)cur.pn * tstep;
    if constexpr (GATHER) { PG8_ROWS(gA, 0); PG8_ROWS(gN, 0); }
#define PG8_OA(h) (GATHER ? gA[h] : voffA)
    S.a_ready(cur);
    if constexpr (SP2) {
        PG8_STAGE(PG8_SB(0, 0), cB, voffB); PG8_STAGE(PG8_SB(0, 1), cB + hstep, voffB); PG8_STAGE(PG8_SA(0, 0), cA, PG8_OA(0)); PG8_STAGE(PG8_SA(0, 1), cA + hstepA, PG8_OA(1));
        if (wr == 1) PG8_BAR;
        PG8_WAIT_V(2); PG8_BAR;
        PG8_STAGE(PG8_SB(1, 0), cB + kstep, voffB); PG8_STAGE(PG8_SA(1, 0), cA + kstep, PG8_OA(0)); PG8_STAGE(PG8_SB(1, 1), cB + hstep + kstep, voffB);
        PG8_WAIT_V(6); PG8_BAR;
    } else {
        PG8_STAGE(PG8_SB(0, 0), cB, voffB); PG8_STAGE(PG8_SA(0, 0), cA, voffA); PG8_STAGE(PG8_SB(0, 1), cB + hstep, voffB); PG8_STAGE(PG8_SA(0, 1), cA + hstep, voffA);
        if (wr == 1) PG8_BAR;
        PG8_WAIT_V(4); PG8_BAR;
        PG8_STAGE(PG8_SB(1, 0), cB + kstep, voffB); PG8_STAGE(PG8_SA(1, 0), cA + kstep, voffA); PG8_STAGE(PG8_SB(1, 1), cB + hstep + kstep, voffB);
        PG8_WAIT_V(6); PG8_BAR;
    }
    for (;;) {
        const bool has_next = S.next(ui + 1, nxt);
        const char* nA = (has_next && !GATHER) ? (const char*)g.A + (size_t)nxt.pm * tstep : cA; const char* nB = has_next ? (const char*)g.Bt + (size_t)nxt.pn * tstep : cB;
        if constexpr (GATHER) { if (has_next) PG8_ROWS(gN, ui + 1); }
#pragma unroll 1
        for (int t = 0; t < nt; t += 2) {
            const bool last = (t == nt - 2);
            const char* a1 = cA + (size_t)(t + 1) * kstep;
            const char* a2 = last ? nA : cA + (size_t)(t + 2) * kstep; const char* b2 = last ? nB : cB + (size_t)(t + 2) * kstep;
            const char* a3 = a2 + kstep; const char* b3 = b2 + kstep;
            if (last && has_next) S.a_ready(nxt);
#ifdef TPROBE_SEG
            if constexpr (Epi::HAS_MID) { if (tid == 0) { const unsigned long long now_ = __builtin_amdgcn_s_memrealtime();
                if (t == 0) tseg_ = now_;
                if ((TPROBE_SEG) == 0 && t == E.mid0) ((volatile PG8_LAS unsigned*)(lds + 131072 + 8192))[2] += (unsigned)(now_ - tseg_);
                if ((TPROBE_SEG) == 1 && t == E.mid0) tseg_ = now_;
                if ((TPROBE_SEG) == 1 && t == E.mid1) ((volatile PG8_LAS unsigned*)(lds + 131072 + 8192))[2] += (unsigned)(now_ - tseg_);
                if ((TPROBE_SEG) == 2 && t == E.mid1) tseg_ = now_; } }
#endif
#ifdef TPROBE_MID
            if constexpr (Epi::HAS_MID) { if (t == E.mid0 || t == E.mid1) { unsigned long long tm0_ = 0; if (tid == 0) tm0_ = __builtin_amdgcn_s_memrealtime(); E.mid(acc, cur, t, wr, wc, fr, fq);
                if (tid == 0) ((volatile PG8_LAS unsigned*)(lds + 131072 + 8192))[2] += (unsigned)(__builtin_amdgcn_s_memrealtime() - tm0_); } }
#else
            if constexpr (Epi::HAS_MID) { if (t == E.mid0 || t == E.mid1) E.mid(acc, cur, t, wr, wc, fr, fq); }
#endif
            if constexpr (SP2) {
            unsigned on0[2], on1[2];
            on0[0] = GATHER ? (last ? gN[0][0] : gA[0][0]) : voffA[0]; on0[1] = GATHER ? (last ? gN[0][1] : gA[0][1]) : voffA[1];
            on1[0] = GATHER ? (last ? gN[1][0] : gA[1][0]) : voffA[0]; on1[1] = GATHER ? (last ? gN[1][1] : gA[1][1]) : voffA[1];
            PG8_LDB(B0, 0, 0); PG8_LDB(B1, 0, 1); PG8_SCHED; PG8_LDA(At, 0, 0); PG8_STAGE(PG8_SA(1, 1), a1 + hstepA, PG8_OA(1));
            PG8_WAIT_V(8); PG8_WAIT_L(0); PG8_BAR; PG8_MMA(0, 0, At, B0); PG8_MMA(0, 1, At, B1); PG8_BAR; PG8_SCHED;
            PG8_LDA(At, 0, 1); PG8_STAGE(PG8_SB(0, 0), b2, voffB); PG8_STAGE(PG8_SB(0, 1), b2 + hstep, voffB); PG8_STAGE(PG8_SA(0, 0), a2, on0);
            PG8_WAIT_V(8); PG8_WAIT_L(0); PG8_BAR; PG8_MMA(1, 0, At, B0); PG8_MMA(1, 1, At, B1); PG8_BAR; PG8_SCHED;
            PG8_LDB(B0, 1, 0); PG8_LDB(B1, 1, 1); PG8_SCHED; PG8_LDA(At, 1, 0); PG8_STAGE(PG8_SA(0, 1), a2 + hstepA, on1);
            PG8_WAIT_V(8); PG8_WAIT_L(0); PG8_BAR; PG8_MMA(0, 0, At, B0); PG8_MMA(0, 1, At, B1); PG8_BAR; PG8_SCHED;
            PG8_LDA(At, 1, 1); PG8_STAGE(PG8_SB(1, 0), b3, voffB); PG8_STAGE(PG8_SB(1, 1), b3 + hstep, voffB); PG8_STAGE(PG8_SA(1, 0), a3, on0);
            PG8_WAIT_V(8); PG8_WAIT_L(0); PG8_BAR; PG8_MMA(1, 0, At, B0); PG8_MMA(1, 1, At, B1); PG8_BAR; PG8_SCHED;
            } else {
            PG8_LDB(B0, 0, 0); PG8_SCHED; PG8_LDA(At, 0, 0); PG8_STAGE(PG8_SA(1, 1), a1 + hstep, voffA);
            PG8_WAIT_L(8); PG8_BAR; PG8_WAIT_L(0); PG8_MMA(0, 0, At, B0); PG8_BAR; PG8_SCHED;
            PG8_LDB(B1, 0, 1); PG8_STAGE(PG8_SB(0, 0), b2, voffB);
            PG8_BAR; PG8_WAIT_L(0); PG8_MMA(0, 1, At, B1); PG8_BAR;
            PG8_LDA(At, 0, 1); PG8_STAGE(PG8_SA(0, 0), a2, voffA);
            PG8_BAR; PG8_WAIT_L(0); PG8_MMA(1, 0, At, B0); PG8_BAR; PG8_SCHED;
            PG8_STAGE(PG8_SB(0, 1), b2 + hstep, voffB);
            PG8_WAIT_V(6); PG8_BAR; PG8_MMA(1, 1, At, B1); PG8_BAR;
            PG8_LDB(B0, 1, 0); PG8_SCHED; PG8_LDA(At, 1, 0); PG8_STAGE(PG8_SA(0, 1), a2 + hstep, voffA);
            PG8_WAIT_L(8); PG8_BAR; PG8_WAIT_L(0); PG8_MMA(0, 0, At, B0); PG8_BAR; PG8_SCHED;
            PG8_LDB(B1, 1, 1); PG8_STAGE(PG8_SB(1, 0), b3, voffB);
            PG8_BAR; PG8_WAIT_L(0); PG8_MMA(0, 1, At, B1); PG8_BAR;
            PG8_LDA(At, 1, 1); PG8_STAGE(PG8_SA(1, 0), a3, voffA);
            PG8_BAR; PG8_WAIT_L(0); PG8_MMA(1, 0, At, B0); PG8_BAR; PG8_SCHED;
            PG8_STAGE(PG8_SB(1, 1), b3 + hstep, voffB);
            PG8_WAIT_V(6); PG8_BAR; PG8_MMA(1, 1, At, B1); PG8_BAR;
            }
        }
#ifdef TPROBE_SEG
        if constexpr (Epi::HAS_MID) { if ((TPROBE_SEG) == 2 && tid == 0) ((volatile PG8_LAS unsigned*)(lds + 131072 + 8192))[2] += (unsigned)(__builtin_amdgcn_s_memrealtime() - tseg_); }
#endif
        if constexpr (ALIGN_EPI) { if (wr == 0) PG8_BAR; }
#ifdef TPROBE_EPI
        unsigned long long te0_ = 0; if constexpr (Epi::PID == (TPROBE_EPI)) { if (tid == 0) te0_ = __builtin_amdgcn_s_memrealtime(); }
#endif
        if constexpr (!Epi::AFTER_DRAIN) { E(acc, cur, wr, wc, fr, fq); S.done(cur); }
#ifdef TPROBE_EPI
        if constexpr (Epi::PID == (TPROBE_EPI)) { if (TPROBE_DRAIN) asm volatile("s_waitcnt vmcnt(0)" ::: "memory"); if (tid == 0) ((volatile PG8_LAS unsigned*)(lds + 131072 + 8192))[2] += (unsigned)(__builtin_amdgcn_s_memrealtime() - te0_); }
#endif
        if (!has_next) break;
#pragma unroll
        for (int a = 0; a < 2; ++a)
#pragma unroll
            for (int b = 0; b < 2; ++b)
#pragma unroll
                for (int m = 0; m < 4; ++m)
#pragma unroll
                    for (int n = 0; n < 2; ++n) acc[a][b][m][n] = (f32x4){0.f, 0.f, 0.f, 0.f};
        cur = nxt; cA = nA; cB = nB; ++ui;
        if constexpr (GATHER) { _Pragma("unroll") for (int h_ = 0; h_ < 2; ++h_) _Pragma("unroll") for (int i_ = 0; i_ < 2; ++i_) gA[h_][i_] = gN[h_][i_]; }
        if constexpr (ALIGN_EPI) { if (wr == 1) PG8_BAR; }
    }
    PG8_WAIT_V(0);
    if constexpr (!ALIGN_EPI) { if (wr == 0) PG8_BAR; }
    PG8_BAR;
    if constexpr (Epi::AFTER_DRAIN) { E.fused(acc, cur, wr, wc, fr, fq, lds, wid, lane); S.done(cur); }
#undef PG8_SA
#undef PG8_OA
#undef PG8_ROWS
#undef PG8_SB
#undef PG8_STAGE
#undef PG8_LDA
#undef PG8_LDB
#undef PG8_MMA
#undef PG8_WAIT_V
#undef PG8_WAIT_L
#undef PG8_BAR
#undef PG8_SCHED
}
}

#define DI __device__ __forceinline__
#define LAS __attribute__((address_space(3)))
typedef unsigned short bf16_t;
typedef float f32x4 __attribute__((ext_vector_type(4)));
typedef float f32x2 __attribute__((ext_vector_type(2)));
typedef float f32x16 __attribute__((ext_vector_type(16)));
typedef unsigned u32x4 __attribute__((ext_vector_type(4)));
typedef unsigned u32x2 __attribute__((ext_vector_type(2)));
typedef short bf16x8 __attribute__((ext_vector_type(8)));
typedef short s16x4 __attribute__((ext_vector_type(4)));
typedef __bf16 bf16x2_t __attribute__((ext_vector_type(2)));
using pg8::Unit;

constexpr int NB = 16, SEQ = 2048, DM = 1024, NTOK = NB * SEQ, NMEM = 256, NMROW = NB * NMEM;
constexpr float EPS = 1e-6f, LOG2E = 1.4426950408889634f;
constexpr float QSCALE_A = 0.125f * LOG2E, QSCALE_M = 0.08838834764831845f * LOG2E;
constexpr int MAXROWS = 73728, MAXTILES = MAXROWS / 256;

constexpr size_t MiB = 1u << 20;
constexpr size_t WS_CTL = 0, CTL_BYTES = 64 * 1024;
constexpr size_t WS_WIN = 1 * MiB, WS_WMRG = 19 * MiB, WS_WOUT = 22 * MiB;
constexpr size_t WS_ROPE = 24 * MiB, WS_WRH = 26 * MiB, WS_WRL = WS_WRH + 128 * 1024;
constexpr size_t WS_RT = 27 * MiB;
constexpr size_t RT_TOKE = 0, RT_RANK = 256 * 1024, RT_W = 512 * 1024, RT_RSTD = 768 * 1024, RT_CCNT = 896 * 1024, RT_META = 960 * 1024;
constexpr size_t WS_WGU = 28 * MiB, WS_WD = 92 * MiB;
constexpr size_t WS_Q = 124 * MiB, WS_K = 172 * MiB, WS_V = 220 * MiB, WS_U = 268 * MiB, WS_CB = 316 * MiB;
constexpr size_t WS_AM = 364 * MiB, WS_PO = 460 * MiB, WS_LSE = 508 * MiB, WS_SROW = 510 * MiB;
constexpr int ECAP = NTOK;
constexpr size_t WS_SROWTOK = WS_PO, WS_SRSTD = WS_PO + (size_t)4 * 32 * ECAP, WS_SDW = WS_PO + (size_t)8 * 32 * ECAP;
constexpr size_t WS_G = 124 * MiB;
constexpr size_t WS_MRG = 220 * MiB, WS_XB = 284 * MiB;
constexpr size_t SR_RSTD = 0, SR_DEST = 320 * 1024, SR_W = 640 * 1024;
constexpr size_t WS_XB8 = 124 * MiB, WS_ACT = 348 * MiB, WS_Y = 124 * MiB;
constexpr size_t WS_SH = WS_WRH + 256 * 1024, WS_SW = WS_WRH + 640 * 1024;
constexpr size_t WS_SB = WS_WRH + 512 * 1024;
constexpr size_t WS_NEED = 512 * MiB;
constexpr size_t DO_A8 = 0, DO_QM = 72 * MiB, DO_KM = 104 * MiB, DO_VM = 108 * MiB;
constexpr int RING_BYTES = 131072, MISC_OFF = 131072, LDS_BYTES = 147456;

DI unsigned pk2(float lo, float hi) { f32x2 v = {lo, hi}; bf16x2_t b = __builtin_convertvector(v, bf16x2_t); return __builtin_bit_cast(unsigned, b); }
DI float bf_lo(unsigned u) { return __uint_as_float(u << 16); }
DI float bf_hi(unsigned u) { return __uint_as_float(u & 0xffff0000u); }
DI float bf2f(short s) { return __uint_as_float(((unsigned)(unsigned short)s) << 16); }
DI float fexp2(float x) { return __builtin_amdgcn_exp2f(x); }
DI float fexp(float x) { return __builtin_amdgcn_exp2f(x * LOG2E); }
DI float frcp(float x) { return __builtin_amdgcn_rcpf(x); }
DI u32x4 pack8(const f32x4& a, const f32x4& b) { u32x4 w; w.x = pk2(a.x, a.y); w.y = pk2(a.z, a.w); w.z = pk2(b.x, b.y); w.w = pk2(b.z, b.w); return w; }
DI f32x4 ldnt(const f32x4* p) { return __builtin_nontemporal_load(p); }
DI void st16(void* p, const u32x4& v) {
#ifdef P1_DEFAULT_ST
    *(u32x4*)p = v;
#else
    __builtin_nontemporal_store(v, (u32x4*)p);
#endif
}
DI void st16f(void* p, const f32x4& v) { __builtin_nontemporal_store(v, (f32x4*)p); }
DI void st8(void* p, const u32x2& v) { __builtin_nontemporal_store(v, (u32x2*)p); }
DI void st16d(void* p, const u32x4& v) { *(u32x4*)p = v; }
DI void st8d(void* p, const u32x2& v) { *(u32x2*)p = v; }
DI float h2f_lo(unsigned w) { return (float)__builtin_bit_cast(_Float16, (unsigned short)(w & 0xffffu)); }
DI float h2f_hi(unsigned w) { return (float)__builtin_bit_cast(_Float16, (unsigned short)(w >> 16)); }
DI int crow(int reg, int h) { return (reg & 3) + 8 * (reg >> 2) + 4 * h; }
DI float wave_sum(float v) {
#pragma unroll
    for (int o = 1; o < 64; o <<= 1) v += __shfl_xor(v, o);
    return v;
}
#define MFMA32(a, b, c) __builtin_amdgcn_mfma_f32_32x32x16_bf16((a), (b), (c), 0, 0, 0)
#define MFMA16(a, b, c) __builtin_amdgcn_mfma_f32_16x16x32_bf16((a), (b), (c), 0, 0, 0)

struct EpiIn {
    static constexpr int PID = 1; static constexpr bool PERM = true, AFTER_DRAIN = false, HAS_MID = false;
    unsigned char* wsb; bf16_t* QM; bf16_t* KMVM; const float *gq, *gk; const _Float16* cs; const float *sh, *sw;
    DI void operator()(const pg8::f32x4 (&acc)[2][2][4][2], const Unit& u, int wr, int wc, int fr, int fq) const {
        const int t = u.pn, row0 = u.pm * 256 + wr * 64 + fr;
        f32x4 sc[2][2];
        { const float* sp = sw + u.pn * 256 + wc * 32 + 8 * fq;
#pragma unroll
          for (int bj = 0; bj < 2; ++bj)
#pragma unroll
              for (int n = 0; n < 2; ++n) sc[bj][n] = *(const f32x4*)(sp + 128 * bj + 4 * n); }
#define EIN_DQ(v, ai, m, rs) do { _Pragma("unroll") for (int bj_ = 0; bj_ < 2; ++bj_) _Pragma("unroll") for (int n_ = 0; n_ < 2; ++n_) _Pragma("unroll") for (int c_ = 0; c_ < 4; ++c_) \
            v[bj_][n_][c_] = (float)__float_as_int(acc[ai][bj_][m][n_][c_]) * ((rs) * sc[bj_][n_][c_]); } while (0)
        if (t >= 32) {
            bf16_t* dst = KMVM + (t >= 34 ? (size_t)NMROW * 512 : 0);
            const int col = (t & 1) * 256 + wc * 32 + 8 * fq;
#pragma unroll
            for (int ai = 0; ai < 2; ++ai)
#pragma unroll
                for (int m = 0; m < 4; ++m) {
                    const int row = row0 + ai * 128 + m * 16; f32x4 v[2][2]; EIN_DQ(v, ai, m, sh[row]);
                    bf16_t* rp = dst + (size_t)(row - NTOK) * 512 + col;
#pragma unroll
                    for (int bj = 0; bj < 2; ++bj) st16(rp + 128 * bj, pack8(v[bj][0], v[bj][1]));
                }
        } else if (t < 6) {
            const bool isq = t < 3; bf16_t* dst = (bf16_t*)(wsb + (isq ? WS_Q : WS_K)); const float* g = isq ? gq : gk; const float osc = isq ? QSCALE_A : 1.f;
            const int head = 4 * (isq ? t : t - 3) + wc;
            f32x4 gv[2][2];
#pragma unroll
            for (int bj = 0; bj < 2; ++bj)
#pragma unroll
                for (int n = 0; n < 2; ++n) gv[bj][n] = *(const f32x4*)(g + 32 * bj + 8 * fq + 4 * n) * osc;
#pragma unroll
            for (int ai = 0; ai < 2; ++ai) {
#pragma unroll
              for (int mp = 0; mp < 2; ++mp) {
                u32x4 csv[2][2];
#pragma unroll
                for (int m2 = 0; m2 < 2; ++m2) { const u32x4* cr = (const u32x4*)(cs + (size_t)(row0 + ai * 128 + (2 * mp + m2) * 16) * 16);
                    csv[m2][0] = cr[0]; csv[m2][1] = cr[1]; }
#pragma unroll
                for (int m = 2 * mp; m < 2 * mp + 2; ++m) {
                    const int row = row0 + ai * 128 + m * 16;
                    f32x4 v[2][2]; EIN_DQ(v, ai, m, sh[row]);
                    float ss = 0.f;
#pragma unroll
                    for (int bj = 0; bj < 2; ++bj)
#pragma unroll
                        for (int n = 0; n < 2; ++n) { const f32x4 x = v[bj][n]; ss += (x.x * x.x + x.y * x.y) + (x.z * x.z + x.w * x.w); }
                    ss += __shfl_xor(ss, 16); ss += __shfl_xor(ss, 32);
                    const float rstd = __builtin_amdgcn_rsqf(ss * (1.f / 64.f) + EPS);
#pragma unroll
                    for (int bj = 0; bj < 2; ++bj)
#pragma unroll
                        for (int n = 0; n < 2; ++n) v[bj][n] = v[bj][n] * rstd * gv[bj][n];
                    f32x4 p0, p1;
#pragma unroll
                    for (int c = 0; c < 4; ++c) { p0[c] = __shfl_xor(v[0][0][c], 16); p1[c] = __shfl_xor(v[0][1][c], 16); }
                    if (fq < 2) {
                        const u32x4 cw = csv[m - 2 * mp][0], sw4 = csv[m - 2 * mp][1];
                        const f32x4 c0 = {h2f_lo(cw.x), h2f_hi(cw.x), h2f_lo(cw.y), h2f_hi(cw.y)}, c1 = {h2f_lo(cw.z), h2f_hi(cw.z), h2f_lo(cw.w), h2f_hi(cw.w)};
                        const f32x4 s0 = {h2f_lo(sw4.x), h2f_hi(sw4.x), h2f_lo(sw4.y), h2f_hi(sw4.y)}, s1 = {h2f_lo(sw4.z), h2f_hi(sw4.z), h2f_lo(sw4.w), h2f_hi(sw4.w)};
                        if (fq == 0) { v[0][0] = v[0][0] * c0 - p0 * s0; v[0][1] = v[0][1] * c1 - p1 * s1; }
                        else         { v[0][0] = v[0][0] * c0 + p0 * s0; v[0][1] = v[0][1] * c1 + p1 * s1; }
                    }
                    bf16_t* rp = dst + (size_t)row * 768 + head * 64 + 8 * fq;
#pragma unroll
                    for (int bj = 0; bj < 2; ++bj) st16(rp + 32 * bj, pack8(v[bj][0], v[bj][1]));
                }
                asm volatile("" ::: "memory");
              }
            }
        } else if (t >= 9 && t < 15) {
            bf16_t* U = (bf16_t*)(wsb + WS_U);
            const int c0 = (t - 9) * 128 + wc * 32 + 8 * fq;
#pragma unroll
            for (int ai = 0; ai < 2; ++ai)
#pragma unroll
                for (int m = 0; m < 4; ++m) {
                    const int row = row0 + ai * 128 + m * 16; f32x4 v[2][2]; EIN_DQ(v, ai, m, sh[row]);
                    st16(U + (size_t)row * 768 + c0, pack8(v[0][0] * v[1][0], v[0][1] * v[1][1]));
                }
        } else {
            bf16_t* dst; int ld, col;
            if (t >= 18) { dst = QM; ld = 512; col = (t - 18) * 256; }
            else { dst = (bf16_t*)(wsb + (t < 9 ? WS_V : WS_CB)); ld = 768; col = (t < 9 ? t - 6 : t - 15) * 256; }
            col += wc * 32 + 8 * fq;
#pragma unroll
            for (int ai = 0; ai < 2; ++ai)
#pragma unroll
                for (int m = 0; m < 4; ++m) {
                    const int row = row0 + ai * 128 + m * 16; f32x4 v[2][2]; EIN_DQ(v, ai, m, sh[row]);
                    bf16_t* rp = dst + (size_t)row * ld + col;
#pragma unroll
                    for (int bj = 0; bj < 2; ++bj) st16(rp + 128 * bj, pack8(v[bj][0], v[bj][1]));
                }
        }
#undef EIN_DQ
    }
};

DI float sigm(float x) { return frcp(1.f + fexp(-fminf(fmaxf(x, -60.f), 60.f))); }
DI f32x4 sigm4(const f32x4& v) { f32x4 r; r.x = sigm(v.x); r.y = sigm(v.y); r.z = sigm(v.z); r.w = sigm(v.w); return r; }
DI float gqf(float x) { return fmaxf(255.f * frcp(1.f + fexp(-x)), 1.f); }
DI unsigned gq4(const f32x4& v) {
    unsigned w = 0u;
    w = __builtin_amdgcn_cvt_pk_u8_f32(gqf(v.x), 0, w); w = __builtin_amdgcn_cvt_pk_u8_f32(gqf(v.y), 1, w); w = __builtin_amdgcn_cvt_pk_u8_f32(gqf(v.z), 2, w); w = __builtin_amdgcn_cvt_pk_u8_f32(gqf(v.w), 3, w);
    return w; }
DI float ub(unsigned w, int k) { return (float)((w >> (8 * k)) & 0xffu); }
struct EpiGate {
    static constexpr int PID = 3; static constexpr bool PERM = true, AFTER_DRAIN = false, HAS_MID = false;
    unsigned char* O; int ld; const float* sh; const float* sg;
    DI void operator()(const pg8::f32x4 (&acc)[2][2][4][2], const Unit& u, int wr, int wc, int fr, int fq) const {
        const int row0 = u.pm * 256 + wr * 64 + fr, col = u.pn * 256 + wc * 64 + 16 * fq;
        const float* sp = sg + u.pn * 256 + wc * 32 + 8 * fq;
        f32x4 sc[2][2];
#pragma unroll
        for (int bj = 0; bj < 2; ++bj)
#pragma unroll
            for (int n = 0; n < 2; ++n) sc[bj][n] = *(const f32x4*)(sp + 128 * bj + 4 * n);
#pragma unroll
        for (int ai = 0; ai < 2; ++ai)
#pragma unroll
            for (int m = 0; m < 4; ++m) {
                const int row = row0 + ai * 128 + m * 16; const float rs = sh[row];
                const float rk = rs * -1.44269504088896341f;
                unsigned wq[2][2];
#pragma unroll
                for (int bj = 0; bj < 2; ++bj)
#pragma unroll
                    for (int n = 0; n < 2; ++n) { unsigned w = 0u;
#pragma unroll
                        for (int c = 0; c < 4; ++c) { const float z = __builtin_fmaf((float)__float_as_int(acc[ai][bj][m][n][c]), rk * sc[bj][n][c], -7.99435343685885794f);
                            const float g = fmaxf(frcp(fexp2(z) + (1.f / 255.f)), 1.f);
                            w = (c == 0) ? __builtin_amdgcn_cvt_pk_u8_f32(g, 0, w) : (c == 1) ? __builtin_amdgcn_cvt_pk_u8_f32(g, 1, w) : (c == 2) ? __builtin_amdgcn_cvt_pk_u8_f32(g, 2, w) : __builtin_amdgcn_cvt_pk_u8_f32(g, 3, w); }
                        wq[bj][n] = w; }
                u32x4 w; w.x = wq[0][0]; w.y = wq[0][1]; w.z = wq[1][0]; w.w = wq[1][1];
#ifdef GATE_NT
                __builtin_nontemporal_store(w, (u32x4*)(O + (size_t)row * ld + col));
#else
                st16d(O + (size_t)row * ld + col, w);
#endif
            }
    }
};
struct EpiMerge {
    static constexpr int PID = 4; static constexpr bool PERM = true, AFTER_DRAIN = false, HAS_MID = true;
    const unsigned char* G; bf16_t* O; int mid0, mid1;
    DI void mid(pg8::f32x4 (&acc)[2][2][4][2], const Unit& u, int t, int wr, int wc, int fr, int fq) const {
        const int ga = (t == mid0) ? 0 : 1;
        int row0 = u.pm * 256 + wr * 64 + fr; const int col = u.pn * 256 + wc * 64 + 16 * fq;
        asm volatile("" : "+v"(row0));
        u32x4 la[2][4], lb[2][4];
#pragma unroll
        for (int ai = 0; ai < 2; ++ai)
#pragma unroll
            for (int m = 0; m < 4; ++m) { const unsigned char* gp = G + (size_t)(row0 + ai * 128 + m * 16) * 3072 + ga * 1024 + col; la[ai][m] = *(const u32x4*)gp; lb[ai][m] = *(const u32x4*)(gp + 1024); }
#pragma unroll
        for (int ai = 0; ai < 2; ++ai)
#pragma unroll
            for (int m = 0; m < 4; ++m)
#pragma unroll
                for (int bj = 0; bj < 2; ++bj)
#pragma unroll
                    for (int n = 0; n < 2; ++n)
#pragma unroll
                        for (int c = 0; c < 4; ++c) acc[ai][bj][m][n][c] *= ub(la[ai][m][2 * bj + n], c) * frcp(ub(lb[ai][m][2 * bj + n], c));
        asm volatile("" ::: "memory");
    }
    DI void operator()(const pg8::f32x4 (&acc)[2][2][4][2], const Unit& u, int wr, int wc, int fr, int fq) const {
        const int row0 = u.pm * 256 + wr * 64 + fr, col = u.pn * 256 + wc * 64 + 16 * fq;
        u32x4 lq[2][4];
#pragma unroll
        for (int ai = 0; ai < 2; ++ai)
#pragma unroll
            for (int m = 0; m < 4; ++m) lq[ai][m] = *(const u32x4*)(G + (size_t)(row0 + ai * 128 + m * 16) * 3072 + 2048 + col);
#pragma unroll
        for (int ai = 0; ai < 2; ++ai)
#pragma unroll
            for (int m = 0; m < 4; ++m) {
                const size_t row = (size_t)(row0 + ai * 128 + m * 16);
#pragma unroll
                for (int bj = 0; bj < 2; ++bj) {
                    const float k = 1.f / 255.f; const unsigned q0 = lq[ai][m][2 * bj], q1 = lq[ai][m][2 * bj + 1];
                    const f32x4 g0 = {ub(q0, 0) * k, ub(q0, 1) * k, ub(q0, 2) * k, ub(q0, 3) * k}, g1 = {ub(q1, 0) * k, ub(q1, 1) * k, ub(q1, 2) * k, ub(q1, 3) * k};
                    st16d(O + row * 1024 + col + 8 * bj, pack8(acc[ai][bj][m][0] * g0, acc[ai][bj][m][1] * g1));
                }
            }
    }
};

struct EpiOut {
    static constexpr int PID = 5; static constexpr bool PERM = true, AFTER_DRAIN = false, HAS_MID = false;
    const float* X; float* O; bf16_t* XB;
    DI void operator()(const pg8::f32x4 (&acc)[2][2][4][2], const Unit& u, int wr, int wc, int fr, int fq) const {
        const int row0 = u.pm * 256 + wr * 64 + fr, col = u.pn * 256 + wc * 32 + 8 * fq;
#pragma unroll
        for (int ai = 0; ai < 2; ++ai)
#pragma unroll
            for (int m = 0; m < 4; ++m) {
                const size_t off = (size_t)(row0 + ai * 128 + m * 16) * 1024 + col;
#pragma unroll
                for (int bj = 0; bj < 2; ++bj) {
                    const f32x4 o0 = *(const f32x4*)(X + off + 128 * bj) + acc[ai][bj][m][0], o1 = *(const f32x4*)(X + off + 128 * bj + 4) + acc[ai][bj][m][1];
                    st16d(XB + off + 128 * bj, pack8(o0, o1));
                }
            }
    }
};

struct EpiUp {
    static constexpr int PID = 8; static constexpr bool PERM = true, AFTER_DRAIN = false, HAS_MID = false;
    const float* sa; const float* sb; bf16_t* ACT;
    DI void operator()(const pg8::f32x4 (&acc)[2][2][4][2], const Unit& u, int wr, int wc, int fr, int fq) const {
        const int row0 = u.pm * 256 + wr * 64 + fr, col = u.aux * 128 + wc * 32 + 8 * fq;
        const float* sbp = sb + (size_t)(u.pn >> 2) * 1024 + u.aux * 256 + wc * 32 + 8 * fq;
        const f32x4 sg0 = *(const f32x4*)(sbp), sg1 = *(const f32x4*)(sbp + 4), su0 = *(const f32x4*)(sbp + 128), su1 = *(const f32x4*)(sbp + 132);
#pragma unroll
        for (int ai = 0; ai < 2; ++ai)
#pragma unroll
            for (int m = 0; m < 4; ++m) {
                const int row = row0 + ai * 128 + m * 16; const float rs = sa[row + u.sb];
                f32x4 o[2];
#pragma unroll
                for (int n = 0; n < 2; ++n)
#pragma unroll
                    for (int c = 0; c < 4; ++c) {
                        const float a = (float)__float_as_int(acc[ai][0][m][n][c]) * rs * (n ? sg1[c] : sg0[c]), b = (float)__float_as_int(acc[ai][1][m][n][c]) * rs * (n ? su1[c] : su0[c]);
                        o[n][c] = a * b * frcp(1.f + fexp(-a)); }
                st16d(ACT + (size_t)row * 512 + col, pack8(o[0], o[1]));
            }
    }
};

struct EpiDown {
    static constexpr int PID = 9; static constexpr bool PERM = true, AFTER_DRAIN = false, HAS_MID = false;
    const u32x2* dw; bf16_t* Y;
    DI void operator()(const pg8::f32x4 (&acc)[2][2][4][2], const Unit& u, int wr, int wc, int fr, int fq) const {
        const int row0 = u.pm * 256 + wr * 64 + fr, col = u.aux * 256 + wc * 32 + 8 * fq;
#pragma unroll
        for (int ai = 0; ai < 2; ++ai)
#pragma unroll
            for (int m = 0; m < 4; ++m) {
                const int row = row0 + ai * 128 + m * 16; const bool ok = (wr * 64 + fr + ai * 128 + m * 16) < u.nv;
                u32x2 rec; rec.x = 0u; rec.y = 0u; if (ok) rec = dw[row + u.sb]; const int d = (int)rec.x;
                if (ok) { const float ww = __uint_as_float(rec.y); bf16_t* rp = Y + (size_t)d * 1024 + col;
#pragma unroll
                    for (int bj = 0; bj < 2; ++bj) st16d(rp + 128 * bj, pack8(acc[ai][bj][m][0] * ww, acc[ai][bj][m][1] * ww)); }
            }
    }
};

struct InOrder {
    static constexpr bool GATHER = false; DI int row(int, int) const { return 0; }
    pg8::StaticOrder so; int nmain;
    DI bool next(int i, Unit& u) const {
        const long L = (long)i * so.G + so.c;
        if (L < nmain) return so.next(i, u);
        const int idx = (int)(L - nmain); if (idx >= 64) return false;
        u.pm = NTOK / 256 + (idx >> 2); u.pn = 32 + (idx & 3); u.aux = u.pn; return true;
    }
    DI void a_ready(const Unit&) const {}
    DI void done(const Unit&) const {}
};
template <bool GATHER_> struct MoeOrder {
    static constexpr bool GATHER = GATHER_;
    const LAS int* tile_exp; int ntiles, G, c; const LAS int* rowtab; const LAS int* tsb; const LAS int* tnv;
    DI int row(int ui, int r) const { return rowtab[ui * 256 + r]; }
    DI bool next(int i, Unit& u) const {
        const int nwg = ntiles * 4; const long L = (long)i * G + c; if (L >= nwg) return false;
        int wgid = (int)L; { const int q = nwg / 8, r = nwg % 8, xcd = wgid % 8, off = wgid / 8; wgid = (xcd < r ? xcd * (q + 1) : r * (q + 1) + (xcd - r) * q) + off; }
        u.pm = wgid >> 2; u.aux = wgid & 3; u.pn = tile_exp[u.pm] * 4 + u.aux; u.sb = tsb[u.pm]; u.nv = tnv[u.pm]; return true;
    }
    DI void a_ready(const Unit&) const {}
    DI void done(const Unit&) const {}
};

struct Args { const void* in[24]; float* out; unsigned char* ws; int ph_lo, ph_hi; };
enum { I_X = 0, I_MEM, I_POS, I_GMIX, I_GMEM, I_WIN, I_GQA, I_GKA, I_WCONV, I_WMKV, I_GQM, I_GKM, I_WPA, I_WPC, I_WPM, I_WOUT, I_GFFN, I_WRG, I_BRG, I_WRE, I_BRE, I_WGATE, I_WUP, I_WDOWN };

DI void transpose_item(const float* src, int ldsrc, int k0, int col0, bf16_t* dst, int lddst, int drow0, int dk0, const float* kgain, LAS float* scr, int lane, bool gmode = false) {
    (void)scr;
    const int kg = lane >> 3, nq = lane & 7;
    const float* sp = src + (size_t)(k0 + 8 * kg) * ldsrc + col0 + (gmode ? 16 * (nq >> 1) + 4 * (nq & 1) : 4 * nq);
    f32x4 v[8];
#pragma unroll
    for (int j = 0; j < 8; ++j) v[j] = ldnt((const f32x4*)(sp + (size_t)j * ldsrc));
    if (kgain) { const f32x4 g0 = *(const f32x4*)(kgain + k0 + 8 * kg), g1 = *(const f32x4*)(kgain + k0 + 8 * kg + 4);
        v[0] *= g0.x; v[1] *= g0.y; v[2] *= g0.z; v[3] *= g0.w; v[4] *= g1.x; v[5] *= g1.y; v[6] *= g1.z; v[7] *= g1.w; }
    bf16_t* dp = dst + (size_t)(drow0 + 4 * nq) * lddst + dk0 + 8 * kg;
#pragma unroll
    for (int q = 0; q < 4; ++q) { u32x4 o; o.x = pk2(v[0][q], v[1][q]); o.y = pk2(v[2][q], v[3][q]); o.z = pk2(v[4][q], v[5][q]); o.w = pk2(v[6][q], v[7][q]);
        *(u32x4*)(dp + (size_t)q * lddst) = o; }
}
DI unsigned q8x4(float a, float b, float c, float d) {
    unsigned w = 0u;
    w = __builtin_amdgcn_cvt_pk_u8_f32(a + 128.f, 0, w); w = __builtin_amdgcn_cvt_pk_u8_f32(b + 128.f, 1, w); w = __builtin_amdgcn_cvt_pk_u8_f32(c + 128.f, 2, w); w = __builtin_amdgcn_cvt_pk_u8_f32(d + 128.f, 3, w);
    return w ^ 0x80808080u;
}
DI void qs_store(const f32x4 (&v)[2][8], const f32x4& inv, unsigned char* dst, int drow0, LAS unsigned char* scr, int lane, int wave) {
    const int kg = lane >> 3, nq = lane & 7;
#pragma unroll
    for (int b = 0; b < 2; ++b)
#pragma unroll
        for (int q = 0; q < 4; ++q) { const float sc = inv[q]; u32x2 o;
            o.x = q8x4(v[b][0][q] * sc, v[b][1][q] * sc, v[b][2][q] * sc, v[b][3][q] * sc); o.y = q8x4(v[b][4][q] * sc, v[b][5][q] * sc, v[b][6][q] * sc, v[b][7][q] * sc);
            *(LAS u32x2*)(scr + (4 * nq + q) * 128 + (((4 * b + (kg >> 1)) ^ nq) << 4) + 8 * (kg & 1)) = o; }
    asm volatile("s_waitcnt lgkmcnt(0)" ::: "memory");
#pragma unroll
    for (int i = 0; i < 4; ++i) { const int col = (lane >> 3) + 8 * i, piece = lane & 7;
        const u32x4 o = *(const LAS u32x4*)(scr + col * 128 + ((piece ^ ((col >> 2) & 7)) << 4));
        *(u32x4*)(dst + (size_t)(drow0 + col) * 1024 + 128 * wave + 16 * piece) = o; }
    asm volatile("" ::: "memory");
}
DI void quant_strip_wg(const float* src, int ldsrc, int col0, bool gmode, const float* kgain, unsigned char* dst, int drow0, float* sb, LAS float* red, int lane, int wave) {
    const int kg = lane >> 3, nq = lane & 7;
    const float* sp = src + (size_t)(128 * wave + 8 * kg) * ldsrc + col0 + (gmode ? 16 * (nq >> 1) + 4 * (nq & 1) : 4 * nq);
    f32x4 v[2][8];
#pragma unroll
    for (int b = 0; b < 2; ++b)
#pragma unroll
        for (int j = 0; j < 8; ++j) v[b][j] = ldnt((const f32x4*)(sp + (size_t)(64 * b + j) * ldsrc));
    f32x4 cm = {0.f, 0.f, 0.f, 0.f};
#pragma unroll
    for (int b = 0; b < 2; ++b) {
        f32x4 g0 = {1.f, 1.f, 1.f, 1.f}, g1 = g0;
        if (kgain) { g0 = *(const f32x4*)(kgain + 128 * wave + 64 * b + 8 * kg); g1 = *(const f32x4*)(kgain + 128 * wave + 64 * b + 8 * kg + 4); }
        v[b][0] *= g0.x; v[b][1] *= g0.y; v[b][2] *= g0.z; v[b][3] *= g0.w; v[b][4] *= g1.x; v[b][5] *= g1.y; v[b][6] *= g1.z; v[b][7] *= g1.w;
#pragma unroll
        for (int j = 0; j < 8; ++j)
#pragma unroll
            for (int q = 0; q < 4; ++q) cm[q] = fmaxf(cm[q], fabsf(v[b][j][q]));
    }
#pragma unroll
    for (int q = 0; q < 4; ++q) { cm[q] = fmaxf(cm[q], __shfl_xor(cm[q], 8)); cm[q] = fmaxf(cm[q], __shfl_xor(cm[q], 16)); cm[q] = fmaxf(cm[q], __shfl_xor(cm[q], 32)); }
    if (kg == 0) *(LAS f32x4*)(red + wave * 32 + 4 * nq) = cm;
    __syncthreads();
#pragma unroll
    for (int w = 0; w < 8; ++w) { const f32x4 o = *(const LAS f32x4*)(red + w * 32 + 4 * nq);
#pragma unroll
        for (int q = 0; q < 4; ++q) cm[q] = fmaxf(cm[q], o[q]); }
    if (wave == 0 && kg == 0) *(f32x4*)(sb + 4 * nq) = cm * (1.f / 127.f);
    f32x4 inv;
#pragma unroll
    for (int q = 0; q < 4; ++q) inv[q] = cm[q] > 0.f ? 127.f / cm[q] : 0.f;
    qs_store(v, inv, dst, drow0, (LAS unsigned char*)red + 4096 + wave * 4096, lane, wave);
    __syncthreads();
}
DI void qs_issue(const float* src, int ldsrc, int col0, bool gmode, int lane, int wave, f32x4 (&v)[2][8]) {
    const int kg = lane >> 3, nq = lane & 7;
    const float* sp = src + (size_t)(128 * wave + 8 * kg) * ldsrc + col0 + (gmode ? 16 * (nq >> 1) + 4 * (nq & 1) : 4 * nq);
#pragma unroll
    for (int b = 0; b < 2; ++b)
#pragma unroll
        for (int j = 0; j < 8; ++j) v[b][j] = ldnt((const f32x4*)(sp + (size_t)(64 * b + j) * ldsrc));
}
DI void qs_finish(f32x4 (&v)[2][8], const f32x4 (&kgn)[2][2], bool usegain, unsigned char* dst, int drow0, float* sb, LAS float* red, int lane, int wave) {
    const int kg = lane >> 3, nq = lane & 7;
    f32x4 cm = {0.f, 0.f, 0.f, 0.f};
#pragma unroll
    for (int b = 0; b < 2; ++b) {
        const f32x4 one = {1.f, 1.f, 1.f, 1.f}; const f32x4 g0 = usegain ? kgn[b][0] : one, g1 = usegain ? kgn[b][1] : one;
        v[b][0] *= g0.x; v[b][1] *= g0.y; v[b][2] *= g0.z; v[b][3] *= g0.w; v[b][4] *= g1.x; v[b][5] *= g1.y; v[b][6] *= g1.z; v[b][7] *= g1.w;
#pragma unroll
        for (int j = 0; j < 8; ++j)
#pragma unroll
            for (int q = 0; q < 4; ++q) cm[q] = fmaxf(cm[q], fabsf(v[b][j][q]));
    }
#pragma unroll
    for (int q = 0; q < 4; ++q) { cm[q] = fmaxf(cm[q], __shfl_xor(cm[q], 8)); cm[q] = fmaxf(cm[q], __shfl_xor(cm[q], 16)); cm[q] = fmaxf(cm[q], __shfl_xor(cm[q], 32)); }
    if (kg == 0) *(LAS f32x4*)(red + wave * 32 + 4 * nq) = cm;
    __syncthreads();
#pragma unroll
    for (int w = 0; w < 8; ++w) { const f32x4 o = *(const LAS f32x4*)(red + w * 32 + 4 * nq);
#pragma unroll
        for (int q = 0; q < 4; ++q) cm[q] = fmaxf(cm[q], o[q]); }
    if (wave == 0 && kg == 0) *(f32x4*)(sb + 4 * nq) = cm * (1.f / 127.f);
    f32x4 inv;
#pragma unroll
    for (int q = 0; q < 4; ++q) inv[q] = cm[q] > 0.f ? 127.f / cm[q] : 0.f;
    qs_store(v, inv, dst, drow0, (LAS unsigned char*)red + 4096 + wave * 4096, lane, wave);
}
DI int gperm_col0(int c) { return 64 * ((c >> 5) & 3) + 8 * (c >> 7); }
DI int orig_col8(int n0) {
    const int t = n0 >> 8, c = n0 & 255;
    if (t < 3)  return (4 * t + ((c >> 5) & 3)) * 64 + 32 * (c >> 7) + (c & 31);
    if (t < 6)  return 768 + (4 * (t - 3) + ((c >> 5) & 3)) * 64 + 32 * (c >> 7) + (c & 31);
    if (t < 9)  return 1536 + (t - 6) * 256 + c;
    if (t < 15) return (c < 128) ? 2304 + 128 * (t - 9) + c : 3840 + 128 * (t - 9) + c - 128;
    if (t < 18) return 3072 + (t - 15) * 256 + c;
    if (t < 20) return 4608 + (t - 18) * 256 + c;
    return 5120 + (t - 20) * 256 + 64 * ((c >> 5) & 3) + 16 * ((c >> 3) & 3) + 8 * (c >> 7);
}
DI void rms_rows_to_i8(const float* x, const float* g, int nrows, unsigned char* A8, float* SH, int gw, int NGW, int lane) {
    const f32x4* gr = (const f32x4*)g + lane; f32x4 gg[4];
#pragma unroll
    for (int j = 0; j < 4; ++j) gg[j] = gr[64 * j];
    for (int m0 = 4 * gw; m0 < nrows; m0 += 4 * NGW) {
        f32x4 v[4][4];
#pragma unroll
        for (int r = 0; r < 4; ++r)
#pragma unroll
            for (int j = 0; j < 4; ++j) v[r][j] = ldnt((const f32x4*)(x + (size_t)(m0 + r) * 1024) + lane + 64 * j);
#pragma unroll
        for (int r = 0; r < 4; ++r) {
            float s = 0.f;
#pragma unroll
            for (int j = 0; j < 4; ++j) s += (v[r][j].x * v[r][j].x + v[r][j].y * v[r][j].y) + (v[r][j].z * v[r][j].z + v[r][j].w * v[r][j].w);
            const float rstd = __builtin_amdgcn_rsqf(wave_sum(s) * (1.f / 1024.f) + EPS);
            float am = 0.f;
#pragma unroll
            for (int j = 0; j < 4; ++j) { v[r][j] = v[r][j] * rstd * gg[j];
                am = fmaxf(am, fmaxf(fmaxf(fabsf(v[r][j].x), fabsf(v[r][j].y)), fmaxf(fabsf(v[r][j].z), fabsf(v[r][j].w)))); }
#pragma unroll
            for (int o = 1; o < 64; o <<= 1) am = fmaxf(am, __shfl_xor(am, o));
            const float inv = am > 0.f ? 127.f / am : 0.f;
            unsigned* q8 = (unsigned*)(A8 + (size_t)(m0 + r) * 1024) + lane;
#pragma unroll
            for (int j = 0; j < 4; ++j) q8[64 * j] = q8x4(v[r][j].x * inv, v[r][j].y * inv, v[r][j].z * inv, v[r][j].w * inv);
            if (lane == 0) SH[m0 + r] = am * (1.f / 127.f);
        }
    }
}

DI int dyn_next1(unsigned* ctr, LAS int* slot, int tid, int par) { if (tid == 0) slot[par] = (int)atomicAdd(ctr, 1u); __syncthreads(); return slot[par]; }
DI int dyn_next(unsigned* ctr, LAS int* slot, int tid) { if (tid == 0) *slot = (int)atomicAdd(ctr, 1u); __syncthreads(); const int v = *slot; __syncthreads(); return v; }
#ifndef P0_NSTRIPWG
#define P0_NSTRIPWG 64
#endif
DI void phase0(const Args& a, LAS unsigned char* lds, int tid, int lane, int wave) {
#ifdef TPROBE_P0
    unsigned long long tq0_ = 0; if (tid == 0) tq0_ = __builtin_amdgcn_s_memrealtime();
#endif
    const int gw = blockIdx.x * 8 + wave, NGW = gridDim.x * 8;
    LAS float* scr = (LAS float*)(lds + wave * 16384);
    unsigned char* ws = a.ws; unsigned char* dob = (unsigned char*)a.out;
    bf16_t* Wt_mrg = (bf16_t*)(ws + WS_WMRG); bf16_t* Wt_out = (bf16_t*)(ws + WS_WOUT);
    if ((int)blockIdx.x < P0_NSTRIPWG || (int)gridDim.x < 2 * P0_NSTRIPWG) {
        unsigned* sctr = (unsigned*)(ws + WS_CTL) + 960; LAS int* sslot = (LAS int*)(lds + MISC_OFF + 8192 + 64); LAS float* red = (LAS float*)lds;
        constexpr int NS0 = 192;
        const float* win = (const float*)a.in[I_WIN]; const float* wmkv = (const float*)a.in[I_WMKV];
        f32x4 kone[2][2];
#pragma unroll
        for (int b = 0; b < 2; ++b) { kone[b][0] = (f32x4){1.f, 1.f, 1.f, 1.f}; kone[b][1] = kone[b][0]; }
#define P0S_N0(it)  ((it) < 160 ? (it) * 32 : 8192 + ((it) - 160) * 32)
#define P0S_SRC(it) ((it) < 160 ? win : wmkv), ((it) < 160 ? 8192 : 1024), ((it) < 160 ? orig_col8((it) * 32) : ((it) - 160) * 32), false
#define P0S_DST(it) false, ws + WS_WIN, P0S_N0(it), (float*)(ws + WS_SW) + P0S_N0(it)
        f32x4 va[2][8], vb[2][8];
        int ia = dyn_next1(sctr, sslot, tid, 0);
        if (ia < NS0) {
            qs_issue(P0S_SRC(ia), lane, wave, va);
            for (;;) {
                __builtin_amdgcn_sched_barrier(0);
                const int ib = dyn_next1(sctr, sslot, tid, 1);
                if (ib < NS0) qs_issue(P0S_SRC(ib), lane, wave, vb);
                __builtin_amdgcn_sched_barrier(0);
                qs_finish(va, kone, P0S_DST(ia), red, lane, wave);
                if (ib >= NS0) break;
                __builtin_amdgcn_sched_barrier(0);
                ia = dyn_next1(sctr, sslot, tid, 0);
                if (ia < NS0) qs_issue(P0S_SRC(ia), lane, wave, va);
                __builtin_amdgcn_sched_barrier(0);
                qs_finish(vb, kone, P0S_DST(ib), red + 256, lane, wave);
                if (ia >= NS0) break;
            }
        }
        __syncthreads();
#undef P0S_N0
#undef P0S_SRC
#undef P0S_DST
    }
    constexpr int I_PA = 4 * 32, I_PC = 12 * 32, I_PM = 8 * 32, I_OUT = 16 * 32;
    constexpr int NITEMS = I_PA + I_PC + I_PM + I_OUT;
    const bool tsplit = (int)gridDim.x >= 192 + 32; const int gwt = tsplit ? ((int)blockIdx.x - 192) * 8 + wave : gw, NGWT = tsplit ? ((int)gridDim.x - 192) * 8 : NGW;
    for (int it = gwt; it < NITEMS && gwt >= 0; it += NGWT) {
        int r = it;
        if (r < I_PA) { const int kb = r >> 5, nb = r & 31; transpose_item((const float*)a.in[I_WPA], 1024, kb * 64, (nb >> 3) * 256 + gperm_col0((nb & 7) * 32), Wt_mrg, 1536, nb * 32, kb * 64, nullptr, scr, lane, true); continue; } r -= I_PA;
        if (r < I_PC) { const int kb = r >> 5, nb = r & 31; transpose_item((const float*)a.in[I_WPC], 1024, kb * 64, (nb >> 3) * 256 + gperm_col0((nb & 7) * 32), Wt_mrg, 1536, nb * 32, 256 + kb * 64, nullptr, scr, lane, true); continue; } r -= I_PC;
        if (r < I_PM) { const int kb = r >> 5, nb = r & 31; transpose_item((const float*)a.in[I_WPM], 1024, kb * 64, (nb >> 3) * 256 + gperm_col0((nb & 7) * 32), Wt_mrg, 1536, nb * 32, 1024 + kb * 64, nullptr, scr, lane, true); continue; } r -= I_PM;
        { const int kb = r >> 5, nb = r & 31; transpose_item((const float*)a.in[I_WOUT], 1024, kb * 64, nb * 32, Wt_out, 1024, nb * 32, kb * 64, nullptr, scr, lane); }
    }
    const int gt = blockIdx.x * 512 + tid, NT = gridDim.x * 512;
    { const float* wrg = (const float*)a.in[I_WRG]; const float* wre = (const float*)a.in[I_WRE]; const float* gf = (const float*)a.in[I_GFFN];
      bf16_t* WH = (bf16_t*)(ws + WS_WRH); bf16_t* WL = (bf16_t*)(ws + WS_WRL);
      for (int idx = gt; idx < 48 * 1024; idx += NT) { const int n = idx >> 10, k = idx & 1023;
          float v = 0.f; if (n < 4) v = wrg[k * 4 + n] * gf[k]; else if (n < 36) v = wre[k * 32 + (n - 4)] * gf[k];
          const unsigned hi = pk2(v, 0.f) & 0xffffu; const float lo = v - __uint_as_float(hi << 16);
          WH[idx] = (bf16_t)hi; WL[idx] = (bf16_t)(pk2(lo, 0.f) & 0xffffu); } }
    { const int* pos = (const int*)a.in[I_POS]; _Float16* cs = (_Float16*)(ws + WS_ROPE);
      for (int idx = gt; idx < NTOK * 8; idx += NT) { const int row = idx >> 3, j = idx & 7;
          const double inv = exp2(-(double)j * (18.931568569324174 / 8.0));
          const float invf = (float)inv; const float ang = (float)pos[row] * invf;
          const double ad = (double)ang; cs[row * 16 + j] = (_Float16)(float)cos(ad); cs[row * 16 + 8 + j] = (_Float16)(float)sin(ad); } }
#ifdef TPROBE_ROWS
    unsigned long long tr0_ = 0; if (tid == 0) tr0_ = __builtin_amdgcn_s_memrealtime();
#endif
    {   unsigned* ctr = (unsigned*)(ws + WS_CTL) + 704; LAS int* slot = (LAS int*)(lds + MISC_OFF + 8192 + 64);
        constexpr int NIT = (NTOK + NMROW) / 32;
        __syncthreads(); int cur = (int)blockIdx.x; int qpar = 0;
        while (cur < NIT) {
            int nxt = 0; if (tid == 0) nxt = (int)atomicAdd(ctr, 1u) + (int)gridDim.x;
            const int row0 = cur * 32 + 4 * wave; const bool isx = row0 < NTOK;
            rms_rows_to_i8(isx ? (const float*)a.in[I_X] + (size_t)row0 * 1024 : (const float*)a.in[I_MEM] + (size_t)(row0 - NTOK) * 1024, isx ? (const float*)a.in[I_GMIX] : (const float*)a.in[I_GMEM], 4,
                           dob + DO_A8 + (size_t)row0 * 1024, (float*)(ws + WS_SH) + row0, 0, 1, lane);
            qpar ^= 1; if (tid == 0) slot[qpar] = nxt;
            __syncthreads(); cur = slot[qpar];
        }
    }
#ifdef TPROBE_P0
    if (tid == 0) ((volatile LAS unsigned*)(lds + MISC_OFF + 8192))[2] += (unsigned)(__builtin_amdgcn_s_memrealtime() - tq0_);
#endif
#ifdef TPROBE_ROWS
    if (tid == 0) ((volatile LAS unsigned*)(lds + MISC_OFF + 8192))[2] += (unsigned)(__builtin_amdgcn_s_memrealtime() - tr0_);
#endif
}

typedef short v4i16_t __attribute__((ext_vector_type(4)));
DI s16x4 vtr(const LAS unsigned char* p) { return __builtin_bit_cast(s16x4, __builtin_amdgcn_ds_read_tr16_b64_v4i16((LAS v4i16_t*)p)); }

DI int kimg64(int slot, int c16) { return slot * 128 + ((c16 ^ ((slot >> 1) & 7)) << 4); }
DI int img256(int row, int ch) { return row * 256 + ((ch ^ (((row & 3) << 2) | ((row >> 2) & 3))) << 4); }
constexpr int A_VOFF = 49152, A_VS = 192;
constexpr int M_VOFF = 65536;

struct AUnit { int b, head, gi, hs, dl, L, j, Q0; size_t rowb; };
DI AUnit a_decode(int wu) {
    AUnit u; const int blk8 = wu & 7; const int bh = wu >> 3; u.head = bh % 12; u.b = bh / 12; u.gi = u.head >> 2; u.hs = u.head & 3;
    u.dl = (u.gi == 0) ? 1 : (u.gi == 1) ? 4 : 16; u.L = SEQ / u.dl;
    if (u.gi < 2) { const int npj = u.L >> 8; u.j = blk8 / npj; u.Q0 = (blk8 % npj) << 8; } else { u.j = 2 * blk8; u.Q0 = 0; }
    u.rowb = (size_t)u.b * SEQ; return u;
}
DI void a_wave_geom(const AUnit& u, int wave, int& qsub, int& kj_first, int& slot_first, int& jq) {
    jq = u.j;
    if (u.gi < 2) { qsub = u.Q0 + 32 * wave; kj_first = qsub - 64; slot_first = 32 * wave; }
    else { const int sub = wave >> 2; jq = u.j + sub; qsub = 32 * (wave & 3); kj_first = qsub - 64; slot_first = sub * 128 + kj_first; }
}
DI void a_issue(const AUnit& u, const bf16_t* Q, const bf16_t* K, const bf16_t* V, int tid, int lane, int wave, u32x4 (&kv)[6], u32x4 (&vv)[6], unsigned& okm, bf16x8 (&qf)[4]) {
    const int nsl = (u.gi < 2) ? 384 : 256; okm = 0u;
#pragma unroll
    for (int i = 0; i < 6; ++i) {
        const int p = tid + i * 512, slot = p >> 3, c16 = p & 7; size_t row; bool ok = slot < nsl;
        if (u.gi < 2) { const int kj = u.Q0 - 64 + slot; ok = ok && (kj >= 0 && kj < u.L); row = u.rowb + (size_t)kj * u.dl + u.j; }
        else { row = u.rowb + (size_t)(slot & 127) * 16 + u.j + (slot >> 7); }
        if (ok) { kv[i] = *(const u32x4*)(K + row * 768 + u.head * 64 + c16 * 8); vv[i] = *(const u32x4*)(V + row * 768 + u.head * 64 + c16 * 8); okm |= 1u << i; }
    }
    int qsub, kj_first, slot_first, jq; a_wave_geom(u, wave, qsub, kj_first, slot_first, jq);
    const size_t rowq = u.rowb + (size_t)(qsub + (lane & 31)) * u.dl + jq;
    const bf16_t* qrow = Q + rowq * 768 + u.head * 64;
#pragma unroll
    for (int s = 0; s < 4; ++s) qf[s] = *(const bf16x8*)(qrow + 16 * s + 8 * (lane >> 5));
}
DI void a_fill(LAS unsigned char* lds, int tid, const u32x4 (&kv)[6], const u32x4 (&vv)[6], unsigned okm) {
#pragma unroll
    for (int i = 0; i < 6; ++i) { const int p = tid + i * 512, slot = p >> 3, c16 = p & 7;
        if (okm & (1u << i)) { *(LAS u32x4*)(lds + kimg64(slot, c16)) = kv[i]; *(LAS u32x4*)(lds + A_VOFF + slot * A_VS + c16 * 16) = vv[i]; } }
}
DI void a_compute(const AUnit& u, const bf16x8 (&qf)[4], bf16_t* PO, float* LSE, LAS unsigned char* lds, int lane, int wave) {
    const int gi = u.gi, hs = u.hs, dl = u.dl, L = u.L; const size_t rowb = u.rowb;
    const int r32 = lane & 31, h = lane >> 5;
    int qsub, kj_first, slot_first, jq; a_wave_geom(u, wave, qsub, kj_first, slot_first, jq);
    const size_t rowq = rowb + (size_t)(qsub + r32) * dl + jq;
    f32x16 o[2];
#pragma unroll
    for (int dt = 0; dt < 2; ++dt)
#pragma unroll
        for (int r = 0; r < 16; ++r) o[dt][r] = 0.f;
    float m = -INFINITY, lp = 0.f;
    const int q4 = (lane & 15) >> 2, p4 = lane & 3, blk = (lane >> 4) & 1;
    const int troff = (4 * h + q4) * A_VS + blk * 32 + p4 * 8;
#pragma unroll
    for (int ci = 0; ci < 5; ++ci) {
        const int c = (ci == 0 ? 2 : ci == 1 ? 1 : ci == 2 ? 3 : ci == 3 ? 0 : 4);
        const int kj = kj_first + 32 * c;
        if (kj < 0 || kj >= L) continue;
        const int slot0 = slot_first + 32 * c, ks = slot0 + r32;
        const LAS unsigned char* kp = lds + ks * 128; const int kx = (ks >> 1) & 7;
        f32x16 S;
        const float ninit = (ci == 0) ? 0.f : -m;
#pragma unroll
        for (int r = 0; r < 16; ++r) S[r] = ninit;
#pragma unroll
        for (int s = 0; s < 4; ++s) { const bf16x8 kf = *(const LAS bf16x8*)(kp + (((2 * s + h) ^ kx) << 4)); S = MFMA32(kf, qf[s], S); }
        if (c == 0) {
#pragma unroll
            for (int r = 0; r < 16; ++r) if (crow(r, h) < r32) S[r] = -INFINITY;
        }
        if (c == 4) {
#pragma unroll
            for (int r = 0; r < 16; ++r) if (crow(r, h) > r32) S[r] = -INFINITY;
        }
        float mx = S[0];
#pragma unroll
        for (int r = 1; r < 16; ++r) mx = fmaxf(mx, S[r]);
        mx = fmaxf(mx, __shfl_xor(mx, 32));
        if (ci == 0 || __builtin_amdgcn_ballot_w64(mx > 8.f) != 0ull) {
            const float d = (ci == 0) ? mx : fmaxf(mx, 0.f), al = fexp2(-d);
            m = ((ci == 0) ? 0.f : m) + d; lp *= al;
#pragma unroll
            for (int r = 0; r < 16; ++r) S[r] -= d;
#pragma unroll
            for (int dt = 0; dt < 2; ++dt)
#pragma unroll
                for (int r = 0; r < 16; ++r) o[dt][r] *= al;
        }
        float rsum = 0.f;
#pragma unroll
        for (int r = 0; r < 16; ++r) { S[r] = fexp2(S[r]); rsum += S[r]; }
        lp += rsum;
        bf16x8 pb[2];
#pragma unroll
        for (int s2 = 0; s2 < 2; ++s2) { u32x4 w; w.x = pk2(S[8 * s2], S[8 * s2 + 1]); w.y = pk2(S[8 * s2 + 2], S[8 * s2 + 3]); w.z = pk2(S[8 * s2 + 4], S[8 * s2 + 5]); w.w = pk2(S[8 * s2 + 6], S[8 * s2 + 7]); pb[s2] = __builtin_bit_cast(bf16x8, w); }
        const LAS unsigned char* trp = lds + A_VOFF + slot0 * A_VS + troff;
#pragma unroll
        for (int dt = 0; dt < 2; ++dt)
#pragma unroll
            for (int s2 = 0; s2 < 2; ++s2) {
                const s16x4 lo = vtr(trp + (16 * s2) * A_VS + dt * 64), hi = vtr(trp + (16 * s2 + 8) * A_VS + dt * 64);
                const bf16x8 va = __builtin_shufflevector(lo, hi, 0, 1, 2, 3, 4, 5, 6, 7);
                o[dt] = MFMA32(va, pb[s2], o[dt]);
            }
    }
    const float l = lp + __shfl_xor(lp, 32), inv = 1.f / l;
    if (h == 0) LSE[((size_t)gi * NTOK + rowq) * 4 + hs] = m + __builtin_amdgcn_logf(l);
    __syncthreads();
    { LAS unsigned char* ot = lds + wave * 4096;
#pragma unroll
      for (int dt = 0; dt < 2; ++dt)
#pragma unroll
          for (int g4 = 0; g4 < 4; ++g4) { u32x2 w; w.x = pk2(o[dt][4 * g4] * inv, o[dt][4 * g4 + 1] * inv); w.y = pk2(o[dt][4 * g4 + 2] * inv, o[dt][4 * g4 + 3] * inv);
              *(LAS u32x2*)(ot + r32 * 128 + (32 * dt + 8 * g4 + 4 * h) * 2) = w; }
      asm volatile("s_waitcnt lgkmcnt(0)" ::: "memory");
#pragma unroll
      for (int i = 0; i < 4; ++i) { const int q = i * 8 + (lane >> 3), c16 = lane & 7;
          const u32x4 w = *(const LAS u32x4*)(ot + q * 128 + c16 * 16);
          const size_t rq = rowb + (size_t)(qsub + q) * dl + jq;
          *(u32x4*)(PO + ((size_t)gi * NTOK + rq) * 256 + hs * 64 + c16 * 8) = w; }
    }
    __syncthreads();
}


DI void attnM_wg(int wu, const bf16_t* QM, const bf16_t* KM, const bf16_t* VM, const float* gqm, const float* gkm, bf16_t* AM, LAS unsigned char* lds, int tid, int lane, int wave) {
    const int qblk = wu & 7, head = (wu >> 3) & 3, b = wu >> 5;
    bf16x8 qf[8];
    { const size_t rowq0 = (size_t)b * SEQ + qblk * 256 + wave * 32 + (lane & 31);
      const bf16_t* qrow0 = QM + rowq0 * 512 + head * 128;
#pragma unroll
      for (int s = 0; s < 8; ++s) qf[s] = *(const bf16x8*)(qrow0 + 16 * s + 8 * (lane >> 5)); }
    { const bf16_t* kb = KM + (size_t)b * NMEM * 512 + head * 128; const bf16_t* vb = VM + (size_t)b * NMEM * 512 + head * 128;
      u32x4 kv[8], vv[8];
#pragma unroll
      for (int i = 0; i < 8; ++i) { const int p = tid + i * 512, row = p >> 4, ch = p & 15;
          kv[i] = *(const u32x4*)(kb + (size_t)row * 512 + ch * 8); vv[i] = *(const u32x4*)(vb + (size_t)row * 512 + ch * 8); }
      const int chl = tid & 15; const f32x4 g0 = *(const f32x4*)(gkm + chl * 8), g1 = *(const f32x4*)(gkm + chl * 8 + 4);
#pragma unroll
      for (int i = 0; i < 8; ++i) { const int p = tid + i * 512, row = p >> 4, ch = p & 15;
          float x[8]; x[0] = bf_lo(kv[i].x); x[1] = bf_hi(kv[i].x); x[2] = bf_lo(kv[i].y); x[3] = bf_hi(kv[i].y); x[4] = bf_lo(kv[i].z); x[5] = bf_hi(kv[i].z); x[6] = bf_lo(kv[i].w); x[7] = bf_hi(kv[i].w);
          float ss = (x[0] * x[0] + x[1] * x[1]) + (x[2] * x[2] + x[3] * x[3]) + (x[4] * x[4] + x[5] * x[5]) + (x[6] * x[6] + x[7] * x[7]);
          ss += __shfl_xor(ss, 1); ss += __shfl_xor(ss, 2); ss += __shfl_xor(ss, 4); ss += __shfl_xor(ss, 8);
          const float rs = __builtin_amdgcn_rsqf(ss * (1.f / 128.f) + EPS);
          u32x4 kn; kn.x = pk2(x[0] * rs * g0.x, x[1] * rs * g0.y); kn.y = pk2(x[2] * rs * g0.z, x[3] * rs * g0.w); kn.z = pk2(x[4] * rs * g1.x, x[5] * rs * g1.y); kn.w = pk2(x[6] * rs * g1.z, x[7] * rs * g1.w);
          const int off = img256(row, ch); *(LAS u32x4*)(lds + off) = kn; *(LAS u32x4*)(lds + M_VOFF + off) = vv[i]; } }
    __syncthreads();
    const int r32 = lane & 31, h = lane >> 5;
    const int q4 = (lane & 15) >> 2, p4 = lane & 3, blk = (lane >> 4) & 1;
    const int kxor = ((r32 & 3) << 2) | ((r32 >> 2) & 3);
    const int vlow0 = ((2 * blk + (p4 >> 1)) ^ (h & 3)) << 4, vlow1 = ((2 * blk + (p4 >> 1)) ^ ((h + 2) & 3)) << 4;
    {
        const size_t rowq = (size_t)b * SEQ + qblk * 256 + wave * 32 + r32;
        { float ss = 0.f;
#pragma unroll
          for (int s = 0; s < 8; ++s)
#pragma unroll
              for (int jx = 0; jx < 8; ++jx) { const float x = bf2f(qf[s][jx]); ss += x * x; }
          ss += __shfl_xor(ss, 32);
          const float rs = __builtin_amdgcn_rsqf(ss * (1.f / 128.f) + EPS) * QSCALE_M;
#pragma unroll
          for (int s = 0; s < 8; ++s) {
              const f32x4 g0 = *(const f32x4*)(gqm + 16 * s + 8 * h), g1 = *(const f32x4*)(gqm + 16 * s + 8 * h + 4);
              u32x4 w;
              w.x = pk2(bf2f(qf[s][0]) * rs * g0.x, bf2f(qf[s][1]) * rs * g0.y); w.y = pk2(bf2f(qf[s][2]) * rs * g0.z, bf2f(qf[s][3]) * rs * g0.w);
              w.z = pk2(bf2f(qf[s][4]) * rs * g1.x, bf2f(qf[s][5]) * rs * g1.y); w.w = pk2(bf2f(qf[s][6]) * rs * g1.z, bf2f(qf[s][7]) * rs * g1.w);
              qf[s] = __builtin_bit_cast(bf16x8, w); } }
        f32x16 o[4];
#pragma unroll
        for (int dt = 0; dt < 4; ++dt)
#pragma unroll
            for (int r = 0; r < 16; ++r) o[dt][r] = 0.f;
        float m = -INFINITY, lp = 0.f;
#pragma unroll 1
        for (int c = 0; c < 8; ++c) {
            const int slot0 = 32 * c;
            const LAS unsigned char* kp = lds + (slot0 + r32) * 256;
            f32x16 S;
            const float ninit = (c == 0) ? 0.f : -m;
#pragma unroll
            for (int r = 0; r < 16; ++r) S[r] = ninit;
#pragma unroll
            for (int s = 0; s < 8; ++s) { const bf16x8 kf = *(const LAS bf16x8*)(kp + (((2 * s + h) ^ kxor) << 4)); S = MFMA32(kf, qf[s], S); }
            float mx = S[0];
#pragma unroll
            for (int r = 1; r < 16; ++r) mx = fmaxf(mx, S[r]);
            mx = fmaxf(mx, __shfl_xor(mx, 32));
            if (c == 0 || __builtin_amdgcn_ballot_w64(mx > 8.f) != 0ull) {
                const float d = (c == 0) ? mx : fmaxf(mx, 0.f), al = fexp2(-d);
                m = ((c == 0) ? 0.f : m) + d; lp *= al;
#pragma unroll
                for (int r = 0; r < 16; ++r) S[r] -= d;
#pragma unroll
                for (int dt = 0; dt < 4; ++dt)
#pragma unroll
                    for (int r = 0; r < 16; ++r) o[dt][r] *= al;
            }
            float rsum = 0.f;
#pragma unroll
            for (int r = 0; r < 16; ++r) { S[r] = fexp2(S[r]); rsum += S[r]; }
            lp += rsum;
            bf16x8 pb[2];
#pragma unroll
            for (int s2 = 0; s2 < 2; ++s2) { u32x4 w; w.x = pk2(S[8 * s2], S[8 * s2 + 1]); w.y = pk2(S[8 * s2 + 2], S[8 * s2 + 3]); w.z = pk2(S[8 * s2 + 4], S[8 * s2 + 5]); w.w = pk2(S[8 * s2 + 6], S[8 * s2 + 7]); pb[s2] = __builtin_bit_cast(bf16x8, w); }
            const LAS unsigned char* vp = lds + M_VOFF + (slot0 + 4 * h + q4) * 256 + (p4 & 1) * 8;
#pragma unroll
            for (int dt = 0; dt < 4; ++dt)
#pragma unroll
                for (int s2 = 0; s2 < 2; ++s2) {
                    const s16x4 lo = vtr(vp + (16 * s2) * 256 + ((dt ^ q4) << 6) + vlow0), hi = vtr(vp + (16 * s2 + 8) * 256 + ((dt ^ q4) << 6) + vlow1);
                    const bf16x8 va = __builtin_shufflevector(lo, hi, 0, 1, 2, 3, 4, 5, 6, 7);
                    o[dt] = MFMA32(va, pb[s2], o[dt]);
                }
        }
        const float l = lp + __shfl_xor(lp, 32), inv = 1.f / l;
        __syncthreads();
        LAS unsigned char* ot = lds + wave * 8192;
#pragma unroll
        for (int dt = 0; dt < 4; ++dt)
#pragma unroll
            for (int g4 = 0; g4 < 4; ++g4) { u32x2 w; w.x = pk2(o[dt][4 * g4] * inv, o[dt][4 * g4 + 1] * inv); w.y = pk2(o[dt][4 * g4 + 2] * inv, o[dt][4 * g4 + 3] * inv);
                *(LAS u32x2*)(ot + r32 * 256 + (32 * dt + 8 * g4 + 4 * h) * 2) = w; }
        asm volatile("s_waitcnt lgkmcnt(0)" ::: "memory");
        const size_t rowq0 = (size_t)b * SEQ + qblk * 256 + wave * 32;
#pragma unroll
        for (int i = 0; i < 8; ++i) { const int q = i * 4 + (lane >> 4), c16 = lane & 15;
            const u32x4 w = *(const LAS u32x4*)(ot + q * 256 + c16 * 16);
            *(u32x4*)(AM + (rowq0 + q) * 1536 + 1024 + head * 128 + c16 * 8) = w; }
    }
    __syncthreads();
}

DI void p2_attnA(const Args& a, LAS unsigned char* lds, int tid, int lane, int wave) {
    unsigned char* ws = a.ws; const int G = gridDim.x; const int vcu = (G % 8 == 0) ? ((int)blockIdx.x % 8) * (G / 8) + (int)blockIdx.x / 8 : (int)blockIdx.x;
    const bf16_t* Q = (const bf16_t*)(ws + WS_Q); const bf16_t* K = (const bf16_t*)(ws + WS_K); const bf16_t* V = (const bf16_t*)(ws + WS_V);
    bf16_t* PO = (bf16_t*)(ws + WS_PO); float* LSE = (float*)(ws + WS_LSE);
    constexpr int NU = NB * 12 * 8;
    const int per = (NU + G - 1) / G, u0 = vcu * per, u1 = (u0 + per < NU) ? u0 + per : NU;
    if (u0 >= u1) return;
    u32x4 kv[6], vv[6]; unsigned okm; bf16x8 qn[4];
    AUnit cu = a_decode(u0);
    a_issue(cu, Q, K, V, tid, lane, wave, kv, vv, okm, qn);
    for (int u = u0; u < u1; ++u) {
        a_fill(lds, tid, kv, vv, okm);
        bf16x8 qf[4];
#pragma unroll
        for (int s = 0; s < 4; ++s) qf[s] = qn[s];
        __syncthreads();
        AUnit nu = cu;
        if (u + 1 < u1) { nu = a_decode(u + 1); a_issue(nu, Q, K, V, tid, lane, wave, kv, vv, okm, qn); }
        a_compute(cu, qf, PO, LSE, lds, lane, wave);
        cu = nu;
    }
}
DI void p2_attnM(const Args& a, LAS unsigned char* lds, int tid, int lane, int wave) {
    unsigned char* ws = a.ws; unsigned char* dob = (unsigned char*)a.out; const int G = gridDim.x; const int vcu = (G % 8 == 0) ? ((int)blockIdx.x % 8) * (G / 8) + (int)blockIdx.x / 8 : (int)blockIdx.x;
    bf16_t* AM = (bf16_t*)(ws + WS_AM);
    const bf16_t* QM = (const bf16_t*)(dob + DO_QM); const bf16_t* KM = (const bf16_t*)(dob + DO_KM); const bf16_t* VM = (const bf16_t*)(dob + DO_VM);
    for (int u = vcu; u < NB * 4 * 8; u += G) attnM_wg(u, QM, KM, VM, (const float*)a.in[I_GQM], (const float*)a.in[I_GKM], AM, lds, tid, lane, wave);
}
DI void p2_conv(const Args& a, LAS unsigned char* lds, int tid) {
    unsigned char* ws = a.ws; bf16_t* AM = (bf16_t*)(ws + WS_AM);
    const bf16_t* U = (const bf16_t*)(ws + WS_U); const bf16_t* CB = (const bf16_t*)(ws + WS_CB); const float* wc = (const float*)a.in[I_WCONV];
    constexpr int TB = 4;
    constexpr int NCH = (NTOK / TB) * 96 / 512;
    unsigned* ctr = (unsigned*)(ws + WS_CTL) + 768; LAS int* slot = (LAS int*)(lds + MISC_OFF + 8192 + 64);
    __syncthreads(); int cur = (int)blockIdx.x; int qpar = 0;
    while (cur < NCH) {
        int nxt = 0; if (tid == 0) nxt = (int)atomicAdd(ctr, 1u) + (int)gridDim.x;
        const int idx = cur * 512 + tid;
        const int tb = idx / 96, c8 = (idx % 96) * 8, row0 = tb * TB, s0 = row0 & (SEQ - 1);
        u32x4 uu[TB + 2], cb[TB];
        const u32x4 zero = {0u, 0u, 0u, 0u};
        uu[0] = (s0 > 0) ? *(const u32x4*)(U + (size_t)(row0 - 1) * 768 + c8) : zero;
#pragma unroll
        for (int t = 0; t < TB; ++t) { uu[t + 1] = *(const u32x4*)(U + (size_t)(row0 + t) * 768 + c8); cb[t] = *(const u32x4*)(CB + (size_t)(row0 + t) * 768 + c8); }
        uu[TB + 1] = (s0 + TB < SEQ) ? *(const u32x4*)(U + (size_t)(row0 + TB) * 768 + c8) : zero;
        float k0[8], k1[8], k2[8];
        { const f32x4 a0 = *(const f32x4*)(wc + c8), a1 = *(const f32x4*)(wc + c8 + 4), b0 = *(const f32x4*)(wc + 768 + c8), b1 = *(const f32x4*)(wc + 768 + c8 + 4),
                      d0 = *(const f32x4*)(wc + 1536 + c8), d1 = *(const f32x4*)(wc + 1536 + c8 + 4);
#pragma unroll
          for (int q = 0; q < 4; ++q) { k0[q] = a0[q]; k0[4 + q] = a1[q]; k1[q] = b0[q]; k1[4 + q] = b1[q]; k2[q] = d0[q]; k2[4 + q] = d1[q]; } }
#pragma unroll
        for (int t = 0; t < TB; ++t) {
            u32x4 o;
#pragma unroll
            for (int w = 0; w < 4; ++w) {
                const float y0 = k0[2 * w] * bf_lo(uu[t][w]) + k1[2 * w] * bf_lo(uu[t + 1][w]) + k2[2 * w] * bf_lo(uu[t + 2][w]);
                const float y1 = k0[2 * w + 1] * bf_hi(uu[t][w]) + k1[2 * w + 1] * bf_hi(uu[t + 1][w]) + k2[2 * w + 1] * bf_hi(uu[t + 2][w]);
                o[w] = pk2(bf_lo(cb[t][w]) * y0, bf_hi(cb[t][w]) * y1);
            }
            *(u32x4*)(AM + (size_t)(row0 + t) * 1536 + 256 + c8) = o;
        }
        qpar ^= 1; if (tid == 0) slot[qpar] = nxt;
        __syncthreads(); cur = slot[qpar];
    }
}
#ifndef P2_ALT
#define P2_ALT 0
#endif
#ifndef P2_REP
#define P2_REP 0
#endif
DI void phase2(const Args& a, LAS unsigned char* lds, int tid, int lane, int wave) {
#ifndef P2_PARTS
#define P2_PARTS 7
#endif
#ifndef TPROBE_P2
#define TPROBE_P2 0
#endif
#define P2_T0(bit) unsigned long long tp_ = 0; if constexpr ((TPROBE_P2) & (bit)) { if (tid == 0) tp_ = __builtin_amdgcn_s_memrealtime(); }
#define P2_T1(bit) if constexpr ((TPROBE_P2) & (bit)) { __syncthreads(); if (tid == 0) ((volatile LAS unsigned*)(lds + MISC_OFF + 8192))[2] += (unsigned)(__builtin_amdgcn_s_memrealtime() - tp_); }
    const bool alt = (P2_ALT) && (((int)blockIdx.x >> 3) & 1);
    if (alt) { p2_attnM(a, lds, tid, lane, wave); __syncthreads(); }
    __builtin_amdgcn_sched_barrier(0); asm volatile("" ::: "memory");
    { P2_T0(1) if constexpr (P2_PARTS & 1) p2_attnA(a, lds, tid, lane, wave); P2_T1(1) }
    if constexpr (P2_REP & 1) p2_attnA(a, lds, tid, lane, wave);
    __builtin_amdgcn_sched_barrier(0); asm volatile("" ::: "memory");
    if (!alt) { P2_T0(2) if constexpr (P2_PARTS & 2) p2_attnM(a, lds, tid, lane, wave); P2_T1(2) }
    if constexpr (P2_REP & 2) p2_attnM(a, lds, tid, lane, wave);
    { P2_T0(4) if constexpr (P2_PARTS & 4) p2_conv(a, lds, tid); P2_T1(4) }
    if constexpr (P2_REP & 4) p2_conv(a, lds, tid);
}

DI void attn_combine(const Args& a, LAS unsigned char* lds, int tid) {
    unsigned char* ws = a.ws;
    const bf16_t* PO = (const bf16_t*)(ws + WS_PO); const float* LSE = (const float*)(ws + WS_LSE); bf16_t* AM = (bf16_t*)(ws + WS_AM);
    constexpr int NCH = NTOK * 32 / 1024;
    unsigned* ctr = (unsigned*)(ws + WS_CTL) + 832; LAS int* slot = (LAS int*)(lds + MISC_OFF + 8192 + 64);
    __syncthreads();
    __syncthreads(); int cur = (int)blockIdx.x; int qpar = 0;
    while (cur < NCH) {
        int nxt = 0; if (tid == 0) nxt = (int)atomicAdd(ctr, 1u) + (int)gridDim.x;
#pragma unroll
      for (int half = 0; half < 2; ++half) {
        const int idx = cur * 1024 + half * 512 + tid;
        const int row = idx >> 5, c8 = (idx & 31) * 8, hs = c8 >> 6;
        const float l0 = LSE[(size_t)row * 4 + hs], l1 = LSE[((size_t)NTOK + row) * 4 + hs], l2 = LSE[((size_t)2 * NTOK + row) * 4 + hs];
        const float mx = fmaxf(l0, fmaxf(l1, l2)); float w0 = fexp2(l0 - mx), w1 = fexp2(l1 - mx), w2 = fexp2(l2 - mx);
        const float inv = 1.f / (w0 + w1 + w2); w0 *= inv; w1 *= inv; w2 *= inv;
        const u32x4 a0 = *(const u32x4*)(PO + (size_t)row * 256 + c8), a1 = *(const u32x4*)(PO + ((size_t)NTOK + row) * 256 + c8), a2 = *(const u32x4*)(PO + ((size_t)2 * NTOK + row) * 256 + c8);
        u32x4 o;
#pragma unroll
        for (int w = 0; w < 4; ++w) o[w] = pk2(w0 * bf_lo(a0[w]) + w1 * bf_lo(a1[w]) + w2 * bf_lo(a2[w]), w0 * bf_hi(a0[w]) + w1 * bf_hi(a1[w]) + w2 * bf_hi(a2[w]));
        *(u32x4*)(AM + (size_t)row * 1536 + c8) = o;
      }
        qpar ^= 1; if (tid == 0) slot[qpar] = nxt;
        __syncthreads(); cur = slot[qpar];
    }
}

DI void phase6(const Args& a, LAS unsigned char* lds, int tid, int lane, int wave) {
    unsigned char* ws = a.ws;
    const bf16_t* XB = (const bf16_t*)(ws + WS_XB);
    const bf16_t* WH = (const bf16_t*)(ws + WS_WRH); const bf16_t* WL = (const bf16_t*)(ws + WS_WRL);
    const float* brg = (const float*)a.in[I_BRG]; const float* bre = (const float*)a.in[I_BRE];
    unsigned* gcnt = (unsigned*)(ws + WS_CTL) + 544;
    u32x2* sr_dw = (u32x2*)(ws + WS_SDW); int* rowtok = (int*)(ws + WS_SROWTOK); float* sr_rstd = (float*)(ws + WS_SRSTD);
    LAS int* asg = (LAS int*)(lds + 32768);
    LAS int* rnk = (LAS int*)(lds + 32768 + 1024);
    LAS float* asgw = (LAS float*)(lds + 32768 + 2048);
    LAS float* rsl = (LAS float*)(lds + 32768 + 3072);
    LAS int* gb = (LAS int*)(lds + 32768 + 3584);
    bool first = true;
    for (int chunk = blockIdx.x; chunk < NTOK / 128; chunk += gridDim.x) {
#ifndef TPROBE_P6
#define TPROBE_P6 0
#endif
#define P6_MARK(bit, acc_) do { if constexpr ((TPROBE_P6) != 0) { if (tid == 0) { const unsigned long long now_ = __builtin_amdgcn_s_memrealtime(); if ((TPROBE_P6) & (bit)) ((volatile LAS unsigned*)(lds + MISC_OFF + 8192))[2] += (unsigned)(now_ - acc_); acc_ = now_; } } } while (0)
        unsigned long long tm6_ = 0; if constexpr ((TPROBE_P6) != 0) { if (tid == 0) tm6_ = __builtin_amdgcn_s_memrealtime(); }
            constexpr int WP = 272;
            constexpr int SLB = 48 * WP;
            LAS unsigned char* wbuf = lds + 40960;
            LAS float* lg = (LAS float*)(lds + wave * 4096);
            const int t0 = chunk * 128 + wave * 16, row = lane & 15, kq = lane >> 4;
            const bf16_t* xp = XB + (size_t)(t0 + row) * 1024 + 8 * kq;
            u32x4 wst[3];
#define RT_STAGE_LOAD(sl) do { _Pragma("unroll") for (int i = 0; i < 3; ++i) { const int p = tid + i * 512, arr = p / 768, q = p % 768, r = q >> 4, c = q & 15; \
                wst[i] = *(const u32x4*)((arr ? WL : WH) + (size_t)r * 1024 + (sl) * 128 + c * 8); } } while (0)
#define RT_STAGE_WRITE(buf) do { _Pragma("unroll") for (int i = 0; i < 3; ++i) { const int p = tid + i * 512, arr = p / 768, q = p % 768, r = q >> 4, c = q & 15; \
                *(LAS u32x4*)(wbuf + ((buf) * 2 + arr) * SLB + r * WP + c * 16) = wst[i]; } } while (0)
            u32x4 xall[8][4];
#pragma unroll
            for (int sl = 0; sl < 8; ++sl)
#pragma unroll
                for (int ks = 0; ks < 4; ++ks) xall[sl][ks] = *(const u32x4*)(xp + sl * 128 + 32 * ks);
            RT_STAGE_LOAD(0); RT_STAGE_WRITE(0); RT_STAGE_LOAD(1); RT_STAGE_WRITE(1);
            __syncthreads();
            pg8::f32x4 acc[3]; acc[0] = acc[1] = acc[2] = (pg8::f32x4){0.f, 0.f, 0.f, 0.f};
            float ss = 0.f, amax = 0.f;
#pragma unroll
            for (int sl = 0; sl < 8; ++sl) {
                if (sl + 2 < 8) RT_STAGE_LOAD(sl + 2);
                const LAS unsigned char* wb = wbuf + (sl % 3) * 2 * SLB;
#pragma unroll
                for (int ks = 0; ks < 4; ++ks) {
                    const u32x4 hi = xall[sl][ks];
#pragma unroll
                    for (int w = 0; w < 4; ++w) { const float e0 = bf_lo(hi[w]), e1 = bf_hi(hi[w]); ss += e0 * e0 + e1 * e1; amax = fmaxf(amax, fmaxf(fabsf(e0), fabsf(e1))); }
                    const bf16x8 ah = __builtin_bit_cast(bf16x8, hi);
#pragma unroll
                    for (int nt = 0; nt < 3; ++nt) {
                        const bf16x8 bh = *(const LAS bf16x8*)(wb + (16 * nt + row) * WP + (32 * ks + 8 * kq) * 2);
                        const bf16x8 bl = *(const LAS bf16x8*)(wb + SLB + (16 * nt + row) * WP + (32 * ks + 8 * kq) * 2);
                        acc[nt] = MFMA16(ah, bh, acc[nt]); acc[nt] = MFMA16(ah, bl, acc[nt]);
                    }
                }
                if (sl + 2 < 8) RT_STAGE_WRITE((sl + 2) % 3);
                __syncthreads();
            }
#undef RT_STAGE_LOAD
#undef RT_STAGE_WRITE
            ss += __shfl_xor(ss, 16); ss += __shfl_xor(ss, 32);
            amax = fmaxf(amax, __shfl_xor(amax, 16)); amax = fmaxf(amax, __shfl_xor(amax, 32));
            P6_MARK(1, tm6_);
            P6_MARK(2, tm6_);
#pragma unroll
            for (int nt = 0; nt < 3; ++nt)
#pragma unroll
                for (int r = 0; r < 4; ++r) lg[(kq * 4 + r) * 48 + 16 * nt + row] = acc[nt][r];
            asm volatile("s_waitcnt lgkmcnt(0)" ::: "memory");
            if (lane < 16) {
                const int tok = t0 + lane; const float rstd = __builtin_amdgcn_rsqf(ss * (1.f / 1024.f) + EPS);
                const LAS float* lp = lg + lane * 48;
                float gv[4]; int g = 0;
#pragma unroll
                for (int n = 0; n < 4; ++n) gv[n] = lp[n] * rstd + brg[n];
                float gm = gv[0];
#pragma unroll
                for (int n = 1; n < 4; ++n) if (gv[n] > gm) { gm = gv[n]; g = n; }
                float gz = 0.f;
#pragma unroll
                for (int n = 0; n < 4; ++n) gz += fexp(gv[n] - gm);
                const float pg = 1.f / gz;
                float sv[8];
#pragma unroll
                for (int e = 0; e < 8; ++e) sv[e] = lp[4 + 8 * g + e] * rstd + bre[8 * g + e];
                int i0 = 0; float s0 = sv[0];
#pragma unroll
                for (int e = 1; e < 8; ++e) if (sv[e] > s0) { s0 = sv[e]; i0 = e; }
                int i1 = -1; float s1 = -INFINITY;
#pragma unroll
                for (int e = 0; e < 8; ++e) if (e != i0 && sv[e] > s1) { s1 = sv[e]; i1 = e; }
                const float r = fexp(s1 - s0), w0 = pg / (1.f + r), w1 = w0 * r;
                const int al2 = (wave * 16 + lane) * 2;
                asg[al2] = g * 8 + i0; asg[al2 + 1] = g * 8 + i1;
                asgw[al2] = w0; asgw[al2 + 1] = w1; rsl[wave * 16 + lane] = rstd * amax * (1.f / 127.f);
            }
        first = false;
        __syncthreads();
        int my_e = 0, my_rank = 0;
        if (tid < 256) { my_e = asg[tid];
            for (int ee = 0; ee < 32; ++ee) { const unsigned long long mk = __ballot(my_e == ee);
                if (my_e == ee) my_rank = __popcll(mk & ((1ull << lane) - 1ull));
                if (lane == 0) rnk[wave * 32 + ee] = __popcll(mk); } }
        __syncthreads();
        int gres = 0;
        if (tid < 32) { const int cnt = rnk[tid] + rnk[32 + tid] + rnk[64 + tid] + rnk[96 + tid]; gres = cnt > 0 ? (int)atomicAdd(gcnt + tid, (unsigned)cnt) : 0; }
            {
                const float inv = amax > 0.f ? 127.f / amax : 0.f;
                LAS unsigned char* cs = lds + wave * 4096;
                const int wofs = row * 128 + 8 * (kq & 1), wsw = (row >> 1) & 7, wch = kq >> 1;
                const int rr = lane >> 2, rseg = lane & 3, rsw = (rr >> 1) & 7;
                unsigned char* orow = ws + WS_XB8 + (size_t)(t0 + rr) * 1024 + 16 * rseg;
#pragma unroll
                for (int sl = 0; sl < 8; ++sl) {
                    LAS unsigned char* cb = cs + (sl & 1) * 2048;
#pragma unroll
                    for (int ks = 0; ks < 4; ++ks) { u32x4 h = xall[sl][ks]; asm volatile("" : "+v"(h));     u32x2 o;
                        o.x = q8x4(bf_lo(h.x) * inv, bf_hi(h.x) * inv, bf_lo(h.y) * inv, bf_hi(h.y) * inv); o.y = q8x4(bf_lo(h.z) * inv, bf_hi(h.z) * inv, bf_lo(h.w) * inv, bf_hi(h.w) * inv);
                        *(LAS u32x2*)(cb + wofs + (((2 * ks + wch) ^ wsw) << 4)) = o; }
                    asm volatile("s_waitcnt lgkmcnt(0)" ::: "memory");
                    const u32x4 q0 = *(const LAS u32x4*)(cb + rr * 128 + ((rseg ^ rsw) << 4)), q1 = *(const LAS u32x4*)(cb + rr * 128 + (((rseg + 4) ^ rsw) << 4));
                    *(u32x4*)(orow + sl * 128) = q0; *(u32x4*)(orow + sl * 128 + 64) = q1;
                    asm volatile("" ::: "memory");
                }
            }
        if (tid < 32) gb[tid] = gres;
        __syncthreads();
        if (tid < 256) { int base = gb[my_e];
            for (int w = 0; w < wave; ++w) base += rnk[w * 32 + my_e];
            const int tok = chunk * 128 + (tid >> 1); const size_t idx = (size_t)my_e * ECAP + (size_t)(base + my_rank);
            u32x2 rec; rec.x = (unsigned)(tok * 2 + (tid & 1)); rec.y = __float_as_uint(asgw[tid]); sr_dw[idx] = rec; rowtok[idx] = tok; sr_rstd[idx] = rsl[tid >> 1]; }
        __syncthreads();
        P6_MARK(4, tm6_);
    }
}

DI void moe_weight_convert(const Args& a, LAS unsigned char* lds, int tid, int lane, int wave) {
    unsigned char* ws = a.ws;
    unsigned char* WGU = ws + WS_WGU; float* SB = (float*)(ws + WS_SB);
    const float* wg = (const float*)a.in[I_WGATE]; const float* wu = (const float*)a.in[I_WUP]; const float* gf = (const float*)a.in[I_GFFN];
    unsigned* ctr = (unsigned*)(ws + WS_CTL) + 640; LAS int* slot = (LAS int*)(lds + MISC_OFF + 8192 + 64); LAS float* red = (LAS float*)lds;
    constexpr int NS = 32 * 32 + 96;
    f32x4 kgn[2][2];
#pragma unroll
    for (int b = 0; b < 2; ++b) { kgn[b][0] = *(const f32x4*)(gf + 128 * wave + 64 * b + 8 * (lane >> 3)); kgn[b][1] = *(const f32x4*)(gf + 128 * wave + 64 * b + 8 * (lane >> 3) + 4); }
    const float* win = (const float*)a.in[I_WIN];
#define QS_UP(it)  ((((it) & 7) * 32) >= 128)
#define QS_SRC(it) ((it) >= 1024 ? win : (QS_UP(it) ? wu : wg) + (size_t)((it) >> 5) * 1024 * 512), ((it) >= 1024 ? 8192 : 512), \
                   ((it) >= 1024 ? orig_col8(5120 + 32 * ((it) - 1024)) : 128 * (((it) & 31) >> 3) + (QS_UP(it) ? ((it) & 7) * 32 - 128 : ((it) & 7) * 32)), ((it) >= 1024)
#define QS_DST(it) ((it) < 1024), ((it) >= 1024 ? ws + WS_WIN : WGU + (size_t)((it) >> 5) * 1024 * 1024), ((it) >= 1024 ? 5120 + 32 * ((it) - 1024) : ((it) & 31) * 32), \
                   ((it) >= 1024 ? (float*)(ws + WS_SW) + 5120 + 32 * ((it) - 1024) : SB + (size_t)((it) >> 5) * 1024 + ((it) & 31) * 32)
    f32x4 va[2][8], vb[2][8];
    int ia = dyn_next1(ctr, slot, tid, 0);
    if (ia >= NS) { __syncthreads(); return; }
    qs_issue(QS_SRC(ia), lane, wave, va);
    for (;;) {
        __builtin_amdgcn_sched_barrier(0);
        const int ib = dyn_next1(ctr, slot, tid, 1);
        if (ib < NS) qs_issue(QS_SRC(ib), lane, wave, vb);
        __builtin_amdgcn_sched_barrier(0);
        qs_finish(va, kgn, QS_DST(ia), red, lane, wave);
        if (ib >= NS) break;
        __builtin_amdgcn_sched_barrier(0);
        ia = dyn_next1(ctr, slot, tid, 0);
        if (ia < NS) qs_issue(QS_SRC(ia), lane, wave, va);
        __builtin_amdgcn_sched_barrier(0);
        qs_finish(vb, kgn, QS_DST(ib), red + 256, lane, wave);
        if (ia >= NS) break;
    }
#undef QS_UP
#undef QS_SRC
#undef QS_DST
}
DI void moe_wd_convert(const Args& a, int wgi, int nwg, int lane, int wave) {
    bf16_t* WD = (bf16_t*)(a.ws + WS_WD); const float* wd = (const float*)a.in[I_WDOWN];
    const int kg = lane >> 3, nq = lane & 7, step = nwg * 8;
    for (int it = wgi * 8 + wave; it < 32 * 8 * 32; it += 2 * step) {
        f32x4 v[2][8]; bool ok[2]; size_t dofs[2];
#pragma unroll
        for (int h = 0; h < 2; ++h) { const int i2 = it + h * step; ok[h] = i2 < 32 * 8 * 32; const int i3 = ok[h] ? i2 : it;
            const int e = i3 >> 8, r = i3 & 255, kb = r >> 5, nb = r & 31;
            const float* sp = wd + (size_t)e * 512 * 1024 + (size_t)(kb * 64 + 8 * kg) * 1024 + nb * 32 + 4 * nq;
#pragma unroll
            for (int j = 0; j < 8; ++j) v[h][j] = ldnt((const f32x4*)(sp + (size_t)j * 1024));
            dofs[h] = (size_t)e * 1024 * 512 + (size_t)(nb * 32 + 4 * nq) * 512 + kb * 64 + 8 * kg; }
#pragma unroll
        for (int h = 0; h < 2; ++h) if (ok[h]) {
#pragma unroll
            for (int q = 0; q < 4; ++q) { u32x4 o; o.x = pk2(v[h][0][q], v[h][1][q]); o.y = pk2(v[h][2][q], v[h][3][q]); o.z = pk2(v[h][4][q], v[h][5][q]); o.w = pk2(v[h][6][q], v[h][7][q]);
                *(u32x4*)(WD + dofs[h] + (size_t)q * 512) = o; } }
    }
}

DI int build_tile_table(const Args& a, LAS unsigned char* lds, int tid) {
    const unsigned* gcnt = (const unsigned*)(a.ws + WS_CTL) + 544;
    LAS int* tbl = (LAS int*)(lds + MISC_OFF); LAS int* tsb = (LAS int*)(lds + MISC_OFF + 8448); LAS int* tnv = tsb + 320; LAS int* tf = tnv + 320; LAS int* cn = tf + 40;
    (void)cn;
    if (tid < 64) {
        const int e = tid & 31; const int c = (tid < 32) ? (int)__hip_atomic_load(gcnt + e, __ATOMIC_RELAXED, __HIP_MEMORY_SCOPE_AGENT) : 0;
        const int ntl = (c + 255) >> 8; int incl = ntl;
#pragma unroll
        for (int o = 1; o < 32; o <<= 1) { const int v = __shfl_up(incl, o); if ((tid & 63) >= o) incl += v; }
        const int first = incl - ntl;
        if (tid < 32) { tf[e] = first; if (e == 31) tf[32] = incl;
            for (int k = 0; k < ntl; ++k) { const int t = first + k, left = c - 256 * k; tbl[t] = e; tsb[t] = e * ECAP - 256 * first; tnv[t] = left < 256 ? left : 256; } }
    }
    __syncthreads();
    const int nt = tf[32];
    return nt;
}

DI void phase10(const Args& a, LAS unsigned char* lds, int tid, int lane, int wave) {
    const bf16_t* Y = (const bf16_t*)(a.ws + WS_Y); const bf16_t* XB = (const bf16_t*)(a.ws + WS_XB); float* O = a.out;
    constexpr int NCH = NTOK / 16, NGW = 8;
    unsigned* ctr = (unsigned*)(a.ws + WS_CTL) + 896; LAS int* slot = (LAS int*)(lds + MISC_OFF + 8192 + 64);
    __syncthreads(); int cur = (int)blockIdx.x; int qpar = 0;
    while (cur < NCH) {
        int nxt = 0; if (tid == 0) nxt = (int)atomicAdd(ctr, 1u) + (int)gridDim.x;
        const int tok0 = cur * 16 + wave;
        u32x4 xv[2][2], y0[2][2], y1[2][2];
#pragma unroll
        for (int t = 0; t < 2; ++t) { const int tok = tok0 + t * NGW;
#pragma unroll
            for (int j = 0; j < 2; ++j) { const size_t c = (size_t)j * 512 + lane * 8;
                xv[t][j] = *(const u32x4*)(XB + (size_t)tok * 1024 + c); y0[t][j] = *(const u32x4*)(Y + (size_t)(tok * 2) * 1024 + c); y1[t][j] = *(const u32x4*)(Y + (size_t)(tok * 2 + 1) * 1024 + c); } }
#pragma unroll
        for (int t = 0; t < 2; ++t) { const int tok = tok0 + t * NGW;
#pragma unroll
            for (int j = 0; j < 2; ++j) { const size_t c = (size_t)j * 512 + lane * 8;
                f32x4 o0, o1;
                o0.x = bf_lo(xv[t][j].x) + bf_lo(y0[t][j].x) + bf_lo(y1[t][j].x); o0.y = bf_hi(xv[t][j].x) + bf_hi(y0[t][j].x) + bf_hi(y1[t][j].x);
                o0.z = bf_lo(xv[t][j].y) + bf_lo(y0[t][j].y) + bf_lo(y1[t][j].y); o0.w = bf_hi(xv[t][j].y) + bf_hi(y0[t][j].y) + bf_hi(y1[t][j].y);
                o1.x = bf_lo(xv[t][j].z) + bf_lo(y0[t][j].z) + bf_lo(y1[t][j].z); o1.y = bf_hi(xv[t][j].z) + bf_hi(y0[t][j].z) + bf_hi(y1[t][j].z);
                o1.z = bf_lo(xv[t][j].w) + bf_lo(y0[t][j].w) + bf_lo(y1[t][j].w); o1.w = bf_hi(xv[t][j].w) + bf_hi(y0[t][j].w) + bf_hi(y1[t][j].w);
                __builtin_nontemporal_store(o0, (f32x4*)(O + (size_t)tok * 1024 + c)); __builtin_nontemporal_store(o1, (f32x4*)(O + (size_t)tok * 1024 + c + 4)); } }
        qpar ^= 1; if (tid == 0) slot[qpar] = nxt;
        __syncthreads(); cur = slot[qpar];
    }
}

#define VM_WAIT() asm volatile("s_waitcnt vmcnt(0)" ::: "memory")
#define XB_TMO      128
#define XB_XCNT(j)  (256  + 64 * (j))
#define XB_XSUB(j)  (1280 + 64 * (j))
#define XB_XGEN(j)  (2304 + 64 * (j))
#define XB_TOP      3328
#define XB_TOPGEN   3392
#define XCD_BAR_WORDS 3456
#define XB_SPIN_CAP (1u << 18)

__device__ __forceinline__ unsigned xb_ld(unsigned* p)              { return __hip_atomic_load(p, __ATOMIC_RELAXED, __HIP_MEMORY_SCOPE_AGENT); }
__device__ __forceinline__ unsigned xb_add(unsigned* p, unsigned v) { return __hip_atomic_fetch_add(p, v, __ATOMIC_RELAXED, __HIP_MEMORY_SCOPE_AGENT); }
__device__ __forceinline__ unsigned xb_xcc_id() { return (unsigned)__builtin_amdgcn_s_getreg((3 << 11) | 20) & 0xFu; }
#define XB_SPIN(cond, bar) do { unsigned _sp = 0; while (cond) { __builtin_amdgcn_s_sleep(1); \
    if ((++_sp & 255u) == 0u) { if (xb_ld(&(bar)[XB_TMO])) break; if (_sp > XB_SPIN_CAP) { atomicAdd(&(bar)[XB_TMO], 1u); break; } } } } while (0)

struct XcdBarrier {
    unsigned* bar; unsigned x;
    volatile LAS unsigned* st;
};

__device__ __forceinline__ XcdBarrier xcd_barrier_post(unsigned* bar, volatile LAS unsigned* st) {
    XcdBarrier b; b.bar = bar; b.x = xb_xcc_id(); b.st = st;
    if (threadIdx.x == 0) (void)xb_add(&bar[XB_XCNT(b.x)], 1u);
    return b;
}
__device__ __forceinline__ void xcd_barrier_complete(unsigned* bar, unsigned x, unsigned& nloc, unsigned& nx) {
    const unsigned G = gridDim.x * gridDim.y * gridDim.z;
    unsigned sum, cnt, mine, sp = 0u;
    for (;;) {
        sum = 0u; cnt = 0u; mine = 0u;
#pragma unroll
        for (unsigned j = 0; j < 16; ++j) { const unsigned c = xb_ld(&bar[XB_XCNT(j)]); sum += c; cnt += (c > 0u) ? 1u : 0u; mine = (j == x) ? c : mine; }
        if (sum == G) break;
        __builtin_amdgcn_s_sleep(1);
        if ((++sp & 255u) == 0u) { if (xb_ld(&bar[XB_TMO])) break; if (sp > XB_SPIN_CAP) { atomicAdd(&bar[XB_TMO], 1u); break; } }
    }
    nloc = mine > 0u ? mine : 1u; nx = cnt > 0u ? cnt : 1u;
}

__device__ __forceinline__ void xcd_barrier(const XcdBarrier& b) {
    asm volatile("s_waitcnt vmcnt(0)" ::: "memory");
    __syncthreads();
    if (threadIdx.x == 0) {
        unsigned* bar = b.bar;
        __builtin_amdgcn_s_waitcnt(0);
        unsigned nloc = b.st[0], nx = b.st[1];
        if (nloc == 0u) { xcd_barrier_complete(bar, b.x, nloc, nx); b.st[0] = nloc; b.st[1] = nx; }
        const unsigned old = xb_add(&bar[XB_XSUB(b.x)], 1u);
        const unsigned gen = old / nloc;
        if (old + 1u == (gen + 1u) * nloc) {
            __builtin_amdgcn_fence(__ATOMIC_RELEASE, "agent");
            asm volatile("s_waitcnt vmcnt(0)" ::: "memory");
            const unsigned og = xb_add(&bar[XB_TOP], 1u);
            const unsigned tg = og / nx;
            if (og + 1u == (tg + 1u) * nx) xb_add(&bar[XB_TOPGEN], 1u);
            else XB_SPIN(xb_ld(&bar[XB_TOPGEN]) == tg, bar);
            __builtin_amdgcn_fence(__ATOMIC_ACQUIRE, "agent");
            xb_add(&bar[XB_XGEN(b.x)], 1u);
            asm volatile("s_waitcnt vmcnt(0)" ::: "memory");
        } else {
            XB_SPIN(xb_ld(&bar[XB_XGEN(b.x)]) == gen, bar);
            __builtin_amdgcn_fence(__ATOMIC_ACQUIRE, "agent");
            asm volatile("s_waitcnt vmcnt(0)" ::: "memory");
        }
    }
    __syncthreads();
}

#ifndef P1_STAGGER_TICKS
#define P1_STAGGER_TICKS 0
#endif
#ifndef P3_STAGGER
#define P3_STAGGER 0
#endif
#ifndef P1_NCV
#define P1_NCV 16
#endif
#ifndef MK_MULTI
#define MK_MULTI 0
#endif
#ifndef PH_MASK
#define PH_MASK 0x7ff
#endif
constexpr int N_PHASES = 11;
template <int K> DI void run_phase(const Args& a, LAS unsigned char* lds) {
    int tid = threadIdx.x; asm volatile("" : "+v"(tid));
    const int lane = tid & 63, wave = __builtin_amdgcn_readfirstlane(tid >> 6);
    unsigned char* ws = a.ws; unsigned char* dob = (unsigned char*)a.out; const int G = gridDim.x;
    if constexpr (K == 0) { phase0(a, lds, tid, lane, wave); }
    if constexpr (K == 1) {
        pg8::Gemm g{(const pg8::bf16_t*)(dob + DO_A8), (const pg8::bf16_t*)(ws + WS_WIN), NTOK + NMROW, 9216, 512};
        const int NCV = (G % 8 == 0 && G >= 64) ? P1_NCV : 0, GG = G - NCV;
        if ((int)blockIdx.x < GG) {
            if (P1_STAGGER_TICKS) { const unsigned long long tgt = __builtin_amdgcn_s_memrealtime() + (unsigned long long)(((int)blockIdx.x >> 3) & 3) * (P1_STAGGER_TICKS);
                while (__builtin_amdgcn_s_memrealtime() < tgt) __builtin_amdgcn_s_sleep(8); }
            InOrder S; S.so.init(NTOK, 5120, GG, (int)blockIdx.x); S.nmain = (NTOK / 256) * 20;
            EpiIn E{ws, (bf16_t*)(dob + DO_QM), (bf16_t*)(dob + DO_KM), (const float*)a.in[I_GQA], (const float*)a.in[I_GKA], (const _Float16*)(ws + WS_ROPE), (const float*)(ws + WS_SH), (const float*)(ws + WS_SW)};
            pg8::gemm_phase<EpiIn, InOrder, true, true, true>(lds, g, S, E);
            __syncthreads();
        }
        moe_weight_convert(a, lds, tid, lane, wave);
    }
    if constexpr (K == 2) { phase2(a, lds, tid, lane, wave); }
    if constexpr (K == 3) {
        pg8::Gemm g{(const pg8::bf16_t*)(dob + DO_A8), (const pg8::bf16_t*)(ws + WS_WIN + (size_t)5120 * 1024), NTOK, 3072, 512};
        pg8::StaticOrder S; S.init(NTOK, 3072, G, (int)blockIdx.x);
        EpiGate E{(unsigned char*)(ws + WS_G), 3072, (const float*)(ws + WS_SH), (const float*)(ws + WS_SW) + 5120};
        const bool early = (P3_STAGGER) && (((int)blockIdx.x >> 3) & 1);
        if (early) attn_combine(a, lds, tid);
        pg8::gemm_phase<EpiGate, pg8::StaticOrder, true, true, true>(lds, g, S, E);
        if (!early) attn_combine(a, lds, tid);
    }
    if constexpr (K == 4) {
        pg8::Gemm g{(const pg8::bf16_t*)(ws + WS_AM), (const pg8::bf16_t*)(ws + WS_WMRG), NTOK, 1024, 1536};
        pg8::StaticOrder S; S.init(NTOK, 1024, G, (int)blockIdx.x);
        EpiMerge E{(const unsigned char*)(ws + WS_G), (bf16_t*)(ws + WS_MRG), 4, 16};
        pg8::gemm_phase<EpiMerge, pg8::StaticOrder, true, true>(lds, g, S, E);
    }
    if constexpr (K == 5) {
        pg8::Gemm g{(const pg8::bf16_t*)(ws + WS_MRG), (const pg8::bf16_t*)(ws + WS_WOUT), NTOK, 1024, 1024};
        pg8::StaticOrder S; S.init(NTOK, 1024, G, (int)blockIdx.x);
        EpiOut E{(const float*)a.in[I_X], a.out, (bf16_t*)(ws + WS_XB)};
        pg8::gemm_phase<EpiOut, pg8::StaticOrder, true, true>(lds, g, S, E);
    }
    if constexpr (K == 6) { phase6(a, lds, tid, lane, wave); }
    if constexpr (K == 8) {
        const int nt = build_tile_table(a, lds, tid);
        LAS int* rowtab = (LAS int*)(lds + MISC_OFF + 1536);
        MoeOrder<true> S{(const LAS int*)(lds + MISC_OFF), nt, G, (int)blockIdx.x, rowtab, (const LAS int*)(lds + MISC_OFF + 8448), (const LAS int*)(lds + MISC_OFF + 8448) + 320};
        { const int* rowtok = (const int*)(ws + WS_SROWTOK); Unit uu;
          int rv[6];
#pragma unroll
          for (int ui = 0; ui < 6; ++ui) { rv[ui] = 0; if (S.next(ui, uu) && tid < 256 && tid < uu.nv) rv[ui] = rowtok[uu.pm * 256 + tid + uu.sb]; }
#pragma unroll
          for (int ui = 0; ui < 6; ++ui) if (tid < 256) rowtab[ui * 256 + tid] = rv[ui]; }
        __syncthreads();
        pg8::Gemm g{(const pg8::bf16_t*)(ws + WS_XB8), (const pg8::bf16_t*)(ws + WS_WGU), nt * 256, 1024, 512};
        EpiUp E{(const float*)(ws + WS_SRSTD), (const float*)(ws + WS_SB), (bf16_t*)(ws + WS_ACT)};
        pg8::gemm_phase<EpiUp, MoeOrder<true>, true, true, true>(lds, g, S, E);
        {
            const int total = nt * 4, rounds = (total + G - 1) / G, busy = total - (rounds - 1) * G;
            if ((int)blockIdx.x >= busy) moe_wd_convert(a, (int)blockIdx.x - busy, G - busy, lane, wave);
            else if (busy == G) moe_wd_convert(a, (int)blockIdx.x, G, lane, wave);
        }
    }
    if constexpr (K == 9) {
        int nt;
        if constexpr ((MK_MULTI) || !(((PH_MASK) >> 8) & 1)) nt = build_tile_table(a, lds, tid);
        else nt = ((const LAS int*)(lds + MISC_OFF + 8448))[640 + 32];
        pg8::Gemm g{(const pg8::bf16_t*)(ws + WS_ACT), (const pg8::bf16_t*)(ws + WS_WD), nt * 256, 1024, 512};
        MoeOrder<false> S{(const LAS int*)(lds + MISC_OFF), nt, G, (int)blockIdx.x, nullptr, (const LAS int*)(lds + MISC_OFF + 8448), (const LAS int*)(lds + MISC_OFF + 8448) + 320};
        EpiDown E{(const u32x2*)(ws + WS_SDW), (bf16_t*)(ws + WS_Y)};
        pg8::gemm_phase<EpiDown, MoeOrder<false>, true, true>(lds, g, S, E);
    }
    if constexpr (K == 10) { phase10(a, lds, tid, lane, wave); }
}

#ifndef USE_CG_SEAM0
#define USE_CG_SEAM0 0
#endif
#ifndef IDLE_MASK
#define IDLE_MASK 0
#endif
#ifndef BUSY_MASK
#define BUSY_MASK 0
#endif
#ifndef IDLE_MODE
#define IDLE_MODE 0
#endif
#ifndef IDLE_SEL
#define IDLE_SEL true
#endif
#ifndef IDLE_AMP
#define IDLE_AMP 8
#endif
#ifndef REP_MASK
#define REP_MASK 0x000
#endif
__global__ void __launch_bounds__(512, 2) mk_fwd(Args a) {
    extern __shared__ __attribute__((aligned(16))) unsigned char lds_raw[];
    LAS unsigned char* lds = (LAS unsigned char*)lds_raw;
    const int tid = threadIdx.x;
    const int lo = a.ph_lo, hi = a.ph_hi;
    cg::grid_group grid = cg::this_grid();
    volatile LAS unsigned* bst = (volatile LAS unsigned*)(lds + MISC_OFF + 8192);
    if (tid < 4) bst[tid] = 0u;
    __syncthreads();
    XcdBarrier bar = xcd_barrier_post((unsigned*)(a.ws + WS_CTL) + 1024, bst);
#define IN(k) ((((PH_MASK) >> (k)) & 1) && lo <= (k) && (k) < hi)
#define RUN(k) do { if (IN(k)) { unsigned long long tb_ = 0; if constexpr (((BUSY_MASK) >> (k)) & 1) { if (tid == 0) tb_ = __builtin_amdgcn_s_memrealtime(); } run_phase<k>(a, lds); if constexpr (((BUSY_MASK) >> (k)) & 1) { __syncthreads(); if (tid == 0) bst[2] += (unsigned)(__builtin_amdgcn_s_memrealtime() - tb_); } if constexpr (((REP_MASK) >> (k)) & 1) { __syncthreads(); run_phase<k>(a, lds); } } \
                    if (IN(k) && IN((k) + 1)) { unsigned long long t0_ = 0; if constexpr (((IDLE_MASK) >> (k)) & 1) { if (tid == 0) t0_ = __builtin_amdgcn_s_memrealtime(); } \
                        if (USE_CG_SEAM0 && (k) == 0) grid.sync(); else xcd_barrier(bar); \
                        if constexpr (((IDLE_MASK) >> (k)) & 1) { if (tid == 0) bst[2] += (unsigned)(__builtin_amdgcn_s_memrealtime() - t0_); } } } while (0)
    if constexpr (((IDLE_MASK) >> 15) & 1) {
        unsigned long long t0_ = 0; if (tid == 0) t0_ = __builtin_amdgcn_s_memrealtime();
        xcd_barrier(bar);
        if (tid == 0) bst[2] += (unsigned)(__builtin_amdgcn_s_memrealtime() - t0_);
    }
    RUN(0); RUN(1); RUN(2); RUN(3); RUN(4); RUN(5);
    do { if (IN(6)) run_phase<6>(a, lds); if (IN(6) && IN(8)) xcd_barrier(bar); } while (0);
    RUN(8); RUN(9); RUN(10);
    if constexpr ((IDLE_MASK) != 0) {
        unsigned* acc = (unsigned*)(a.ws + WS_CTL) + 512;
        if (tid == 0 && (IDLE_SEL)) { if ((IDLE_MODE) == 1) atomicMax(acc, bst[2] * gridDim.x); else if ((IDLE_MODE) == 2) atomicMax(acc, (10000u - (bst[2] < 10000u ? bst[2] : 10000u)) * gridDim.x); else atomicAdd(acc, bst[2]); }
        xcd_barrier(bar);
        if (tid == 0) { const unsigned tot = xb_ld(acc); const unsigned long long tgt = __builtin_amdgcn_s_memrealtime() + (unsigned long long)tot * (IDLE_AMP) / gridDim.x;
            while (__builtin_amdgcn_s_memrealtime() < tgt) __builtin_amdgcn_s_sleep(20); }
        __syncthreads();
    }
#undef IN
#undef RUN
}

extern "C" void kernel_launch(void* const* d_in, const int* in_sizes, int n_in, void* d_out, int out_size, void* d_ws, size_t ws_size, hipStream_t stream) {
    static int grid = 0;
    if (grid == 0) {
        if (n_in != 24 || out_size != NTOK * DM || ws_size < WS_NEED) { fprintf(stderr, "kernel_launch: unexpected shapes (n_in %d, out %d, ws %zu)\n", n_in, out_size, ws_size); grid = -1; return; }
        int dev = 0, cus = 0, per_cu = 0;
        (void)hipGetDevice(&dev); (void)hipDeviceGetAttribute(&cus, hipDeviceAttributeMultiprocessorCount, dev);
        (void)hipFuncSetAttribute((const void*)mk_fwd, hipFuncAttributeMaxDynamicSharedMemorySize, LDS_BYTES);
        (void)hipOccupancyMaxActiveBlocksPerMultiprocessor(&per_cu, (const void*)mk_fwd, 512, LDS_BYTES);
        (void)hipGetLastError();
        if (per_cu < 1) { fprintf(stderr, "kernel_launch: occupancy query says %d blocks per CU: this kernel cannot be made resident, nothing launched\n", per_cu); grid = -1; return; }
        grid = cus;
    }
    if (grid < 0) return;
    Args a{};
    for (int i = 0; i < 24; ++i) a.in[i] = d_in[i];
    a.out = (float*)d_out; a.ws = (unsigned char*)d_ws;
#if MK_MULTI
    for (int p = 0; p < N_PHASES; ++p) { a.ph_lo = p; a.ph_hi = p + 1; hipLaunchKernelGGL(mk_fwd, dim3(grid), dim3(512), LDS_BYTES, stream, a); }
#else
    a.ph_lo = 0; a.ph_hi = N_PHASES;
    if (hipMemsetAsync((char*)d_ws + WS_CTL, 0, CTL_BYTES, stream) != hipSuccess) { fprintf(stderr, "kernel_launch: memset failed\n"); return; }
    void* args[] = {&a};
    hipError_t e = hipLaunchCooperativeKernel((const void*)mk_fwd, dim3(grid), dim3(512), args, LDS_BYTES, stream);
    if (e != hipSuccess) fprintf(stderr, "cooperative launch failed: %s (grid %d)\n", hipGetErrorString(e), grid);
#endif
}
```
